# Optimizing an MI355X kernel written in HIP

```python
import functools
import jax, jax.numpy as jnp
from jax import lax
import numpy as np

D_MODEL = 4096
BATCH = 2
SEQ = 4096
DEPTH = 1
DEC_BATCH = 128
DEC_SEQ = 8
PAST_LEN = 8192
PAGE_SIZE = 128

ATTN_WIDTH = D_MODEL // 2
D_CONV = D_MODEL - ATTN_WIDTH
HEAD_DIM = 64
N_Q_HEADS = ATTN_WIDTH // HEAD_DIM
N_KV_HEADS = max(1, N_Q_HEADS // 8)
GROUP = N_Q_HEADS // N_KV_HEADS
KV_DIM = N_KV_HEADS * HEAD_DIM
WINDOW = 128
BLOCK = 128
CONV_K = 3
D_FF = ((8 * D_MODEL // 3 + 255) // 256) * 256
N_IN = ATTN_WIDTH + 2 * KV_DIM + 3 * D_CONV
N_MOD = 6
EPS = 1e-5

kernel_name = "hybrid_swa_sink_shortconv_convffn_adaln_step"


def _rmsnorm(x, g):
    xf = x.astype(jnp.float32)
    y = xf * lax.rsqrt(jnp.mean(xf * xf, axis=-1, keepdims=True) + EPS)
    return (y * g.astype(jnp.float32)).astype(x.dtype)


def _causal_dwconv(u, prev, w):
    t = u.shape[1]
    full = jnp.concatenate([prev.astype(u.dtype), u], axis=1)
    y = full[:, 0:t] * w[0]
    for j in range(1, CONV_K):
        y = y + full[:, j:j + t] * w[j]
    return y, full[:, full.shape[1] - (CONV_K - 1):]


def _sink_softmax(s, mask, sinks):
    sink = sinks.astype(jnp.float32).reshape(N_KV_HEADS, GROUP, 1, 1)
    s = jnp.where(mask, s, -jnp.inf)
    m = jnp.maximum(jnp.max(s, axis=-1, keepdims=True), sink)
    p = jnp.exp(s - m)
    return p / (jnp.sum(p, axis=-1, keepdims=True) + jnp.exp(sink - m))


def _prompt_attention(q, k, v, sinks):
    n, t = q.shape[0], q.shape[1]
    nb = t // BLOCK
    qb = q.reshape(n, nb, BLOCK, N_KV_HEADS, GROUP, HEAD_DIM)
    kb = k.reshape(n, nb, BLOCK, N_KV_HEADS, HEAD_DIM)
    vb = v.reshape(n, nb, BLOCK, N_KV_HEADS, HEAD_DIM)

    def with_prev(a):
        prev = jnp.concatenate([jnp.zeros_like(a[:, :1]), a[:, :-1]], axis=1)
        return jnp.concatenate([prev, a], axis=2)

    kk, vv = with_prev(kb), with_prev(vb)
    s = jnp.einsum("nbqkgd,nbskd->nbkgqs", qb, kk).astype(jnp.float32) * (HEAD_DIM ** -0.5)
    blk = jnp.arange(nb)[:, None, None] * BLOCK
    qpos = blk + jnp.arange(BLOCK)[None, :, None]
    kpos = blk - BLOCK + jnp.arange(2 * BLOCK)[None, None, :]
    diff = qpos - kpos
    mask = (diff >= 0) & (diff <= WINDOW) & (kpos >= 0)
    p = _sink_softmax(s, mask[:, None, None], sinks).astype(v.dtype)
    o = jnp.einsum("nbkgqs,nbskd->nbqkgd", p, vv).reshape(n, t, N_Q_HEADS * HEAD_DIM)
    keep = min(WINDOW, t)
    return o, k[:, t - keep:], v[:, t - keep:]


def _sample_attention(q, k, v, k_buf, v_buf, sinks):
    n, t = q.shape[0], q.shape[1]
    w = k_buf.shape[1]
    kk = jnp.concatenate([k_buf.astype(k.dtype), k], axis=1)
    vv = jnp.concatenate([v_buf.astype(v.dtype), v], axis=1)
    qg = q.reshape(n, t, N_KV_HEADS, GROUP, HEAD_DIM)
    s = jnp.einsum("nqkgd,nskd->nkgqs", qg, kk).astype(jnp.float32) * (HEAD_DIM ** -0.5)
    qpos = PAST_LEN + jnp.arange(t)
    kpos = jnp.concatenate([PAST_LEN - w + jnp.arange(w), PAST_LEN + jnp.arange(t)])
    diff = qpos[:, None] - kpos[None, :]
    mask = (diff >= 0) & (diff <= WINDOW)
    p = _sink_softmax(s, mask, sinks).astype(v.dtype)
    o = jnp.einsum("nkgqs,nskd->nqkgd", p, vv).reshape(n, t, N_Q_HEADS * HEAD_DIM)
    return o, kk[:, kk.shape[1] - w:], vv[:, vv.shape[1] - w:]


def _layer(x, c, conv_prev, ffn_prev, attend, w_mod, b_mod, g_mix, g_ffn, w_in, conv_w,
           w_out, w_gate_up, ffn_conv_w, w_down):
    n, t, _ = x.shape
    mod = (jax.nn.silu(c) @ w_mod + b_mod).reshape(n, N_MOD, 1, D_MODEL)
    shift_m, scale_m, gate_m = mod[:, 0], mod[:, 1], mod[:, 2]
    shift_f, scale_f, gate_f = mod[:, 3], mod[:, 4], mod[:, 5]

    h = _rmsnorm(x, g_mix) * (1 + scale_m) + shift_m
    proj = h @ w_in
    cuts = [ATTN_WIDTH, ATTN_WIDTH + KV_DIM, ATTN_WIDTH + 2 * KV_DIM,
            ATTN_WIDTH + 2 * KV_DIM + D_CONV, ATTN_WIDTH + 2 * KV_DIM + 2 * D_CONV]
    q, k, v, b_gate, c_gate, h_conv = jnp.split(proj, cuts, axis=-1)
    attn_out, k_state, v_state = attend(
        q.reshape(n, t, N_Q_HEADS, HEAD_DIM),
        k.reshape(n, t, N_KV_HEADS, HEAD_DIM),
        v.reshape(n, t, N_KV_HEADS, HEAD_DIM))
    y_conv, conv_state = _causal_dwconv(c_gate * h_conv, conv_prev, conv_w)
    mixed = jnp.concatenate([attn_out, b_gate * y_conv], axis=-1) @ w_out
    x = x + gate_m * mixed

    h = _rmsnorm(x, g_ffn) * (1 + scale_f) + shift_f
    gate_pre, up = jnp.split(h @ w_gate_up, [D_FF], axis=-1)
    g_conv, ffn_state = _causal_dwconv(gate_pre, ffn_prev, ffn_conv_w)
    x = x + gate_f * ((jax.nn.silu(g_conv) * up) @ w_down)
    return x, k_state, v_state, conv_state, ffn_state


def setup_inputs(seed: int = 0) -> dict:
    key = jax.random.key(seed)
    ks = jax.random.split(key, 20)
    f32 = jnp.float32

    def nrm(k, shape, scale):
        return jax.random.normal(k, shape, f32) * scale

    wb = min(WINDOW, PAST_LEN)
    return {
        "x_prompt": nrm(ks[0], (BATCH, SEQ, D_MODEL), 1.0),
        "x_sample": nrm(ks[1], (DEC_BATCH, DEC_SEQ, D_MODEL), 1.0),
        "cache_k_win": nrm(ks[2], (DEPTH, DEC_BATCH, wb, N_KV_HEADS, HEAD_DIM), 1.0),
        "cache_v_win": nrm(ks[3], (DEPTH, DEC_BATCH, wb, N_KV_HEADS, HEAD_DIM), 1.0),
        "state_conv": nrm(ks[4], (DEPTH, DEC_BATCH, CONV_K - 1, D_CONV), 1.0),
        "state_ffn_conv": nrm(ks[5], (DEPTH, DEC_BATCH, CONV_K - 1, D_FF), 1.0),
        "c_prompt": nrm(ks[6], (BATCH, D_MODEL), 1.0),
        "c_sample": nrm(ks[7], (DEC_BATCH, D_MODEL), 1.0),
        "w_mod": nrm(ks[8], (DEPTH, D_MODEL, N_MOD * D_MODEL), 0.5 * D_MODEL ** -0.5),
        "b_mod": nrm(ks[9], (DEPTH, N_MOD * D_MODEL), 0.02),
        "g_mix": 1.0 + nrm(ks[10], (DEPTH, D_MODEL), 0.05),
        "g_ffn": 1.0 + nrm(ks[11], (DEPTH, D_MODEL), 0.05),
        "w_in": nrm(ks[12], (DEPTH, D_MODEL, N_IN), D_MODEL ** -0.5),
        "conv_w": nrm(ks[13], (DEPTH, CONV_K, D_CONV), CONV_K ** -0.5),
        "sinks": nrm(ks[14], (DEPTH, N_Q_HEADS), 1.0),
        "w_out": nrm(ks[15], (DEPTH, ATTN_WIDTH + D_CONV, D_MODEL), (ATTN_WIDTH + D_CONV) ** -0.5),
        "w_gate_up": nrm(ks[16], (DEPTH, D_MODEL, 2 * D_FF), D_MODEL ** -0.5),
        "ffn_conv_w": nrm(ks[17], (DEPTH, CONV_K, D_FF), CONV_K ** -0.5),
        "w_down": nrm(ks[18], (DEPTH, D_FF, D_MODEL), D_FF ** -0.5),
        "g_final": 1.0 + nrm(ks[19], (D_MODEL,), 0.05),
    }


def reference(x_prompt, x_sample, cache_k_win, cache_v_win, state_conv, state_ffn_conv,
              c_prompt, c_sample, w_mod, b_mod, g_mix, g_ffn, w_in, conv_w, sinks, w_out,
              w_gate_up, ffn_conv_w, w_down, g_final):
    xp, xs = x_prompt, x_sample
    kp_l, vp_l, cp_l, fp_l = [], [], [], []
    ks_l, vs_l, cs_l, fs_l = [], [], [], []
    for l in range(DEPTH):
        weights = (w_mod[l], b_mod[l], g_mix[l], g_ffn[l], w_in[l], conv_w[l], w_out[l],
                   w_gate_up[l], ffn_conv_w[l], w_down[l])
        conv0 = jnp.zeros((xp.shape[0], CONV_K - 1, D_CONV), xp.dtype)
        ffn0 = jnp.zeros((xp.shape[0], CONV_K - 1, D_FF), xp.dtype)
        xp, kp, vp, cp, fp = _layer(
            xp, c_prompt, conv0, ffn0,
            functools.partial(_prompt_attention, sinks=sinks[l]), *weights)
        xs, ksn, vsn, csn, fsn = _layer(
            xs, c_sample, state_conv[l], state_ffn_conv[l],
            functools.partial(_sample_attention, k_buf=cache_k_win[l], v_buf=cache_v_win[l],
                              sinks=sinks[l]), *weights)
        kp_l.append(kp); vp_l.append(vp); cp_l.append(cp); fp_l.append(fp)
        ks_l.append(ksn); vs_l.append(vsn); cs_l.append(csn); fs_l.append(fsn)
    y_prompt = _rmsnorm(xp, g_final)
    y_sample = _rmsnorm(xs, g_final)
    return (y_prompt, y_sample,
            jnp.stack(kp_l), jnp.stack(vp_l), jnp.stack(cp_l), jnp.stack(fp_l),
            jnp.stack(ks_l), jnp.stack(vs_l), jnp.stack(cs_l), jnp.stack(fs_l))
```

```cpp
#include <hip/hip_runtime.h>
#include <hip/hip_bf16.h>
#include <cstdio>
#include <cstdint>
#include <cmath>
#define MK_PER_PHASE 1
namespace pg8 {
#define PG8_LAS __attribute__((address_space(3)))
typedef unsigned short bf16_t;
typedef short bf16x8 __attribute__((ext_vector_type(8)));
typedef float f32x4 __attribute__((ext_vector_type(4)));
typedef unsigned u32x4 __attribute__((ext_vector_type(4)));
constexpr int BM = 256, BK = 64, HALF = 128, HTB = HALF * BK * 2  , STAGE_BYTES = 8 * HTB, NXCD = 8, WGM = 8;

__host__ __device__ __forceinline__ int lds_byte(int r, int c) { const int st = (r >> 4) * 2 + (c >> 5), rr = r & 15, cc = c & 31, ob = rr * 64 + cc * 2; return st * 1024 + (ob ^ (((ob >> 9) & 1) << 5)); }
__host__ __device__ __forceinline__ void stage_rc(int b, int& R, int& C) { const int st = b / 1024, sb = b % 1024, swz = sb ^ (((sb >> 9) & 1) << 5); R = (st >> 1) * 16 + swz / 64; C = (st & 1) * 32 + (swz % 64) / 2; }
__host__ __device__ __forceinline__ int perm32(int rho) { const int n = rho >> 4, i = rho & 15; return 8 * (i >> 2) + 4 * n + (i & 3); }

struct Unit { int pm, pn; };
struct Gemm { const bf16_t* A; const bf16_t* Bt; int M, N, K; };

struct StaticOrder {
    int nM, nN, nwg, G, c;
    __host__ __device__ void init(int M, int N, int G_, int c_) { nM = M / BM; nN = N / BM; nwg = nM * nN; G = G_; c = c_; }
    __host__ __device__ bool next(int i, Unit& u) const {
        const long L = (long)i * G + c; if (L >= nwg) return false;
        int wgid = (int)L; { const int q = nwg / NXCD, r = nwg % NXCD, xcd = wgid % NXCD, off = wgid / NXCD; wgid = (xcd < r ? xcd * (q + 1) : r * (q + 1) + (xcd - r) * q) + off; }
        const int nig = WGM * nN, gid = wgid / nig, fm = gid * WGM, gsz = (nM - fm) < WGM ? (nM - fm) : WGM;
        u.pm = fm + ((wgid % nig) % gsz); u.pn = (wgid % nig) / gsz; return true;
    }
    __device__ __forceinline__ void a_ready(const Unit&) const {}
    __device__ __forceinline__ void done(const Unit&) const {}
};

__device__ __forceinline__ unsigned cvt_pk_bf16(float lo, float hi) { unsigned r; asm volatile("v_cvt_pk_bf16_f32 %0, %1, %2" : "=v"(r) : "v"(lo), "v"(hi)); return r; }
typedef float f32x2 __attribute__((ext_vector_type(2)));
__device__ __forceinline__ f32x2 gelu_pk(f32x2 v) {
    const f32x2 av = __builtin_elementwise_abs(v), d = av * 0.2316418882f + 1.0f;
    f32x2 t; t.x = __builtin_amdgcn_rcpf(d.x); t.y = __builtin_amdgcn_rcpf(d.y);
    f32x2 q = t * 0.5307027145f + (-0.7265760135f); q = q * t + 0.7107068705f; q = q * t + (-0.142248368f); q = q * t + 0.127414796f; q = q * t;
    const f32x2 s = (v * v) * (-0.72134752044f);
    f32x2 e; e.x = __builtin_amdgcn_exp2f(s.x); e.y = __builtin_amdgcn_exp2f(s.y);
    const f32x2 m = v * (q * e), r = v - m;
    f32x2 o; o.x = v.x < 0.f ? m.x : r.x; o.y = v.y < 0.f ? m.y : r.y; return o;
}

template <int ACT  > struct EpiBf16 {
    static constexpr bool PERM = true, AFTER_DRAIN = false; static_assert(ACT == 0 || ACT == 1, "EpiBf16: ACT is 0 (none) or 1 (gelu_pk)");
    bf16_t* O; int ldc; const float* bias; int split_cols; size_t split_stride; float scale0;
    __device__ __forceinline__ void operator()(const f32x4 (&acc)[2][2][4][2], const Unit& u, int wr, int wc, int fr, int fq) const {
        const int row0 = u.pm * BM + wr * 64 + fr; int colt = u.pn * BM; bf16_t* base = O;
        float sc = 1.f; if (split_cols) { const int t = colt / split_cols; base += (size_t)t * split_stride; colt -= t * split_cols; if (t == 0) sc = scale0; }
        const int col0 = colt + wc * 32 + 8 * fq, bcol0 = u.pn * BM + wc * 32 + 8 * fq;
        f32x4 bv[2][2];
#pragma unroll
        for (int bj = 0; bj < 2; ++bj)
#pragma unroll
            for (int n = 0; n < 2; ++n) bv[bj][n] = bias ? *(const f32x4*)(bias + bcol0 + bj * HALF + 4 * n) : (f32x4){0.f, 0.f, 0.f, 0.f};
#pragma unroll
        for (int ai = 0; ai < 2; ++ai)
#pragma unroll
            for (int m = 0; m < 4; ++m) { bf16_t* rowp = base + (size_t)(row0 + ai * HALF + m * 16) * ldc + col0;
#pragma unroll
                for (int bj = 0; bj < 2; ++bj) { f32x4 v0 = acc[ai][bj][m][0] + bv[bj][0], v1 = acc[ai][bj][m][1] + bv[bj][1];
                    if (ACT == 1) { f32x2 a = gelu_pk((f32x2){v0[0], v0[1]}), b = gelu_pk((f32x2){v0[2], v0[3]}), c = gelu_pk((f32x2){v1[0], v1[1]}), d = gelu_pk((f32x2){v1[2], v1[3]});
                        v0 = (f32x4){a.x, a.y, b.x, b.y}; v1 = (f32x4){c.x, c.y, d.x, d.y}; }
                    v0 = v0 * sc; v1 = v1 * sc; u32x4 w; w.x = cvt_pk_bf16(v0[0], v0[1]); w.y = cvt_pk_bf16(v0[2], v0[3]); w.z = cvt_pk_bf16(v1[0], v1[1]); w.w = cvt_pk_bf16(v1[2], v1[3]);
                    *(u32x4*)(rowp + bj * HALF) = w; } }
    }
};
struct EpiF32 {
    static constexpr bool PERM = false, AFTER_DRAIN = false;
    float* C; int ldc; const float* bias;
    __device__ __forceinline__ void operator()(const f32x4 (&acc)[2][2][4][2], const Unit& u, int wr, int wc, int fr, int fq) const {
        const int row0 = u.pm * BM + wr * 64 + fr, col0 = u.pn * BM + wc * 32 + 4 * fq;
        f32x4 bv[2][2];
#pragma unroll
        for (int bj = 0; bj < 2; ++bj)
#pragma unroll
            for (int n = 0; n < 2; ++n) bv[bj][n] = bias ? *(const f32x4*)(bias + col0 + bj * HALF + n * 16) : (f32x4){0.f, 0.f, 0.f, 0.f};
#pragma unroll
        for (int ai = 0; ai < 2; ++ai)
#pragma unroll
            for (int m = 0; m < 4; ++m) { float* rowp = C + (size_t)(row0 + ai * HALF + m * 16) * ldc + col0;
#pragma unroll
                for (int bj = 0; bj < 2; ++bj)
#pragma unroll
                    for (int n = 0; n < 2; ++n) *(f32x4*)(rowp + bj * HALF + n * 16) = acc[ai][bj][m][n] + bv[bj][n]; }
    }
};
struct EpiResGate {
    static constexpr bool PERM = false, AFTER_DRAIN = false;
    const float* base_p; const float* base_s; float* out; const float* gate;
    __device__ __forceinline__ void operator()(const f32x4 (&acc)[2][2][4][2], const Unit& u, int wr, int wc, int fr, int fq) const {
        const int col0 = u.pn * BM + wc * 32 + 4 * fq;
#pragma unroll
        for (int ai = 0; ai < 2; ++ai)
#pragma unroll
            for (int m = 0; m < 4; ++m) {
                const int r = u.pm * BM + ai * HALF + wr * 64 + m * 16 + fr;
                const int cond = r < 8192 ? (r >> 12) : 2 + ((r - 8192) >> 3);
                const float* bp = (r < 8192 ? base_p + (size_t)r * 4096 : base_s + (size_t)(r - 8192) * 4096) + col0;
                const float* gp = gate + (size_t)cond * 24576 + col0;
                float* op = out + (size_t)r * 4096 + col0;
#pragma unroll
                for (int bj = 0; bj < 2; ++bj)
#pragma unroll
                    for (int n = 0; n < 2; ++n) { const f32x4 b = *(const f32x4*)(bp + bj * HALF + n * 16), g = *(const f32x4*)(gp + bj * HALF + n * 16);
                        *(f32x4*)(op + bj * HALF + n * 16) = b + g * acc[ai][bj][m][n]; }
            }
    }
};
template <class Epi, class Sched, bool ALIGN_EPI = false, bool SP2 = false>
__device__ __forceinline__ void gemm_phase(PG8_LAS unsigned char* lds, const Gemm g, const Sched& S, const Epi& E) {
    const int tid = threadIdx.x, wid = __builtin_amdgcn_readfirstlane(tid >> 6), lane = tid & 63, wr = wid >> 2, wc = wid & 3, fr = lane & 15, fq = lane >> 4;
    const int K = g.K, nt = K / BK;
    unsigned voffA[2], voffB[2];
#pragma unroll
    for (int i = 0; i < 2; ++i) { int R, C; stage_rc(tid * 16 + i * 8192, R, C); const int Rb = Epi::PERM ? ((R & ~31) + perm32(R & 31)) : R;
        voffA[i] = (unsigned)(R * K + C) * 2u; voffB[i] = (unsigned)(Rb * K + C) * 2u; }
    const size_t kstep = (size_t)(BK * 2);
    const size_t hstep = (size_t)HALF * K * 2;
    const size_t tstep = 2 * hstep;
    const unsigned ldsw = (unsigned)wid * 1024u;
    const int aoff = lds_byte(wr * 64 + fr, fq * 8), boff = lds_byte(wc * 32 + fr, fq * 8);
#define PG8_SA(b, h) (((b) * 2 + (h)) * HTB)
#define PG8_SB(b, h) ((4 + (b) * 2 + (h)) * HTB)
#define PG8_STAGE(bufoff, gbase, voff) do { _Pragma("unroll") for (int _i = 0; _i < 2; ++_i) \
        __builtin_amdgcn_global_load_lds((const unsigned*)((const char*)(gbase) + (voff)[_i]), (PG8_LAS unsigned*)(lds + (bufoff) + ldsw + _i * 8192), 16, 0, 0); } while (0)
#define PG8_LDA(dst, b, h) do { _Pragma("unroll") for (int m = 0; m < 4; ++m) _Pragma("unroll") for (int k = 0; k < 2; ++k) dst[m][k] = *(const PG8_LAS bf16x8*)(lds + PG8_SA(b, h) + aoff + m * 2048 + k * 1024); } while (0)
#define PG8_LDB(dst, b, h) do { _Pragma("unroll") for (int n = 0; n < 2; ++n) _Pragma("unroll") for (int k = 0; k < 2; ++k) dst[n][k] = *(const PG8_LAS bf16x8*)(lds + PG8_SB(b, h) + boff + n * 2048 + k * 1024); } while (0)
#define PG8_MMA(ai, bj, At, Bt) do { __builtin_amdgcn_s_setprio(1); _Pragma("unroll") for (int m = 0; m < 4; ++m) _Pragma("unroll") for (int n = 0; n < 2; ++n) _Pragma("unroll") for (int k = 0; k < 2; ++k) \
        acc[ai][bj][m][n] = __builtin_amdgcn_mfma_f32_16x16x32_bf16(Bt[n][k], At[m][k], acc[ai][bj][m][n], 0, 0, 0); __builtin_amdgcn_s_setprio(0); } while (0)
#define PG8_WAIT_V(n) asm volatile("s_waitcnt vmcnt(" #n ")" ::: "memory")
#define PG8_WAIT_L(n) asm volatile("s_waitcnt lgkmcnt(" #n ")" ::: "memory")
#define PG8_BAR __builtin_amdgcn_s_barrier()
#define PG8_SCHED __builtin_amdgcn_sched_barrier(0)
    Unit cur, nxt; int ui = 0;
    if (!S.next(0, cur)) return;
    f32x4 acc[2][2][4][2];
#pragma unroll
    for (int a = 0; a < 2; ++a)
#pragma unroll
        for (int b = 0; b < 2; ++b)
#pragma unroll
            for (int m = 0; m < 4; ++m)
#pragma unroll
                for (int n = 0; n < 2; ++n) acc[a][b][m][n] = (f32x4){0.f, 0.f, 0.f, 0.f};
    bf16x8 At[4][2], B0[2][2], B1[2][2];
    const char* cA = (const char*)g.A + (size_t)cur.pm * tstep; const char* cB = (const char*)g.Bt + (size_t)cur.pn * tstep;
    S.a_ready(cur);
    if constexpr (SP2) {
        PG8_STAGE(PG8_SB(0, 0), cB, voffB); PG8_STAGE(PG8_SB(0, 1), cB + hstep, voffB); PG8_STAGE(PG8_SA(0, 0), cA, voffA); PG8_STAGE(PG8_SA(0, 1), cA + hstep, voffA);
        if (wr == 1) PG8_BAR;
        PG8_WAIT_V(2); PG8_BAR;
        PG8_STAGE(PG8_SB(1, 0), cB + kstep, voffB); PG8_STAGE(PG8_SA(1, 0), cA + kstep, voffA); PG8_STAGE(PG8_SB(1, 1), cB + hstep + kstep, voffB);
        PG8_WAIT_V(6); PG8_BAR;
    } else {
        PG8_STAGE(PG8_SB(0, 0), cB, voffB); PG8_STAGE(PG8_SA(0, 0), cA, voffA); PG8_STAGE(PG8_SB(0, 1), cB + hstep, voffB); PG8_STAGE(PG8_SA(0, 1), cA + hstep, voffA);
        if (wr == 1) PG8_BAR;
        PG8_WAIT_V(4); PG8_BAR;
        PG8_STAGE(PG8_SB(1, 0), cB + kstep, voffB); PG8_STAGE(PG8_SA(1, 0), cA + kstep, voffA); PG8_STAGE(PG8_SB(1, 1), cB + hstep + kstep, voffB);
        PG8_WAIT_V(6); PG8_BAR;
    }
    for (;;) {
        const bool has_next = S.next(ui + 1, nxt);
        const char* nA = has_next ? (const char*)g.A + (size_t)nxt.pm * tstep : cA; const char* nB = has_next ? (const char*)g.Bt + (size_t)nxt.pn * tstep : cB;
        for (int t = 0; t < nt; t += 2) {
            const bool last = (t == nt - 2);
            const char* a1 = cA + (size_t)(t + 1) * kstep;
            const char* a2 = last ? nA : cA + (size_t)(t + 2) * kstep; const char* b2 = last ? nB : cB + (size_t)(t + 2) * kstep;
            const char* a3 = a2 + kstep; const char* b3 = b2 + kstep;
            if (last && has_next) S.a_ready(nxt);
            if constexpr (SP2) {
            PG8_LDB(B0, 0, 0); PG8_LDB(B1, 0, 1); PG8_SCHED; PG8_LDA(At, 0, 0); PG8_STAGE(PG8_SA(1, 1), a1 + hstep, voffA);
            PG8_WAIT_V(8); PG8_WAIT_L(0); PG8_BAR; PG8_MMA(0, 0, At, B0); PG8_MMA(0, 1, At, B1); PG8_BAR; PG8_SCHED;
            PG8_LDA(At, 0, 1); PG8_STAGE(PG8_SB(0, 0), b2, voffB); PG8_STAGE(PG8_SB(0, 1), b2 + hstep, voffB); PG8_STAGE(PG8_SA(0, 0), a2, voffA);
            PG8_WAIT_V(8); PG8_WAIT_L(0); PG8_BAR; PG8_MMA(1, 0, At, B0); PG8_MMA(1, 1, At, B1); PG8_BAR; PG8_SCHED;
            PG8_LDB(B0, 1, 0); PG8_LDB(B1, 1, 1); PG8_SCHED; PG8_LDA(At, 1, 0); PG8_STAGE(PG8_SA(0, 1), a2 + hstep, voffA);
            PG8_WAIT_V(8); PG8_WAIT_L(0); PG8_BAR; PG8_MMA(0, 0, At, B0); PG8_MMA(0, 1, At, B1); PG8_BAR; PG8_SCHED;
            PG8_LDA(At, 1, 1); PG8_STAGE(PG8_SB(1, 0), b3, voffB); PG8_STAGE(PG8_SB(1, 1), b3 + hstep, voffB); PG8_STAGE(PG8_SA(1, 0), a3, voffA);
            PG8_WAIT_V(8); PG8_WAIT_L(0); PG8_BAR; PG8_MMA(1, 0, At, B0); PG8_MMA(1, 1, At, B1); PG8_BAR; PG8_SCHED;
            } else {
            PG8_LDB(B0, 0, 0); PG8_SCHED; PG8_LDA(At, 0, 0); PG8_STAGE(PG8_SA(1, 1), a1 + hstep, voffA);
            PG8_WAIT_L(8); PG8_BAR; PG8_WAIT_L(0); PG8_MMA(0, 0, At, B0); PG8_BAR; PG8_SCHED;
            PG8_LDB(B1, 0, 1); PG8_STAGE(PG8_SB(0, 0), b2, voffB);
            PG8_BAR; PG8_WAIT_L(0); PG8_MMA(0, 1, At, B1); PG8_BAR;
            PG8_LDA(At, 0, 1); PG8_STAGE(PG8_SA(0, 0), a2, voffA);
            PG8_BAR; PG8_WAIT_L(0); PG8_MMA(1, 0, At, B0); PG8_BAR; PG8_SCHED;
            PG8_STAGE(PG8_SB(0, 1), b2 + hstep, voffB);
            PG8_WAIT_V(6); PG8_BAR; PG8_MMA(1, 1, At, B1); PG8_BAR;
            PG8_LDB(B0, 1, 0); PG8_SCHED; PG8_LDA(At, 1, 0); PG8_STAGE(PG8_SA(0, 1), a2 + hstep, voffA);
            PG8_WAIT_L(8); PG8_BAR; PG8_WAIT_L(0); PG8_MMA(0, 0, At, B0); PG8_BAR; PG8_SCHED;
            PG8_LDB(B1, 1, 1); PG8_STAGE(PG8_SB(1, 0), b3, voffB);
            PG8_BAR; PG8_WAIT_L(0); PG8_MMA(0, 1, At, B1); PG8_BAR;
            PG8_LDA(At, 1, 1); PG8_STAGE(PG8_SA(1, 0), a3, voffA);
            PG8_BAR; PG8_WAIT_L(0); PG8_MMA(1, 0, At, B0); PG8_BAR; PG8_SCHED;
            PG8_STAGE(PG8_SB(1, 1), b3 + hstep, voffB);
            PG8_WAIT_V(6); PG8_BAR; PG8_MMA(1, 1, At, B1); PG8_BAR;
            }
        }
        if constexpr (ALIGN_EPI) { if (wr == 0) PG8_BAR; }
        if constexpr (!Epi::AFTER_DRAIN) { E(acc, cur, wr, wc, fr, fq); S.done(cur); }
        if (!has_next) break;
#pragma unroll
        for (int a = 0; a < 2; ++a)
#pragma unroll
            for (int b = 0; b < 2; ++b)
#pragma unroll
                for (int m = 0; m < 4; ++m)
#pragma unroll
                    for (int n = 0; n < 2; ++n) acc[a][b][m][n] = (f32x4){0.f, 0.f, 0.f, 0.f};
        cur = nxt; cA = nA; cB = nB; ++ui;
        if constexpr (ALIGN_EPI) { if (wr == 1) PG8_BAR; }
    }
    PG8_WAIT_V(0);
    if constexpr (!ALIGN_EPI) { if (wr == 0) PG8_BAR; }
    PG8_BAR;
    if constexpr (Epi::AFTER_DRAIN) { E.fused(acc, cur, wr, wc, fr, fq, lds, wid, lane); S.done(cur); }
#undef PG8_SA
#undef PG8_SB
#undef PG8_STAGE
#undef PG8_LDA
#undef PG8_LDB
#undef PG8_MMA
#undef PG8_WAIT_V
#undef PG8_WAIT_L
#undef PG8_BAR
#undef PG8_SCHED
}
}
#define GAS __attribute__((address_space(1)))
#define LAS __attribute__((address_space(3)))
typedef unsigned short bf16;
typedef unsigned v4u __attribute__((ext_vector_type(4)));
typedef float f32x4 __attribute__((ext_vector_type(4)));
typedef short bf16x8 __attribute__((ext_vector_type(8)));
typedef GAS unsigned gu32;
typedef GAS unsigned long long gu64;
#define RLX_AGENT __ATOMIC_RELAXED, __HIP_MEMORY_SCOPE_AGENT
#define LDS_WAIT() asm volatile("s_waitcnt lgkmcnt(0)" ::: "memory")
#define VM_WAIT() asm volatile("s_waitcnt vmcnt(0)" ::: "memory")
__device__ __forceinline__ unsigned long long rt() { return __builtin_amdgcn_s_memrealtime(); }
__device__ __forceinline__ unsigned f2bf(float f) { unsigned u = __builtin_bit_cast(unsigned, f); return (u + 0x7fffu + ((u >> 16) & 1u)) >> 16; }
__device__ __forceinline__ unsigned pk2(float lo, float hi) { return f2bf(lo) | (f2bf(hi) << 16); }
#define XB_TMO      128
#define XB_XCNT(j)  (256  + 64 * (j))
#define XB_XSUB(j)  (1280 + 64 * (j))
#define XB_XGEN(j)  (2304 + 64 * (j))
#define XB_TOP      3328
#define XB_TOPGEN   3392
#define XCD_BAR_WORDS 3456
#define XB_SPIN_CAP (1u << 18)

__device__ __forceinline__ unsigned xb_ld(unsigned* p)              { return __hip_atomic_load(p, __ATOMIC_RELAXED, __HIP_MEMORY_SCOPE_AGENT); }
__device__ __forceinline__ unsigned xb_add(unsigned* p, unsigned v) { return __hip_atomic_fetch_add(p, v, __ATOMIC_RELAXED, __HIP_MEMORY_SCOPE_AGENT); }
__device__ __forceinline__ unsigned xb_xcc_id() { return (unsigned)__builtin_amdgcn_s_getreg((3 << 11) | 20) & 0xFu; }
#define XB_SPIN(cond, bar) do { unsigned _sp = 0; while (cond) { __builtin_amdgcn_s_sleep(1); \
    if ((++_sp & 255u) == 0u) { if (xb_ld(&(bar)[XB_TMO])) break; if (_sp > XB_SPIN_CAP) { atomicAdd(&(bar)[XB_TMO], 1u); break; } } } } while (0)

struct XcdBarrier {
    unsigned* bar; unsigned x;
    volatile LAS unsigned* st;
};

__device__ __forceinline__ XcdBarrier xcd_barrier_post(unsigned* bar, volatile LAS unsigned* st) {
    XcdBarrier b; b.bar = bar; b.x = xb_xcc_id(); b.st = st;
    if (threadIdx.x == 0) (void)xb_add(&bar[XB_XCNT(b.x)], 1u);
    return b;
}
__device__ __forceinline__ void xcd_barrier_complete(unsigned* bar, unsigned x, unsigned& nloc, unsigned& nx) {
    const unsigned G = gridDim.x * gridDim.y * gridDim.z;
    unsigned sum, cnt, mine, sp = 0u;
    for (;;) {
        sum = 0u; cnt = 0u; mine = 0u;
#pragma unroll
        for (unsigned j = 0; j < 16; ++j) { const unsigned c = xb_ld(&bar[XB_XCNT(j)]); sum += c; cnt += (c > 0u) ? 1u : 0u; mine = (j == x) ? c : mine; }
        if (sum == G) break;
        __builtin_amdgcn_s_sleep(1);
        if ((++sp & 255u) == 0u) { if (xb_ld(&bar[XB_TMO])) break; if (sp > XB_SPIN_CAP) { atomicAdd(&bar[XB_TMO], 1u); break; } }
    }
    nloc = mine > 0u ? mine : 1u; nx = cnt > 0u ? cnt : 1u;
}

__device__ __forceinline__ void xcd_barrier(const XcdBarrier& b) {
    asm volatile("s_waitcnt vmcnt(0)" ::: "memory");
    __syncthreads();
    if (threadIdx.x == 0) {
        unsigned* bar = b.bar;
        __builtin_amdgcn_s_waitcnt(0);
        unsigned nloc = b.st[0], nx = b.st[1];
        if (nloc == 0u) { xcd_barrier_complete(bar, b.x, nloc, nx); b.st[0] = nloc; b.st[1] = nx; }
        const unsigned old = xb_add(&bar[XB_XSUB(b.x)], 1u);
        const unsigned gen = old / nloc;
        if (old + 1u == (gen + 1u) * nloc) {
            __builtin_amdgcn_fence(__ATOMIC_RELEASE, "agent");
            asm volatile("s_waitcnt vmcnt(0)" ::: "memory");
            const unsigned og = xb_add(&bar[XB_TOP], 1u);
            const unsigned tg = og / nx;
            if (og + 1u == (tg + 1u) * nx) xb_add(&bar[XB_TOPGEN], 1u);
            else XB_SPIN(xb_ld(&bar[XB_TOPGEN]) == tg, bar);
            __builtin_amdgcn_fence(__ATOMIC_ACQUIRE, "agent");
            xb_add(&bar[XB_XGEN(b.x)], 1u);
            asm volatile("s_waitcnt vmcnt(0)" ::: "memory");
        } else {
            XB_SPIN(xb_ld(&bar[XB_XGEN(b.x)]) == gen, bar);
            __builtin_amdgcn_fence(__ATOMIC_ACQUIRE, "agent");
            asm volatile("s_waitcnt vmcnt(0)" ::: "memory");
        }
    }
    __syncthreads();
}
__device__ __forceinline__ float wave_sum(float v) {
#pragma unroll
    for (int o = 1; o < 64; o <<= 1) v += __shfl_xor(v, o);
    return v;
}
__device__ __forceinline__ void p0_transpose_item(const float* W, int K, int N, bf16* WT, int row_off, LAS float* scr, int item, int lane) {
    const int nblk = N / 32, kb = item / nblk, nb = item % nblk, k0 = 64 * kb, n0 = 32 * nb;
#pragma unroll 8
    for (int i = 0; i < 32; ++i) { const int kk = 2 * i + (lane >> 5); scr[kk * 33 + (lane & 31)] = W[(size_t)(k0 + kk) * N + n0 + (lane & 31)]; }
    LDS_WAIT(); asm volatile("" ::: "memory");
    const int c = lane & 7;
#pragma unroll
    for (int j = 0; j < 4; ++j) { const int n = (lane >> 3) + 8 * j; const LAS float* s = scr + (8 * c) * 33 + n;
        v4u o; o.x = pk2(s[0 * 33], s[1 * 33]); o.y = pk2(s[2 * 33], s[3 * 33]); o.z = pk2(s[4 * 33], s[5 * 33]); o.w = pk2(s[6 * 33], s[7 * 33]);
        *(GAS v4u*)(WT + (size_t)(row_off + n0 + n) * K + k0 + 8 * c) = o; }
    LDS_WAIT(); asm volatile("" ::: "memory");
}

constexpr int NWAVES = 8;
constexpr int DM = 4096, SEQ = 4096, NTOKP = 8192, NTOKS = 1024, MTOT = 9216, NCOND = 130;
constexpr int NIN = 8704, DFF = 11008, NGU = 22016, NMOD = 24576, DCONV = 2048;
constexpr int COL_K = 2048, COL_V = 2304, COL_B = 2560, COL_C = 4608, COL_HC = 6656;
constexpr float RMS_EPS = 1e-5f;
constexpr float LOG2E = 1.4426950408889634f;
constexpr size_t O_Y = 0, O_KP = 37748736, O_VP = O_KP + 65536, O_CP = O_VP + 65536, O_FP = O_CP + 8192, O_KS = O_FP + 44032, O_VS = O_KS + 4194304,
                 O_CS = O_VS + 4194304, O_FS = O_CS + 524288, O_END = O_FS + 2818048;
static_assert(O_END == 49662976, "d_out map");
constexpr size_t MiB = 1u << 20;
constexpr size_t WS_CTL = 0, CTL_ZERO_BYTES = 1 * MiB;
constexpr size_t WS_SC = 2 * MiB, WS_MOD = 4 * MiB, WS_WIN = 32 * MiB, WS_WOUT = 100 * MiB, WS_WGU = 132 * MiB, WS_WDN = 304 * MiB, WS_WMOD = 390 * MiB,
                 WS_H = 582 * MiB, WS_PROJ = 654 * MiB, WS_MIX = 807 * MiB, WS_X1 = 879 * MiB, WS_GU = 1023 * MiB, WS_END = 1410 * MiB, WS_ACT = 390 * MiB;
static_assert(WS_WIN + (size_t)NIN * DM * 2 <= WS_WOUT && WS_WGU + (size_t)NGU * DM * 2 <= WS_WDN && WS_WDN + (size_t)DM * DFF * 2 <= WS_WMOD && WS_WMOD + (size_t)NMOD * DM * 2 <= WS_H &&
              WS_H + (size_t)MTOT * DM * 2 <= WS_PROJ && WS_PROJ + (size_t)MTOT * NIN * 2 <= WS_MIX && WS_MIX + (size_t)MTOT * DM * 2 <= WS_X1 && WS_X1 + (size_t)MTOT * DM * 4 <= WS_GU &&
              WS_GU + (size_t)MTOT * NGU * 2 <= WS_END && WS_ACT + (size_t)MTOT * DFF * 2 <= WS_PROJ && WS_MOD + (size_t)256 * NMOD * 4 <= WS_WIN, "d_ws map");
constexpr int CW_BAR = 4096;
constexpr int RING_OFF = 0, RING_BYTES = 131072;
constexpr int LDSCTL_OFF = RING_BYTES, MISC_OFF = LDSCTL_OFF + 320;
constexpr int LDS_BYTES = 147456;

typedef float f32x16 __attribute__((ext_vector_type(16)));
typedef float f32x2_t __attribute__((ext_vector_type(2)));
typedef __bf16 bf16x2_t __attribute__((ext_vector_type(2)));
typedef short s16x4 __attribute__((ext_vector_type(4)));
#define DI __device__ __forceinline__
DI unsigned cvtpk(float lo, float hi) { f32x2_t v = {lo, hi}; bf16x2_t b = __builtin_convertvector(v, bf16x2_t); return __builtin_bit_cast(unsigned, b); }
DI float bf_lo(unsigned w) { return __uint_as_float(w << 16); }
DI float bf_hi(unsigned w) { return __uint_as_float(w & 0xffff0000u); }
DI void unpack8(const v4u w, float (&f)[8]) { f[0] = bf_lo(w.x); f[1] = bf_hi(w.x); f[2] = bf_lo(w.y); f[3] = bf_hi(w.y); f[4] = bf_lo(w.z); f[5] = bf_hi(w.z); f[6] = bf_lo(w.w); f[7] = bf_hi(w.w); }
DI v4u pack8(const float (&f)[8]) { v4u w; w.x = cvtpk(f[0], f[1]); w.y = cvtpk(f[2], f[3]); w.z = cvtpk(f[4], f[5]); w.w = cvtpk(f[6], f[7]); return w; }
DI float silu_f(float x) { return x / (1.0f + __expf(-x)); }

struct Frame {
    LAS unsigned char* lds;
    volatile LAS unsigned* MISC;
    gu32* ctl;
    int tid, lane, wave, vcu, G;
};
struct Args { const float* in[20]; float* out; unsigned char* ws; int ph_lo, ph_hi, li, pad; };

DI void p0_prologue(Frame& F, const Args& a) {
    LAS float* scr = (LAS float*)(F.lds + RING_OFF + F.wave * 16384);
    const int gw = F.vcu * NWAVES + F.wave, NGW = F.G * NWAVES;
    unsigned char* ws = a.ws;
    constexpr int I_MOD = (DM / 64) * (NMOD / 32), I_IN = (DM / 64) * (NIN / 32), I_OUT = (DM / 64) * (DM / 32), I_GU = (DM / 64) * (NGU / 32), I_DN = (DFF / 64) * (DM / 32);
    constexpr int NITEMS = I_MOD + I_IN + I_OUT + I_GU + I_DN;
    for (int it = gw; it < NITEMS; it += NGW) {
        int r = it;
        if (r < I_MOD) { p0_transpose_item(a.in[8], DM, NMOD, (bf16*)(ws + WS_WMOD), 0, scr, r, F.lane); continue; } r -= I_MOD;
        if (r < I_IN) { p0_transpose_item(a.in[12], DM, NIN, (bf16*)(ws + WS_WIN), 0, scr, r, F.lane); continue; } r -= I_IN;
        if (r < I_OUT) { p0_transpose_item(a.in[15], DM, DM, (bf16*)(ws + WS_WOUT), 0, scr, r, F.lane); continue; } r -= I_OUT;
        if (r < I_GU) { p0_transpose_item(a.in[16], DM, NGU, (bf16*)(ws + WS_WGU), 0, scr, r, F.lane); continue; } r -= I_GU;
        p0_transpose_item(a.in[18], DFF, DM, (bf16*)(ws + WS_WDN), 0, scr, r, F.lane);
    }
    bf16* SC = (bf16*)(ws + WS_SC);
    for (int m = gw; m < 256; m += NGW) {
        const float* crow_ = m < 2 ? a.in[6] + (size_t)m * DM : a.in[7] + (size_t)(m - 2) * DM;
        GAS unsigned long long* o8 = (GAS unsigned long long*)(SC + (size_t)m * DM) + F.lane;
#pragma unroll 4
        for (int j = 0; j < 16; ++j) {
            unsigned long long w = 0ull;
            if (m < NCOND) { const f32x4 v = ((const GAS f32x4*)crow_)[F.lane + 64 * j]; w = (unsigned long long)cvtpk(silu_f(v.x), silu_f(v.y)) | ((unsigned long long)cvtpk(silu_f(v.z), silu_f(v.w)) << 32); }
            o8[64 * j] = w;
        }
    }
}

DI void norm_row_bf16(const float* xrow, const float* g, const float* shift, const float* scale, bf16* orow, int lane) {
    const GAS f32x4* xr = (const GAS f32x4*)xrow + lane;
    f32x4 v[16]; float s = 0.f;
#pragma unroll
    for (int j = 0; j < 16; ++j) { v[j] = xr[64 * j]; s += (v[j].x * v[j].x + v[j].y * v[j].y) + (v[j].z * v[j].z + v[j].w * v[j].w); }
    const float rstd = 1.0f / sqrtf(wave_sum(s) * (1.0f / DM) + RMS_EPS);
    GAS unsigned long long* o8 = (GAS unsigned long long*)orow + lane;
#pragma unroll
    for (int j = 0; j < 16; ++j) {
        const f32x4 gg = ((const GAS f32x4*)g)[lane + 64 * j], sc = ((const GAS f32x4*)scale)[lane + 64 * j], sh = ((const GAS f32x4*)shift)[lane + 64 * j];
        const f32x4 o = (v[j] * rstd) * gg * (sc + 1.0f) + sh;
        o8[64 * j] = (unsigned long long)cvtpk(o.x, o.y) | ((unsigned long long)cvtpk(o.z, o.w) << 32);
    }
}
DI int cond_of_row(int row) { return row < NTOKP ? (row >> 12) : 2 + ((row - NTOKP) >> 3); }
DI void norm_row_f32_inplace(float* xrow, const float* g, int lane) {
    GAS f32x4* xr = (GAS f32x4*)xrow + lane;
    f32x4 v[16]; float s = 0.f;
#pragma unroll
    for (int j = 0; j < 16; ++j) { v[j] = xr[64 * j]; s += (v[j].x * v[j].x + v[j].y * v[j].y) + (v[j].z * v[j].z + v[j].w * v[j].w); }
    const float rstd = 1.0f / sqrtf(wave_sum(s) * (1.0f / DM) + RMS_EPS);
#pragma unroll
    for (int j = 0; j < 16; ++j) { const f32x4 gg = ((const GAS f32x4*)g)[lane + 64 * j]; xr[64 * j] = (v[j] * rstd) * gg; }
}

namespace att {
constexpr int KROW = 72, VROW = 260;
constexpr int VT_OFF = 256 * KROW * 2;
constexpr float C2 = 0.125f * LOG2E;
DI int crow(int i, int h) { return (i & 3) + 8 * (i >> 2) + 4 * h; }
#define ATT_MFMA(a, b, c) __builtin_amdgcn_mfma_f32_32x32x16_bf16((a), (b), (c), 0, 0, 0)
DI void softmax5(f32x16 (&sc)[5], int kb0, int jmin, int jmax, float sink2, int h, bf16x8 (&pf)[5][2]) {
    float mx = -INFINITY;
#pragma unroll
    for (int b = 0; b < 5; ++b)
#pragma unroll
        for (int i = 0; i < 16; ++i) { const int j = 32 * (kb0 + b) + crow(i, h); const float v = (j >= jmin && j <= jmax) ? sc[b][i] * C2 : -INFINITY; sc[b][i] = v; mx = fmaxf(mx, v); }
    mx = fmaxf(mx, __shfl_xor(mx, 32)); mx = fmaxf(mx, sink2);
    float sum = 0.f;
#pragma unroll
    for (int b = 0; b < 5; ++b)
#pragma unroll
        for (int i = 0; i < 16; ++i) { const float p = __builtin_amdgcn_exp2f(sc[b][i] - mx); sc[b][i] = p; sum += p; }
    sum += __shfl_xor(sum, 32); sum += __builtin_amdgcn_exp2f(sink2 - mx);
    const float inv = 1.0f / sum;
#pragma unroll
    for (int b = 0; b < 5; ++b)
#pragma unroll
        for (int s = 0; s < 2; ++s) { v4u w; w.x = cvtpk(sc[b][8 * s] * inv, sc[b][8 * s + 1] * inv); w.y = cvtpk(sc[b][8 * s + 2] * inv, sc[b][8 * s + 3] * inv);
            w.z = cvtpk(sc[b][8 * s + 4] * inv, sc[b][8 * s + 5] * inv); w.w = cvtpk(sc[b][8 * s + 6] * inv, sc[b][8 * s + 7] * inv); pf[b][s] = __builtin_bit_cast(bf16x8, w); }
}
DI void store_o(const f32x16& o, bf16* orow, int dblk, int h) {
#pragma unroll
    for (int g = 0; g < 4; ++g) { const unsigned long long w = (unsigned long long)cvtpk(o[4 * g], o[4 * g + 1]) | ((unsigned long long)cvtpk(o[4 * g + 2], o[4 * g + 3]) << 32);
        *(GAS unsigned long long*)(orow + 32 * dblk + 8 * g + 4 * h) = w; }
}
DI void prompt_unit(LAS unsigned char* lds, const bf16* PROJ, bf16* MIX, const float* sinks, int n, int blk, int kv, int tid) {
    const int lane = tid & 63, w = __builtin_amdgcn_readfirstlane(tid >> 6), r = lane & 31, h = lane >> 5;
    LAS bf16* Kl = (LAS bf16*)lds; LAS bf16* Vt = (LAS bf16*)(lds + VT_OFF);
#pragma unroll
    for (int i = 0; i < 4; ++i) {
        const int c = tid + 512 * i, key = c >> 3, ch = c & 7, kpos = blk * 128 - 128 + key;
        v4u kvv = (v4u){0u, 0u, 0u, 0u}, vvv = (v4u){0u, 0u, 0u, 0u};
        if (kpos >= 0) { const bf16* src = PROJ + (size_t)(n * SEQ + kpos) * NIN + kv * 64 + ch * 8; kvv = *(const GAS v4u*)(src + COL_K); vvv = *(const GAS v4u*)(src + COL_V); }
        *(LAS v4u*)(Kl + key * KROW + ch * 8) = kvv;
        LAS bf16* vd = Vt + (ch * 8) * VROW + key;
        vd[0 * VROW] = (bf16)(vvv.x & 0xffffu); vd[1 * VROW] = (bf16)(vvv.x >> 16); vd[2 * VROW] = (bf16)(vvv.y & 0xffffu); vd[3 * VROW] = (bf16)(vvv.y >> 16);
        vd[4 * VROW] = (bf16)(vvv.z & 0xffffu); vd[5 * VROW] = (bf16)(vvv.z >> 16); vd[6 * VROW] = (bf16)(vvv.w & 0xffffu); vd[7 * VROW] = (bf16)(vvv.w >> 16);
    }
    __syncthreads();
    const int hq = kv * 8 + w; const float sink2 = sinks[hq] * LOG2E;
    const f32x16 zero = {};
    for (int c = 0; c < 4; ++c) {
        const int qi = 32 * c + r; const size_t qrow = (size_t)(n * SEQ + blk * 128 + qi);
        bf16x8 qf[4];
#pragma unroll
        for (int d0 = 0; d0 < 4; ++d0) qf[d0] = *(const GAS bf16x8*)(PROJ + qrow * NIN + hq * 64 + 16 * d0 + 8 * h);
        f32x16 sc[5];
#pragma unroll
        for (int b = 0; b < 5; ++b) {
            const LAS bf16* kp = Kl + ((c + b) * 32 + r) * KROW + 8 * h;
#pragma unroll
            for (int d0 = 0; d0 < 4; ++d0) { const bf16x8 a = *(const LAS bf16x8*)(kp + 16 * d0); sc[b] = ATT_MFMA(a, qf[d0], d0 == 0 ? zero : sc[b]); }
        }
        const int jmin = (blk == 0 && qi < 128) ? 128 : qi, jmax = qi + 128;
        bf16x8 pf[5][2];
        softmax5(sc, c, jmin, jmax, sink2, h, pf);
        bf16* orow = MIX + qrow * DM + hq * 64;
#pragma unroll
        for (int dblk = 0; dblk < 2; ++dblk) {
            f32x16 o = zero;
#pragma unroll
            for (int b = 0; b < 5; ++b)
#pragma unroll
                for (int s = 0; s < 2; ++s) {
                    const LAS bf16* vp = Vt + (dblk * 32 + r) * VROW + (c + b) * 32 + 16 * s + 4 * h;
                    const s16x4 lo = *(const LAS s16x4*)vp, hi = *(const LAS s16x4*)(vp + 8);
                    const bf16x8 a = __builtin_shufflevector(lo, hi, 0, 1, 2, 3, 4, 5, 6, 7);
                    o = ATT_MFMA(a, pf[b][s], o);
                }
            store_o(o, orow, dblk, h);
        }
    }
    __syncthreads();
}
DI void sample_chunk(const bf16* PROJ, const float* ck, const float* cv, bf16* MIX, const float* sinks, int s, int kv, int c, int lane) {
    const int r = lane & 31, h = lane >> 5, rho = 32 * c + r, g = rho >> 3, t = rho & 7, hq = kv * 8 + g;
    const size_t qrow = (size_t)(NTOKP + s * 8 + t);
    const float sink2 = sinks[hq] * LOG2E;
    const f32x16 zero = {};
    bf16x8 qf[4];
#pragma unroll
    for (int d0 = 0; d0 < 4; ++d0) qf[d0] = *(const GAS bf16x8*)(PROJ + qrow * NIN + hq * 64 + 16 * d0 + 8 * h);
    f32x16 sc[5];
#pragma unroll
    for (int b = 0; b < 4; ++b) {
        const float* kp = ck + ((size_t)(s * 128 + 32 * b + r) * 4 + kv) * 64 + 8 * h;
#pragma unroll
        for (int d0 = 0; d0 < 4; ++d0) { const f32x4 x0 = *(const GAS f32x4*)(kp + 16 * d0), x1 = *(const GAS f32x4*)(kp + 16 * d0 + 4);
            v4u wv; wv.x = cvtpk(x0.x, x0.y); wv.y = cvtpk(x0.z, x0.w); wv.z = cvtpk(x1.x, x1.y); wv.w = cvtpk(x1.z, x1.w);
            sc[b] = ATT_MFMA(__builtin_bit_cast(bf16x8, wv), qf[d0], d0 == 0 ? zero : sc[b]); }
    }
    {
        const bf16* kp = PROJ + (size_t)(NTOKP + s * 8 + (r & 7)) * NIN + COL_K + kv * 64 + 8 * h;
#pragma unroll
        for (int d0 = 0; d0 < 4; ++d0) { v4u wv = *(const GAS v4u*)(kp + 16 * d0); if (r >= 8) wv = (v4u){0u, 0u, 0u, 0u};
            sc[4] = ATT_MFMA(__builtin_bit_cast(bf16x8, wv), qf[d0], d0 == 0 ? zero : sc[4]); }
    }
    bf16x8 pf[5][2];
    softmax5(sc, 0, t, 128 + t, sink2, h, pf);
    bf16* orow = MIX + qrow * DM + hq * 64;
#pragma unroll
    for (int dblk = 0; dblk < 2; ++dblk) {
        f32x16 o = zero;
#pragma unroll
        for (int b = 0; b < 4; ++b)
#pragma unroll
            for (int ss = 0; ss < 2; ++ss) {
                const float* vp = cv + ((size_t)(s * 128 + 32 * b + 16 * ss + 4 * h) * 4 + kv) * 64 + dblk * 32 + r;
                v4u wv; wv.x = cvtpk(vp[0 * 256], vp[1 * 256]); wv.y = cvtpk(vp[2 * 256], vp[3 * 256]); wv.z = cvtpk(vp[8 * 256], vp[9 * 256]); wv.w = cvtpk(vp[10 * 256], vp[11 * 256]);
                o = ATT_MFMA(__builtin_bit_cast(bf16x8, wv), pf[b][ss], o);
            }
        {
            const bf16* vp = PROJ + (size_t)(NTOKP + s * 8 + 4 * h) * NIN + COL_V + kv * 64 + dblk * 32 + r;
            v4u wv; wv.x = (unsigned)vp[0] | ((unsigned)vp[NIN] << 16); wv.y = (unsigned)vp[2 * NIN] | ((unsigned)vp[3 * NIN] << 16); wv.z = 0u; wv.w = 0u;
            o = ATT_MFMA(__builtin_bit_cast(bf16x8, wv), pf[4][0], o);
        }
        store_o(o, orow, dblk, h);
    }
}
}

DI void conv_item(const Args& a, const bf16* PROJ, bf16* MIX, int rc, int cg, int lane) {
    const int row0 = rc * 8, ch = cg * 512 + lane * 8;
    const float* cw = a.in[13];
    float w0[8], w1[8], w2[8], p2[8], p1[8];
#pragma unroll
    for (int e = 0; e < 8; ++e) { w0[e] = cw[ch + e]; w1[e] = cw[DCONV + ch + e]; w2[e] = cw[2 * DCONV + ch + e]; }
    const bool samp = row0 >= NTOKP; const int seq = (row0 - NTOKP) >> 3;
    if (samp) {
        const float* sp = a.in[4] + (size_t)seq * 2 * DCONV + ch;
#pragma unroll
        for (int e = 0; e < 8; ++e) { p2[e] = sp[e]; p1[e] = sp[DCONV + e]; }
    } else if ((row0 & (SEQ - 1)) == 0) {
#pragma unroll
        for (int e = 0; e < 8; ++e) { p2[e] = 0.f; p1[e] = 0.f; }
    } else {
        const bf16* pr = PROJ + (size_t)(row0 - 2) * NIN + ch;
        float c_[8], h_[8];
        unpack8(*(const GAS v4u*)(pr + COL_C), c_); unpack8(*(const GAS v4u*)(pr + COL_HC), h_);
#pragma unroll
        for (int e = 0; e < 8; ++e) p2[e] = c_[e] * h_[e];
        unpack8(*(const GAS v4u*)(pr + NIN + COL_C), c_); unpack8(*(const GAS v4u*)(pr + NIN + COL_HC), h_);
#pragma unroll
        for (int e = 0; e < 8; ++e) p1[e] = c_[e] * h_[e];
    }
#pragma unroll
    for (int i = 0; i < 8; ++i) {
        const bf16* pr = PROJ + (size_t)(row0 + i) * NIN + ch;
        float b_[8], c_[8], h_[8], o_[8];
        unpack8(*(const GAS v4u*)(pr + COL_B), b_); unpack8(*(const GAS v4u*)(pr + COL_C), c_); unpack8(*(const GAS v4u*)(pr + COL_HC), h_);
#pragma unroll
        for (int e = 0; e < 8; ++e) { const float u = c_[e] * h_[e]; o_[e] = b_[e] * (w0[e] * p2[e] + w1[e] * p1[e] + w2[e] * u); p2[e] = p1[e]; p1[e] = u; }
        *(GAS v4u*)(MIX + (size_t)(row0 + i) * DM + DCONV + ch) = pack8(o_);
    }
    float* so = nullptr;
    if (samp) so = a.out + O_CS + (size_t)seq * 2 * DCONV + ch;
    else if (((row0 + 8) & (SEQ - 1)) == 0) so = a.out + O_CP + (size_t)(row0 >> 12) * 2 * DCONV + ch;
    if (so) {
        *(GAS f32x4*)(so) = (f32x4){p2[0], p2[1], p2[2], p2[3]}; *(GAS f32x4*)(so + 4) = (f32x4){p2[4], p2[5], p2[6], p2[7]};
        *(GAS f32x4*)(so + DCONV) = (f32x4){p1[0], p1[1], p1[2], p1[3]}; *(GAS f32x4*)(so + DCONV + 4) = (f32x4){p1[4], p1[5], p1[6], p1[7]};
    }
}
DI void kvstate_item(const Args& a, const bf16* PROJ, int it, int lane) {
    const float* src_f = nullptr; const bf16* src_b = nullptr; float* dst;
    if (it < 512) {
        const int tsr = it >> 8, n = (it >> 7) & 1, i = it & 127;
        src_b = PROJ + (size_t)(n * SEQ + SEQ - 128 + i) * NIN + (tsr ? COL_V : COL_K);
        dst = a.out + (tsr ? O_VP : O_KP) + (size_t)(n * 128 + i) * 256;
    } else {
        const int j = it - 512, tsr = j >> 14, s = (j >> 7) & 127, i = j & 127;
        dst = a.out + (tsr ? O_VS : O_KS) + (size_t)(s * 128 + i) * 256;
        if (i < 120) src_f = (tsr ? a.in[3] : a.in[2]) + (size_t)(s * 128 + i + 8) * 256;
        else src_b = PROJ + (size_t)(NTOKP + s * 8 + (i - 120)) * NIN + (tsr ? COL_V : COL_K);
    }
    f32x4 v;
    if (src_f) v = ((const GAS f32x4*)src_f)[lane];
    else { const unsigned long long w = ((const GAS unsigned long long*)src_b)[lane]; v = (f32x4){bf_lo((unsigned)w), bf_hi((unsigned)w), bf_lo((unsigned)(w >> 32)), bf_hi((unsigned)(w >> 32))}; }
    ((GAS f32x4*)dst)[lane] = v;
}
DI void act_item(const Args& a, const bf16* GU, bf16* ACT, int rc, int cg, int lane) {
    const int row0 = rc * 8, ch = cg * 512 + lane * 8;
    if (ch >= DFF) return;
    const float* cw = a.in[17];
    float w0[8], w1[8], w2[8], p2[8], p1[8];
#pragma unroll
    for (int e = 0; e < 8; ++e) { w0[e] = cw[ch + e]; w1[e] = cw[DFF + ch + e]; w2[e] = cw[2 * DFF + ch + e]; }
    const bool samp = row0 >= NTOKP; const int seq = (row0 - NTOKP) >> 3;
    if (samp) {
        const float* sp = a.in[5] + (size_t)seq * 2 * DFF + ch;
#pragma unroll
        for (int e = 0; e < 8; ++e) { p2[e] = sp[e]; p1[e] = sp[DFF + e]; }
    } else if ((row0 & (SEQ - 1)) == 0) {
#pragma unroll
        for (int e = 0; e < 8; ++e) { p2[e] = 0.f; p1[e] = 0.f; }
    } else {
        const bf16* pr = GU + (size_t)(row0 - 2) * NGU + ch;
        unpack8(*(const GAS v4u*)(pr), p2); unpack8(*(const GAS v4u*)(pr + NGU), p1);
    }
#pragma unroll
    for (int i = 0; i < 8; ++i) {
        const bf16* pr = GU + (size_t)(row0 + i) * NGU + ch;
        float g_[8], u_[8], o_[8];
        unpack8(*(const GAS v4u*)(pr), g_); unpack8(*(const GAS v4u*)(pr + DFF), u_);
#pragma unroll
        for (int e = 0; e < 8; ++e) { const float gc = w0[e] * p2[e] + w1[e] * p1[e] + w2[e] * g_[e]; o_[e] = silu_f(gc) * u_[e]; p2[e] = p1[e]; p1[e] = g_[e]; }
        *(GAS v4u*)(ACT + (size_t)(row0 + i) * DFF + ch) = pack8(o_);
    }
    float* so = nullptr;
    if (samp) so = a.out + O_FS + (size_t)seq * 2 * DFF + ch;
    else if (((row0 + 8) & (SEQ - 1)) == 0) so = a.out + O_FP + (size_t)(row0 >> 12) * 2 * DFF + ch;
    if (so) {
        *(GAS f32x4*)(so) = (f32x4){p2[0], p2[1], p2[2], p2[3]}; *(GAS f32x4*)(so + 4) = (f32x4){p2[4], p2[5], p2[6], p2[7]};
        *(GAS f32x4*)(so + DFF) = (f32x4){p1[0], p1[1], p1[2], p1[3]}; *(GAS f32x4*)(so + DFF + 4) = (f32x4){p1[4], p1[5], p1[6], p1[7]};
    }
}

#ifndef MK_PER_PHASE
#define MK_PER_PHASE 0
#endif
constexpr int NPHASE = 11;
__global__ void __launch_bounds__(NWAVES * 64, 2) mega_fwd(Args args) {
    extern __shared__ __attribute__((aligned(16))) unsigned char lds[];
    Frame F;
    F.lds = (LAS unsigned char*)lds;
    F.MISC = (volatile LAS unsigned*)(F.lds + MISC_OFF);
    F.tid = threadIdx.x; F.lane = F.tid & 63; F.wave = __builtin_amdgcn_readfirstlane(F.tid >> 6);
    F.G = gridDim.x; { const int bx = blockIdx.x; F.vcu = (F.G % 8 == 0) ? (bx % 8) * (F.G / 8) + bx / 8 : bx; }
    unsigned char* ws = args.ws;
    F.ctl = (gu32*)(ws + WS_CTL);
    for (int u = F.tid; u < (LDS_BYTES - LDSCTL_OFF) / 4; u += NWAVES * 64) ((LAS unsigned*)(F.lds + LDSCTL_OFF))[u] = 0u;
    __syncthreads();
    XcdBarrier bar; bar.bar = (unsigned*)(F.ctl + CW_BAR); bar.x = 0; bar.st = nullptr;
    if (!MK_PER_PHASE) bar = xcd_barrier_post((unsigned*)(F.ctl + CW_BAR), F.MISC + 8);
#define GRID_BAR() do { if (!MK_PER_PHASE) xcd_barrier(bar); } while (0)
    const int lo = args.ph_lo, hi = args.ph_hi;
#define IN(k) (lo <= (k) && (k) < hi)
#define BOTH(k) (IN(k) && IN((k) + 1))
    const int gw = F.vcu * NWAVES + F.wave, NGW = F.G * NWAVES;
    bf16* const SC = (bf16*)(ws + WS_SC); float* const MOD = (float*)(ws + WS_MOD);
    bf16* const H = (bf16*)(ws + WS_H); bf16* const PROJ = (bf16*)(ws + WS_PROJ); bf16* const MIX = (bf16*)(ws + WS_MIX);
    float* const X1 = (float*)(ws + WS_X1); bf16* const GU = (bf16*)(ws + WS_GU); bf16* const ACT = (bf16*)(ws + WS_ACT);

    if (IN(0)) { p0_prologue(F, args); if (BOTH(0)) GRID_BAR(); }
    if (IN(1)) {
        pg8::Gemm g{SC, (const bf16*)(ws + WS_WMOD), 256, NMOD, DM}; pg8::StaticOrder S; S.init(256, NMOD, F.G, (int)blockIdx.x);
        pg8::EpiF32 E{MOD, NMOD, args.in[9]};
        pg8::gemm_phase<pg8::EpiF32, pg8::StaticOrder, true, true>(F.lds + RING_OFF, g, S, E);
        if (BOTH(1)) GRID_BAR();
    }
    if (IN(2)) {
        for (int m = gw; m < MTOT; m += NGW) {
            const float* xrow = m < NTOKP ? args.in[0] + (size_t)m * DM : args.in[1] + (size_t)(m - NTOKP) * DM;
            const float* mod = MOD + (size_t)cond_of_row(m) * NMOD;
            norm_row_bf16(xrow, args.in[10], mod + 0 * DM, mod + 1 * DM, H + (size_t)m * DM, F.lane);
        }
        if (BOTH(2)) GRID_BAR();
    }
    if (IN(3)) {
        pg8::Gemm g{H, (const bf16*)(ws + WS_WIN), MTOT, NIN, DM}; pg8::StaticOrder S; S.init(MTOT, NIN, F.G, (int)blockIdx.x);
        pg8::EpiBf16<0> E{PROJ, NIN, nullptr, 0, 0, 1.f};
        pg8::gemm_phase<pg8::EpiBf16<0>, pg8::StaticOrder, true, true>(F.lds + RING_OFF, g, S, E);
        if (BOTH(3)) GRID_BAR();
    }
    if (IN(4)) {
        for (int u = (int)blockIdx.x; u < 256; u += F.G) att::prompt_unit(F.lds + RING_OFF, PROJ, MIX, args.in[14], u >> 7, (u >> 2) & 31, u & 3, F.tid);
        for (int it = gw; it < 1024; it += NGW) att::sample_chunk(PROJ, args.in[2], args.in[3], MIX, args.in[14], it >> 3, (it >> 1) & 3, it & 1, F.lane);
        for (int it = gw; it < 1152 * 4; it += NGW) conv_item(args, PROJ, MIX, it >> 2, it & 3, F.lane);
        for (int it = gw; it < 33280; it += NGW) kvstate_item(args, PROJ, it, F.lane);
        if (BOTH(4)) GRID_BAR();
    }
    if (IN(5)) {
        pg8::Gemm g{MIX, (const bf16*)(ws + WS_WOUT), MTOT, DM, DM}; pg8::StaticOrder S; S.init(MTOT, DM, F.G, (int)blockIdx.x);
        pg8::EpiResGate E{args.in[0], args.in[1], X1, MOD + 2 * DM};
        pg8::gemm_phase<pg8::EpiResGate, pg8::StaticOrder, true, true>(F.lds + RING_OFF, g, S, E);
        if (BOTH(5)) GRID_BAR();
    }
    if (IN(6)) {
        for (int m = gw; m < MTOT; m += NGW) {
            const float* mod = MOD + (size_t)cond_of_row(m) * NMOD;
            norm_row_bf16(X1 + (size_t)m * DM, args.in[11], mod + 3 * DM, mod + 4 * DM, H + (size_t)m * DM, F.lane);
        }
        if (BOTH(6)) GRID_BAR();
    }
    if (IN(7)) {
        pg8::Gemm g{H, (const bf16*)(ws + WS_WGU), MTOT, NGU, DM}; pg8::StaticOrder S; S.init(MTOT, NGU, F.G, (int)blockIdx.x);
        pg8::EpiBf16<0> E{GU, NGU, nullptr, 0, 0, 1.f};
        pg8::gemm_phase<pg8::EpiBf16<0>, pg8::StaticOrder, true, true>(F.lds + RING_OFF, g, S, E);
        if (BOTH(7)) GRID_BAR();
    }
    if (IN(8)) {
        for (int it = gw; it < 1152 * 22; it += NGW) act_item(args, GU, ACT, it / 22, it % 22, F.lane);
        if (BOTH(8)) GRID_BAR();
    }
    if (IN(9)) {
        pg8::Gemm g{ACT, (const bf16*)(ws + WS_WDN), MTOT, DM, DFF}; pg8::StaticOrder S; S.init(MTOT, DM, F.G, (int)blockIdx.x);
        pg8::EpiResGate E{X1, X1 + (size_t)NTOKP * DM, args.out + O_Y, MOD + 5 * DM};
        pg8::gemm_phase<pg8::EpiResGate, pg8::StaticOrder, true, true>(F.lds + RING_OFF, g, S, E);
        if (BOTH(9)) GRID_BAR();
    }
    if (IN(10)) {
        for (int m = gw; m < MTOT; m += NGW) norm_row_f32_inplace(args.out + O_Y + (size_t)m * DM, args.in[19], F.lane);
    }
#undef IN
#undef BOTH
#undef GRID_BAR
}

extern "C" void kernel_launch(void* const* d_in, const int* in_sizes, int n_in, void* d_out, int out_size, void* d_ws, size_t ws_size, hipStream_t stream) {
    static int grid = 0;
    if (grid == 0) {
        if (n_in != 20 || in_sizes[0] != NTOKP * DM || (size_t)out_size != O_END || ws_size < WS_END) {
            fprintf(stderr, "kernel_launch: unexpected shapes: n_in %d in0 %d out %d ws %zu (need %zu); nothing launched\n", n_in, n_in > 0 ? in_sizes[0] : -1, out_size, ws_size, (size_t)WS_END); grid = -1; return; }
        int dev = 0, cus = 0, per_cu = 0;
        if (hipGetDevice(&dev) != hipSuccess || hipDeviceGetAttribute(&cus, hipDeviceAttributeMultiprocessorCount, dev) != hipSuccess) { fprintf(stderr, "kernel_launch: device query failed\n"); grid = -1; return; }
        if (hipFuncSetAttribute((const void*)mega_fwd, hipFuncAttributeMaxDynamicSharedMemorySize, LDS_BYTES) != hipSuccess) { fprintf(stderr, "kernel_launch: hipFuncSetAttribute failed\n"); grid = -1; return; }
        if (hipOccupancyMaxActiveBlocksPerMultiprocessor(&per_cu, (const void*)mega_fwd, NWAVES * 64, LDS_BYTES) != hipSuccess || per_cu < 1)
            fprintf(stderr, "kernel_launch: note: occupancy query reports %d workgroups per CU\n", per_cu);
        (void)hipGetLastError();
        grid = cus;
    }
    if (grid < 0) return;
    if (hipMemsetAsync((char*)d_ws + WS_CTL, 0, CTL_ZERO_BYTES, stream) != hipSuccess) { fprintf(stderr, "kernel_launch: memset failed\n"); return; }
    Args a{};
    for (int i = 0; i < 20; ++i) a.in[i] = (const float*)d_in[i];
    a.out = (float*)d_out; a.ws = (unsigned char*)d_ws; a.li = 0; a.pad = 0;
#if MK_PER_PHASE
    for (int p = 0; p < NPHASE; ++p) { a.ph_lo = p; a.ph_hi = p + 1; hipLaunchKernelGGL(mega_fwd, dim3(grid), dim3(NWAVES * 64), LDS_BYTES, stream, a); }
#else
    a.ph_lo = 0; a.ph_hi = NPHASE;
    hipLaunchKernelGGL(mega_fwd, dim3(grid), dim3(NWAVES * 64), LDS_BYTES, stream, a);
#endif
    const hipError_t le = hipPeekAtLastError();
    if (le != hipSuccess) fprintf(stderr, "kernel_launch: launch failed: %s\n", hipGetErrorName(le));
}
```

```cpp
#include <hip/hip_runtime.h>
#include <hip/hip_bf16.h>
#include <cstdio>
#include <cstdint>
#include <cmath>
#define MK_PER_PHASE 0
namespace pg8 {
#define PG8_LAS __attribute__((address_space(3)))
typedef unsigned short bf16_t;
typedef short bf16x8 __attribute__((ext_vector_type(8)));
typedef float f32x4 __attribute__((ext_vector_type(4)));
typedef unsigned u32x4 __attribute__((ext_vector_type(4)));
constexpr int BM = 256, BK = 64, HALF = 128, HTB = HALF * BK * 2  , STAGE_BYTES = 8 * HTB, NXCD = 8, WGM = 8;

__host__ __device__ __forceinline__ int lds_byte(int r, int c) { const int st = (r >> 4) * 2 + (c >> 5), rr = r & 15, cc = c & 31, ob = rr * 64 + cc * 2; return st * 1024 + (ob ^ (((ob >> 9) & 1) << 5)); }
__host__ __device__ __forceinline__ void stage_rc(int b, int& R, int& C) { const int st = b / 1024, sb = b % 1024, swz = sb ^ (((sb >> 9) & 1) << 5); R = (st >> 1) * 16 + swz / 64; C = (st & 1) * 32 + (swz % 64) / 2; }
__host__ __device__ __forceinline__ int perm32(int rho) { const int n = rho >> 4, i = rho & 15; return 8 * (i >> 2) + 4 * n + (i & 3); }

struct Unit { unsigned w0, w1;
    __host__ __device__ __forceinline__ int pm() const { return (int)(w0 & 255u); } __host__ __device__ __forceinline__ int pn() const { return (int)((w0 >> 8) & 255u); }
    __host__ __device__ __forceinline__ int k0() const { return (int)((w0 >> 16) & 255u) * 128; } __host__ __device__ __forceinline__ int nt() const { return (int)(w0 >> 24) * 2; }
    __host__ __device__ __forceinline__ int ns() const { return (int)(w1 & 255u); } __host__ __device__ __forceinline__ int sp() const { return (int)((w1 >> 8) & 255u); } __host__ __device__ __forceinline__ int sid() const { return (int)((w1 >> 16) & 0x7fffu); } __host__ __device__ __forceinline__ bool f8() const { return (w1 >> 31) != 0u; }
    __host__ __device__ __forceinline__ void set(int pm_, int pn_, int k0_, int nt_, int ns_, int sp_, int sid_) { w0 = (unsigned)pm_ | ((unsigned)pn_ << 8) | ((unsigned)(k0_ >> 7) << 16) | ((unsigned)(nt_ >> 1) << 24); w1 = (unsigned)ns_ | ((unsigned)sp_ << 8) | ((unsigned)sid_ << 16); }
};
struct Gemm { const bf16_t* A; const bf16_t* Bt; int M, N, K, ld; size_t bh = 0, bt = 0; const bf16_t* A8 = nullptr; const bf16_t* B8 = nullptr; float seam = 1.0f; };

struct StaticOrder {
    int nM, nN, nwg, G, c, ntK; int pm0 = 0; int pmode = 0;
    __host__ __device__ void init(int M, int N, int K, int G_, int c_) { nM = M / BM; nN = N / BM; nwg = nM * nN; G = G_; c = c_; ntK = K / BK; }
    __host__ __device__ bool next(int i, Unit& u) const { return at((long)i * G + c, u); }
    __host__ __device__ bool at(const long L, Unit& u) const {
        if (L >= nwg) return false;
        int wgid = (int)L; { const int q = nwg / NXCD, r = nwg % NXCD, xcd = wgid % NXCD, off = wgid / NXCD; wgid = (xcd < r ? xcd * (q + 1) : r * (q + 1) + (xcd - r) * q) + off; }
        const int nig = WGM * nN, gid = wgid / nig, fm = gid * WGM, gsz = (nM - fm) < WGM ? (nM - fm) : WGM;
        int pm_ = pm0 + fm + ((wgid % nig) % gsz); if (pmode == 1) pm_ = (pm_ == 0) ? 15 : 30 + pm_; else if (pmode == 2) pm_ = (pm_ < 15) ? pm_ : pm_ + 1;
        else if (pmode == 3) pm_ = (pm_ < 15) ? pm_ : (pm_ < 30 ? pm_ + 1 : pm_ + 2); else if (pmode == 4) pm_ = 15 + 16 * pm_;
        u.set(pm_, (wgid % nig) / gsz, 0, ntK, 1, 0, 0); return true;
    }
    __device__ __forceinline__ void a_ready(const Unit&) const {}
    __device__ __forceinline__ void done(const Unit&) const {}
    __device__ __forceinline__ bool combine(f32x4 (&)[2][2][4][2], const Unit&, int, int) const { return true; }
};
struct PairOrder : StaticOrder {
    int nt8 = 16, k1 = 2048, nt16 = 32;
    __device__ __forceinline__ bool next(int i, Unit& u) const {
        if (!at((long)(i >> 1) * G + c, u)) return false;
        if ((i & 1) == 0) { u.set(u.pm(), u.pn(), 0, nt8, 1, 0, 0); u.w1 |= 0x80000000u; } else u.set(u.pm(), u.pn(), k1, nt16, 1, 0, 0);
        return true;
    }
};
struct SplitOrder : StaticOrder {
    bool ints = false;
    int S, full, rem; float* slab; unsigned* tick; PG8_LAS unsigned* wgflag = nullptr;
    __device__ __forceinline__ void init2(int M, int N, int K, int G_, int c_, int S_, float* slab_, unsigned* tick_) {
        init(M, N, K, G_, c_); full = nwg / G; rem = nwg - full * G; slab = slab_; tick = tick_;
        const int grp = (rem + 7) >> 3; S = S_; if (grp > 0 && grp * S * 8 > G) S = (G >> 3) / grp; if (S < 1 || (G & 7)) S = 1; if (S > (ntK >> 1)) S = ntK >> 1;
    }
    __device__ __forceinline__ bool next(int i, Unit& u) const {
        if (i < full) return at((long)i * G + c, u);
        if (i > full || rem == 0) return false;
        if (S == 1) return at((long)i * G + c, u);
        const int x = c & 7, y = c >> 3, jhi = y / S, s = y - jhi * S, j = jhi * 8 + x;
        if (j >= rem) return false;
        at((long)full * G + j, u);
        const int pairs = ntK >> 1, p = pairs / S, r = pairs - p * S, np = p + (s < r ? 1 : 0), p0 = s * p + (s < r ? s : r);
        u.set(u.pm(), u.pn(), p0 * 2 * BK, np * 2, S, s, j); return true;
    }
    __device__ __forceinline__ bool combine(f32x4 (&acc)[2][2][4][2], const Unit& u, int wid, int lane) const {
        float* mine = slab + ((size_t)(u.sid() * S + u.sp()) * 8 + wid) * 8192;
        const __amdgpu_buffer_rsrc_t rs = __builtin_amdgcn_make_buffer_rsrc(mine, 0, 32768, 0x00020000);
        const unsigned voff = (unsigned)lane * 16u;
#pragma unroll
        for (int ai = 0; ai < 2; ++ai)
#pragma unroll
            for (int bj = 0; bj < 2; ++bj)
#pragma unroll
                for (int m = 0; m < 4; ++m)
#pragma unroll
                    for (int n = 0; n < 2; ++n) __builtin_amdgcn_raw_buffer_store_b128(__builtin_bit_cast(u32x4, acc[ai][bj][m][n]), rs, voff, ((((ai * 2 + bj) * 4 + m) * 2 + n) * 1024),   16);
        asm volatile("s_waitcnt vmcnt(0)" ::: "memory");
        unsigned old = 0u;
        if (wgflag) {
            asm volatile("" ::: "memory"); __builtin_amdgcn_s_barrier(); asm volatile("" ::: "memory");
            if (wid == 0) { if (lane == 0) old = __hip_atomic_fetch_add(tick + (size_t)(u.sid() * 8) * 16, 1u, __ATOMIC_RELAXED, __HIP_MEMORY_SCOPE_AGENT);
                old = (unsigned)__builtin_amdgcn_readfirstlane((int)old); if (lane == 0) *wgflag = old; }
            asm volatile("s_waitcnt vmcnt(0) lgkmcnt(0)" ::: "memory"); __builtin_amdgcn_s_barrier(); asm volatile("" ::: "memory");
            old = (unsigned)__builtin_amdgcn_readfirstlane((int)*wgflag);
        } else {
            if (lane == 0) old = __hip_atomic_fetch_add(tick + (size_t)(u.sid() * 8 + wid) * 16, 1u, __ATOMIC_RELAXED, __HIP_MEMORY_SCOPE_AGENT);
            old = (unsigned)__builtin_amdgcn_readfirstlane((int)old);
        }
        if (old + 1u != (unsigned)S) { __builtin_amdgcn_s_waitcnt(0); return false; }
        __builtin_amdgcn_fence(__ATOMIC_ACQUIRE, "agent"); asm volatile("s_waitcnt vmcnt(0)" ::: "memory");
        for (int s = 0; s < S; ++s) {
            const __amdgpu_buffer_rsrc_t rr = __builtin_amdgcn_make_buffer_rsrc(slab + ((size_t)(u.sid() * S + s) * 8 + wid) * 8192, 0, 32768, 0x00020000);
#pragma unroll
            for (int ai = 0; ai < 2; ++ai) {
                f32x4 t[2][4][2];
#pragma unroll
                for (int bj = 0; bj < 2; ++bj)
#pragma unroll
                    for (int m = 0; m < 4; ++m)
#pragma unroll
                        for (int n = 0; n < 2; ++n) t[bj][m][n] = __builtin_bit_cast(f32x4, __builtin_amdgcn_raw_buffer_load_b128(rr, voff, ((((ai * 2 + bj) * 4 + m) * 2 + n) * 1024), 0));
                __builtin_amdgcn_sched_barrier(0);
#pragma unroll
                for (int bj = 0; bj < 2; ++bj)
#pragma unroll
                    for (int m = 0; m < 4; ++m)
#pragma unroll
                        for (int n = 0; n < 2; ++n) { typedef int i32x4_ __attribute__((ext_vector_type(4)));
                            acc[ai][bj][m][n] = (s == 0) ? t[bj][m][n] : (ints ? __builtin_bit_cast(f32x4, __builtin_bit_cast(i32x4_, acc[ai][bj][m][n]) + __builtin_bit_cast(i32x4_, t[bj][m][n])) : acc[ai][bj][m][n] + t[bj][m][n]); }
                __builtin_amdgcn_sched_barrier(0);
            }
        }
        __builtin_amdgcn_s_waitcnt(0);
        return true;
    }
};

__device__ __forceinline__ unsigned cvt_pk_bf16(float lo, float hi) { unsigned r; asm volatile("v_cvt_pk_bf16_f32 %0, %1, %2" : "=v"(r) : "v"(lo), "v"(hi)); return r; }
typedef float f32x2 __attribute__((ext_vector_type(2)));
__device__ __forceinline__ f32x2 gelu_pk(f32x2 v) {
    const f32x2 av = __builtin_elementwise_abs(v), d = av * 0.2316418882f + 1.0f;
    f32x2 t; t.x = __builtin_amdgcn_rcpf(d.x); t.y = __builtin_amdgcn_rcpf(d.y);
    f32x2 q = t * 0.5307027145f + (-0.7265760135f); q = q * t + 0.7107068705f; q = q * t + (-0.142248368f); q = q * t + 0.127414796f; q = q * t;
    const f32x2 s = (v * v) * (-0.72134752044f);
    f32x2 e; e.x = __builtin_amdgcn_exp2f(s.x); e.y = __builtin_amdgcn_exp2f(s.y);
    const f32x2 m = v * (q * e), r = v - m;
    f32x2 o; o.x = v.x < 0.f ? m.x : r.x; o.y = v.y < 0.f ? m.y : r.y; return o;
}

template <int ACT  > struct EpiBf16 {
    static constexpr bool PERM = true, AFTER_DRAIN = false; static_assert(ACT == 0 || ACT == 1, "EpiBf16: ACT is 0 (none) or 1 (gelu_pk)");
    bf16_t* O; int ldc; const float* bias; int split_cols; size_t split_stride; float scale0;
    __device__ __forceinline__ void operator()(const f32x4 (&acc)[2][2][4][2], const Unit& u, int wr, int wc, int fr, int fq) const {
        const int row0 = u.pm() * BM + wr * 64 + fr; int colt = u.pn() * BM; bf16_t* base = O;
        float sc = 1.f; if (split_cols) { const int t = colt / split_cols; base += (size_t)t * split_stride; colt -= t * split_cols; if (t == 0) sc = scale0; }
        const int col0 = colt + wc * 32 + 8 * fq, bcol0 = u.pn() * BM + wc * 32 + 8 * fq;
        f32x4 bv[2][2];
#pragma unroll
        for (int bj = 0; bj < 2; ++bj)
#pragma unroll
            for (int n = 0; n < 2; ++n) bv[bj][n] = bias ? *(const f32x4*)(bias + bcol0 + bj * HALF + 4 * n) : (f32x4){0.f, 0.f, 0.f, 0.f};
#pragma unroll
        for (int ai = 0; ai < 2; ++ai)
#pragma unroll
            for (int m = 0; m < 4; ++m) { bf16_t* rowp = base + (size_t)(row0 + ai * HALF + m * 16) * ldc + col0;
#pragma unroll
                for (int bj = 0; bj < 2; ++bj) { f32x4 v0 = acc[ai][bj][m][0] + bv[bj][0], v1 = acc[ai][bj][m][1] + bv[bj][1];
                    if (ACT == 1) { f32x2 a = gelu_pk((f32x2){v0[0], v0[1]}), b = gelu_pk((f32x2){v0[2], v0[3]}), c = gelu_pk((f32x2){v1[0], v1[1]}), d = gelu_pk((f32x2){v1[2], v1[3]});
                        v0 = (f32x4){a.x, a.y, b.x, b.y}; v1 = (f32x4){c.x, c.y, d.x, d.y}; }
                    v0 = v0 * sc; v1 = v1 * sc; u32x4 w; w.x = cvt_pk_bf16(v0[0], v0[1]); w.y = cvt_pk_bf16(v0[2], v0[3]); w.z = cvt_pk_bf16(v1[0], v1[1]); w.w = cvt_pk_bf16(v1[2], v1[3]);
                    *(u32x4*)(rowp + bj * HALF) = w; } }
    }
};
struct EpiF32 {
    static constexpr bool PERM = false, AFTER_DRAIN = false;
    float* C; int ldc; const float* bias;
    __device__ __forceinline__ void operator()(const f32x4 (&acc)[2][2][4][2], const Unit& u, int wr, int wc, int fr, int fq) const {
        const int row0 = u.pm() * BM + wr * 64 + fr, col0 = u.pn() * BM + wc * 32 + 4 * fq;
        f32x4 bv[2][2];
#pragma unroll
        for (int bj = 0; bj < 2; ++bj)
#pragma unroll
            for (int n = 0; n < 2; ++n) bv[bj][n] = bias ? *(const f32x4*)(bias + col0 + bj * HALF + n * 16) : (f32x4){0.f, 0.f, 0.f, 0.f};
#pragma unroll
        for (int ai = 0; ai < 2; ++ai)
#pragma unroll
            for (int m = 0; m < 4; ++m) { float* rowp = C + (size_t)(row0 + ai * HALF + m * 16) * ldc + col0;
#pragma unroll
                for (int bj = 0; bj < 2; ++bj)
#pragma unroll
                    for (int n = 0; n < 2; ++n) *(f32x4*)(rowp + bj * HALF + n * 16) = acc[ai][bj][m][n] + bv[bj][n]; }
    }
};
template <bool BASE_BF16, bool OUT_BF16> struct EpiResGate {
    static constexpr bool PERM = false, AFTER_DRAIN = false;
    const void* base_p; const void* base_s; void* out; const float* gate; float accs = 1.0f;
    __device__ __forceinline__ void ldgrp(int gi, const Unit& u, int wr, int fr, int col0, f32x4 (&b)[4], f32x4 (&g)[4]) const {
        const int ai = gi >> 2, m = gi & 3, r = u.pm() * BM + ai * HALF + wr * 64 + m * 16 + fr;
        const int cond = r < 8192 ? (r >> 12) : 2 + ((r - 8192) >> 3);
        const float* gp = gate + (size_t)cond * 24576 + col0;
        if (BASE_BF16) {
            typedef unsigned u32x2 __attribute__((ext_vector_type(2)));
            const bf16_t* bp = (r < 8192 ? (const bf16_t*)base_p + (size_t)r * 4096 : (const bf16_t*)base_s + (size_t)(r - 8192) * 4096) + col0;
#pragma unroll
            for (int q = 0; q < 4; ++q) { const u32x2 w = *(const u32x2*)(bp + (q >> 1) * HALF + (q & 1) * 16);
                b[q] = (f32x4){__uint_as_float(w.x << 16), __uint_as_float(w.x & 0xffff0000u), __uint_as_float(w.y << 16), __uint_as_float(w.y & 0xffff0000u)}; g[q] = *(const f32x4*)(gp + (q >> 1) * HALF + (q & 1) * 16); }
        } else {
            const float* bp = (r < 8192 ? (const float*)base_p + (size_t)r * 4096 : (const float*)base_s + (size_t)(r - 8192) * 4096) + col0;
#pragma unroll
            for (int q = 0; q < 4; ++q) { b[q] = *(const f32x4*)(bp + (q >> 1) * HALF + (q & 1) * 16); g[q] = *(const f32x4*)(gp + (q >> 1) * HALF + (q & 1) * 16); }
        }
        __builtin_amdgcn_sched_barrier(0);
    }
    __device__ __forceinline__ void operator()(const f32x4 (&acc)[2][2][4][2], const Unit& u, int wr, int wc, int fr, int fq) const {
        const int col0 = u.pn() * BM + wc * 32 + 4 * fq;
        f32x4 b[2][4], g[2][4];
        ldgrp(0, u, wr, fr, col0, b[0], g[0]);
#pragma unroll
        for (int gi = 0; gi < 8; ++gi) {
            if (gi + 1 < 8) ldgrp(gi + 1, u, wr, fr, col0, b[(gi + 1) & 1], g[(gi + 1) & 1]);
            const int ai = gi >> 2, m = gi & 3, r = u.pm() * BM + ai * HALF + wr * 64 + m * 16 + fr;
#pragma unroll
            for (int q = 0; q < 4; ++q) { const f32x4 o = b[gi & 1][q] + (g[gi & 1][q] * accs) * acc[ai][q >> 1][m][q & 1];
                if (OUT_BF16) { typedef unsigned u32x2 __attribute__((ext_vector_type(2))); u32x2 w; w.x = cvt_pk_bf16(o[0], o[1]); w.y = cvt_pk_bf16(o[2], o[3]);
                    *(u32x2*)((bf16_t*)out + (size_t)r * 4096 + col0 + (q >> 1) * HALF + (q & 1) * 16) = w; }
                else *(f32x4*)((float*)out + (size_t)r * 4096 + col0 + (q >> 1) * HALF + (q & 1) * 16) = o; }
            __builtin_amdgcn_sched_barrier(0);
        }
    }
};
__device__ __forceinline__ float dpp_ror1(float x) { return __builtin_bit_cast(float, __builtin_amdgcn_mov_dpp(__builtin_bit_cast(int, x), 0x121, 0xf, 0xf, true)); }
__device__ __forceinline__ float dpp_ror2(float x) { return __builtin_bit_cast(float, __builtin_amdgcn_mov_dpp(__builtin_bit_cast(int, x), 0x122, 0xf, 0xf, true)); }
__device__ __forceinline__ float dpp_shr1(float old, float x) { return __builtin_bit_cast(float, __builtin_amdgcn_update_dpp(__builtin_bit_cast(int, old), __builtin_bit_cast(int, x), 0x111, 0xf, 0xf, false)); }
__device__ __forceinline__ float dpp_shr2(float old, float x) { return __builtin_bit_cast(float, __builtin_amdgcn_update_dpp(__builtin_bit_cast(int, old), __builtin_bit_cast(int, x), 0x112, 0xf, 0xf, false)); }
constexpr float WGU_I8SCALE = 2048.0f;
constexpr float ATT_PRESCALE = 16.0f, WOUT_PRESCALE = 2048.0f;
constexpr float ACT_PRESCALE = 8.0f, WDN_PRESCALE = 4096.0f;
template <bool I8> struct EpiGateUpT {
    static constexpr bool PERM = true, AFTER_DRAIN = false;
    unsigned char* ACT; int ldact  ; const float* cw; const float* st; float* sb; float* out_fp; float* out_fs; PG8_LAS float* halo; float accs = 1.0f; const float* rowscale = nullptr;
    template <bool SAMP> __device__ __forceinline__ void body(const f32x4 (&acc)[2][2][4][2], const Unit& u, int wr, int wc, int fr, int fq) const {
        constexpr int DFF_ = 11008;
        const int pm = u.pm(), ch0 = 128 * u.pn() + 32 * wc + 8 * fq;
        PG8_LAS float* RS = halo + 1024;
        if (I8) { const int t_ = (wr * 4 + wc) * 64 + fq * 16 + fr; if (t_ < 256) RS[t_] = rowscale[pm * BM + t_] * accs; }
        auto cv = [](const f32x4& a_, float f_) -> f32x4 { if (I8) { typedef int i32x4_ __attribute__((ext_vector_type(4))); const i32x4_ i_ = __builtin_bit_cast(i32x4_, a_);
            return (f32x4){(float)i_[0] * f_, (float)i_[1] * f_, (float)i_[2] * f_, (float)i_[3] * f_}; } else return a_ * f_; };
        if (fr >= 14) {
#pragma unroll
            for (int ai = 0; ai < 2; ++ai) { PG8_LAS f32x4* hp = (PG8_LAS f32x4*)(halo + ((((ai * 2 + wr) * 4 + wc) * 2 + (fr - 14)) * 4 + fq) * 8); const float f_ = I8 ? rowscale[pm * BM + ai * HALF + wr * 64 + 48 + fr] * accs : accs; f32x4 t0_ = acc[ai][0][3][0], t1_ = acc[ai][0][3][1]; if (I8) asm volatile("" : "+v"(t0_), "+v"(t1_));
                hp[0] = cv(t0_, f_); hp[1] = cv(t1_, f_); }
        }
        f32x2 w0[4], w1[4], w2[4];
        { const f32x4 a0 = *(const f32x4*)(cw + ch0), a1 = *(const f32x4*)(cw + ch0 + 4), b0 = *(const f32x4*)(cw + DFF_ + ch0), b1 = *(const f32x4*)(cw + DFF_ + ch0 + 4), c0 = *(const f32x4*)(cw + 2 * DFF_ + ch0), c1 = *(const f32x4*)(cw + 2 * DFF_ + ch0 + 4);
          w0[0] = (f32x2){a0[0], a0[1]}; w0[1] = (f32x2){a0[2], a0[3]}; w0[2] = (f32x2){a1[0], a1[1]}; w0[3] = (f32x2){a1[2], a1[3]};
          w1[0] = (f32x2){b0[0], b0[1]}; w1[1] = (f32x2){b0[2], b0[3]}; w1[2] = (f32x2){b1[0], b1[1]}; w1[3] = (f32x2){b1[2], b1[3]};
          w2[0] = (f32x2){c0[0], c0[1]}; w2[1] = (f32x2){c0[2], c0[3]}; w2[2] = (f32x2){c1[0], c1[1]}; w2[3] = (f32x2){c1[2], c1[3]}; }
        asm volatile("s_waitcnt lgkmcnt(0)" ::: "memory"); __builtin_amdgcn_s_barrier(); asm volatile("" ::: "memory");
#pragma unroll
        for (int ai = 0; ai < 2; ++ai) {
            float o1[8], o2[8];
            if (wr == 1 || ai == 1) {
                const int sa = (wr == 1) ? ai : 0, sw = (wr == 1) ? 0 : 1;
                const PG8_LAS f32x4* h1 = (const PG8_LAS f32x4*)(halo + ((((sa * 2 + sw) * 4 + wc) * 2 + 1) * 4 + fq) * 8);
                const PG8_LAS f32x4* h0 = (const PG8_LAS f32x4*)(halo + ((((sa * 2 + sw) * 4 + wc) * 2 + 0) * 4 + fq) * 8);
                const f32x4 x0 = h1[0], x1 = h1[1], y0 = h0[0], y1 = h0[1];
#pragma unroll
                for (int j = 0; j < 4; ++j) { o1[j] = x0[j]; o1[4 + j] = x1[j]; o2[j] = (fr == 0) ? y0[j] : x0[j]; o2[4 + j] = (fr == 0) ? y1[j] : x1[j]; }
            } else {
#pragma unroll
                for (int j = 0; j < 8; ++j) { o1[j] = 0.f; o2[j] = 0.f; }
            }
#pragma unroll
            for (int m = 0; m < 4; ++m) {
                const int r = pm * BM + ai * HALF + wr * 64 + m * 16 + fr;
                float g[8], p1[8], p2[8];
                const float rs_c = I8 ? RS[ai * HALF + wr * 64 + m * 16 + fr] : accs;
                const f32x4 ga_ = cv(acc[ai][0][m][0], rs_c), gb_ = cv(acc[ai][0][m][1], rs_c);
#pragma unroll
                for (int j = 0; j < 4; ++j) { g[j] = ga_[j]; g[4 + j] = gb_[j]; }
#pragma unroll
                for (int j = 0; j < 8; ++j) { p1[j] = dpp_shr1(o1[j], g[j]); p2[j] = dpp_shr2(o2[j], g[j]); }
                if (m < 3) {
#pragma unroll
                    for (int j = 0; j < 8; ++j) { o1[j] = dpp_ror1(g[j]); o2[j] = dpp_ror2(g[j]); }
                }
                if (SAMP) {
                    const int t = fr & 7, seq = (r - 8192) >> 3;
                    const float* sp = st + (size_t)seq * 2 * DFF_ + ch0;
                    f32x4 s00 = {0.f, 0.f, 0.f, 0.f}, s01 = s00, s10 = s00, s11 = s00;
                    if (t < 2) { s10 = *(const f32x4*)(sp + DFF_); s11 = *(const f32x4*)(sp + DFF_ + 4); if (t == 0) { s00 = *(const f32x4*)(sp); s01 = *(const f32x4*)(sp + 4); } }
#pragma unroll
                    for (int j = 0; j < 4; ++j) { p1[j] = (t == 0) ? s10[j] : p1[j]; p1[4 + j] = (t == 0) ? s11[j] : p1[4 + j];
                        p2[j] = (t == 0) ? s00[j] : ((t == 1) ? s10[j] : p2[j]); p2[4 + j] = (t == 0) ? s01[j] : ((t == 1) ? s11[j] : p2[4 + j]); }
                    if (!I8 && t >= 6) { float* so = out_fs + ((size_t)seq * 2 + (t - 6)) * DFF_ + ch0; *(f32x4*)(so) = ga_; *(f32x4*)(so + 4) = gb_; }
                } else {
                    if (ai == 0 && m == 0) { if (wr == 0 && fr < 2) { float* q = sb + ((size_t)pm * 6 + fr) * DFF_ + ch0; *(f32x4*)(q) = ga_; *(f32x4*)(q + 4) = gb_;
                        q += 2 * DFF_; *(f32x4*)(q) = cv(acc[0][1][0][0], rs_c); *(f32x4*)(q + 4) = cv(acc[0][1][0][1], rs_c); } }
                    if (ai == 1 && m == 3) { if (wr == 1 && fr >= 14) { float* q = sb + ((size_t)pm * 6 + 4 + (fr - 14)) * DFF_ + ch0; *(f32x4*)(q) = ga_; *(f32x4*)(q + 4) = gb_;
                        if ((pm & 15) == 15) { float* so = out_fp + ((size_t)(pm >> 4) * 2 + (fr - 14)) * DFF_ + ch0; *(f32x4*)(so) = ga_; *(f32x4*)(so + 4) = gb_; } } }
                }
                int q0 = 0, q1 = 0;
#pragma unroll
                for (int jp = 0; jp < 4; ++jp) {
                    const f32x2 gv = (f32x2){g[2 * jp], g[2 * jp + 1]}, p1v = (f32x2){p1[2 * jp], p1[2 * jp + 1]}, p2v = (f32x2){p2[2 * jp], p2[2 * jp + 1]};
                    const f32x2 ur_ = (jp < 2) ? (f32x2){acc[ai][1][m][0][2 * jp], acc[ai][1][m][0][2 * jp + 1]} : (f32x2){acc[ai][1][m][1][2 * jp - 4], acc[ai][1][m][1][2 * jp - 3]};
                    const float ux_ = ur_.x, uy_ = ur_.y;
                    const f32x2 uv = I8 ? (f32x2){(float)__float_as_int(ux_), (float)__float_as_int(uy_)} * rs_c : ur_ * rs_c;
                    const f32x2 gc = w0[jp] * p2v + w1[jp] * p1v + w2[jp] * gv, ea = gc * (-1.4426950408889634f);
                    f32x2 e; e.x = __builtin_amdgcn_exp2f(ea.x); e.y = __builtin_amdgcn_exp2f(ea.y);
                    const f32x2 d = e + 1.0f; f32x2 rc; rc.x = __builtin_amdgcn_rcpf(d.x); rc.y = __builtin_amdgcn_rcpf(d.y);
                    const f32x2 o = ((gc * rc) * uv) * ACT_PRESCALE;
                    const float ox = __builtin_amdgcn_fmed3f(o.x, -448.0f, 448.0f), oy = __builtin_amdgcn_fmed3f(o.y, -448.0f, 448.0f);
                    if (jp == 0) q0 = __builtin_amdgcn_cvt_pk_fp8_f32(ox, oy, q0, false); else if (jp == 1) q0 = __builtin_amdgcn_cvt_pk_fp8_f32(ox, oy, q0, true);
                    else if (jp == 2) q1 = __builtin_amdgcn_cvt_pk_fp8_f32(ox, oy, q1, false); else q1 = __builtin_amdgcn_cvt_pk_fp8_f32(ox, oy, q1, true);
                }
                { typedef unsigned u32x2 __attribute__((ext_vector_type(2))); *(u32x2*)(ACT + (size_t)r * ldact + ch0) = (u32x2){(unsigned)q0, (unsigned)q1}; }
            }
        }
    }
    __device__ __forceinline__ void operator()(const f32x4 (&acc)[2][2][4][2], const Unit& u, int wr, int wc, int fr, int fq) const {
        if (u.pm() >= 32) body<true>(acc, u, wr, wc, fr, fq); else body<false>(acc, u, wr, wc, fr, fq);
    }
};
typedef EpiGateUpT<false> EpiGateUp;
struct EpiGateState {
    static constexpr bool PERM = true, AFTER_DRAIN = false;
    float* out_fs;
    __device__ __forceinline__ void operator()(const f32x4 (&acc)[2][2][4][2], const Unit& u, int wr, int wc, int fr, int fq) const {
        constexpr int DFF_ = 11008;
#pragma unroll
        for (int ai = 0; ai < 2; ++ai)
#pragma unroll
            for (int m = 0; m < 4; ++m) { float* rowp = out_fs + (size_t)(ai * HALF + wr * 64 + m * 16 + fr) * DFF_;
#pragma unroll
                for (int bj = 0; bj < 2; ++bj) { const int tile = 2 * u.pn() + bj;
                    float* q = rowp + 128 * tile + 32 * wc + 8 * fq; *(f32x4*)(q) = acc[ai][bj][m][0]; *(f32x4*)(q + 4) = acc[ai][bj][m][1]; } }
    }
};
template <bool I8> struct EpiInProjT {
    static constexpr bool PERM = true, AFTER_DRAIN = false;
    bf16_t* PROJ; int ldp; bf16_t* MIX; int ldm; const float* cw; const float* st; float* sb; float* out_cp; float* out_cs; PG8_LAS float* halo; float accs = 1.0f; const float* rowscale = nullptr;
    static __device__ __forceinline__ f32x4 cv(const f32x4& a_, float f_) { if (I8) { typedef int i32x4_ __attribute__((ext_vector_type(4))); const i32x4_ i_ = __builtin_bit_cast(i32x4_, a_);
        return (f32x4){(float)i_[0] * f_, (float)i_[1] * f_, (float)i_[2] * f_, (float)i_[3] * f_}; } else return a_; }
    __device__ __forceinline__ void plain(const f32x4 (&acc)[2][2][4][2], const Unit& u, int wr, int wc, int fr, int fq) const {
        const int row0 = u.pm() * BM + wr * 64 + fr, col0 = 2048 + (u.pn() - 32) * BM + wc * 32 + 8 * fq;
#pragma unroll
        for (int ai = 0; ai < 2; ++ai)
#pragma unroll
            for (int m = 0; m < 4; ++m) { bf16_t* rowp = PROJ + (size_t)(row0 + ai * HALF + m * 16) * ldp + col0; const float rs_c = I8 ? rowscale[row0 + ai * HALF + m * 16] * accs : 1.0f;
#pragma unroll
                for (int bj = 0; bj < 2; ++bj) { const f32x4 v0 = cv(acc[ai][bj][m][0], rs_c), v1 = cv(acc[ai][bj][m][1], rs_c);
                    u32x4 w; w.x = cvt_pk_bf16(v0[0], v0[1]); w.y = cvt_pk_bf16(v0[2], v0[3]); w.z = cvt_pk_bf16(v1[0], v1[1]); w.w = cvt_pk_bf16(v1[2], v1[3]);
                    *(u32x4*)(rowp + bj * HALF) = w; } }
    }
    template <bool SAMP> __device__ __forceinline__ void body(const f32x4 (&acc)[2][2][4][2], const Unit& u, int wr, int wc, int fr, int fq) const {
        constexpr int DC = 2048;
        typedef unsigned u32x2 __attribute__((ext_vector_type(2)));
        const int pm = u.pm(), ch0 = 64 * u.pn() + 16 * wc + 4 * fq;
        PG8_LAS float* RS = halo + 1024;
        if (I8) { const int t_ = (wr * 4 + wc) * 64 + fq * 16 + fr; if (t_ < 256) RS[t_] = rowscale[pm * BM + t_] * accs; }
        if (fr >= 14) {
#pragma unroll
            for (int ai = 0; ai < 2; ++ai) { const float f_ = I8 ? rowscale[pm * BM + ai * HALF + wr * 64 + 48 + fr] * accs : 1.0f; f32x4 t0_ = acc[ai][0][3][1], t1_ = acc[ai][1][3][0]; if (I8) asm volatile("" : "+v"(t0_), "+v"(t1_));
                *(PG8_LAS f32x4*)(halo + ((((ai * 2 + wr) * 4 + wc) * 2 + (fr - 14)) * 4 + fq) * 4) = cv(t0_, f_) * cv(t1_, f_); }
        }
        const f32x4 w0 = *(const f32x4*)(cw + ch0), w1 = *(const f32x4*)(cw + DC + ch0), w2 = *(const f32x4*)(cw + 2 * DC + ch0);
        asm volatile("s_waitcnt lgkmcnt(0)" ::: "memory"); __builtin_amdgcn_s_barrier(); asm volatile("" ::: "memory");
#pragma unroll
        for (int ai = 0; ai < 2; ++ai) {
            float o1[4], o2[4];
            if (wr == 1 || ai == 1) {
                const int sa = (wr == 1) ? ai : 0, sw = (wr == 1) ? 0 : 1;
                const f32x4 x = *(const PG8_LAS f32x4*)(halo + ((((sa * 2 + sw) * 4 + wc) * 2 + 1) * 4 + fq) * 4);
                const f32x4 y = *(const PG8_LAS f32x4*)(halo + ((((sa * 2 + sw) * 4 + wc) * 2 + 0) * 4 + fq) * 4);
#pragma unroll
                for (int j = 0; j < 4; ++j) { o1[j] = x[j]; o2[j] = (fr == 0) ? y[j] : x[j]; }
            } else {
#pragma unroll
                for (int j = 0; j < 4; ++j) { o1[j] = 0.f; o2[j] = 0.f; }
            }
#pragma unroll
            for (int m = 0; m < 4; ++m) {
                const int r = pm * BM + ai * HALF + wr * 64 + m * 16 + fr;
                const float rs_c = I8 ? RS[ai * HALF + wr * 64 + m * 16 + fr] : 1.0f;
                const f32x4 Bv = cv(acc[ai][0][m][0], rs_c), uu = cv(acc[ai][0][m][1], rs_c) * cv(acc[ai][1][m][0], rs_c), Qv = cv(acc[ai][1][m][1], rs_c);
                { u32x2 wq; wq.x = cvt_pk_bf16(Qv[0], Qv[1]); wq.y = cvt_pk_bf16(Qv[2], Qv[3]); *(u32x2*)(PROJ + (size_t)r * ldp + ch0) = wq; }
                f32x4 p1, p2;
#pragma unroll
                for (int j = 0; j < 4; ++j) { p1[j] = dpp_shr1(o1[j], uu[j]); p2[j] = dpp_shr2(o2[j], uu[j]); }
                if (m < 3) {
#pragma unroll
                    for (int j = 0; j < 4; ++j) { o1[j] = dpp_ror1(uu[j]); o2[j] = dpp_ror2(uu[j]); }
                }
                if (SAMP) {
                    const int t = fr & 7, seq = (r - 8192) >> 3;
                    const float* sp = st + (size_t)seq * 2 * DC + ch0;
                    f32x4 s0 = {0.f, 0.f, 0.f, 0.f}, s1 = s0;
                    if (t < 2) { s1 = *(const f32x4*)(sp + DC); if (t == 0) s0 = *(const f32x4*)(sp); }
#pragma unroll
                    for (int j = 0; j < 4; ++j) { p1[j] = (t == 0) ? s1[j] : p1[j]; p2[j] = (t == 0) ? s0[j] : ((t == 1) ? s1[j] : p2[j]); }
                    if (t >= 6) *(f32x4*)(out_cs + ((size_t)seq * 2 + (t - 6)) * DC + ch0) = uu;
                } else {
                    if (ai == 0 && m == 0) { if (wr == 0 && fr < 2) { float* q = sb + ((size_t)pm * 6 + fr) * DC + ch0; *(f32x4*)(q) = uu; *(f32x4*)(q + 2 * DC) = Bv; } }
                    if (ai == 1 && m == 3) { if (wr == 1 && fr >= 14) { *(f32x4*)(sb + ((size_t)pm * 6 + 4 + (fr - 14)) * DC + ch0) = uu;
                        if ((pm & 15) == 15) *(f32x4*)(out_cp + ((size_t)(pm >> 4) * 2 + (fr - 14)) * DC + ch0) = uu; } }
                }
                const f32x4 o = Bv * (w0 * p2 + w1 * p1 + w2 * uu);
                u32x2 wo; wo.x = cvt_pk_bf16(o[0], o[1]); wo.y = cvt_pk_bf16(o[2], o[3]);
                *(u32x2*)(MIX + (size_t)r * ldm + DC + ch0) = wo;
            }
        }
    }
    __device__ __forceinline__ void operator()(const f32x4 (&acc)[2][2][4][2], const Unit& u, int wr, int wc, int fr, int fq) const {
        if (u.pn() >= 32) plain(acc, u, wr, wc, fr, fq); else if (!I8 && u.pm() >= 32) body<true>(acc, u, wr, wc, fr, fq); else body<false>(acc, u, wr, wc, fr, fq);
    }
};
typedef EpiInProjT<false> EpiInProj;
template <bool B_> struct BoolTag { static constexpr bool value = B_; };
template <class Epi, class Sched, bool ALIGN_EPI = false, bool SP2 = false, int PREC = 0>
__device__ __forceinline__ void gemm_phase(PG8_LAS unsigned char* lds, const Gemm g, const Sched& S, const Epi& E) {
    constexpr bool FP8 = (PREC == 1), I8 = (PREC == 2), MIXED = (PREC == 3);
    constexpr bool T8 = FP8 || MIXED;
    int tid_ = threadIdx.x; asm volatile("" : "+v"(tid_));
    const int tid = tid_, wid = __builtin_amdgcn_readfirstlane(tid >> 6), lane = tid & 63, wr = wid >> 2, wc = wid & 3, fr = lane & 15, fq = lane >> 4;
    const int K = g.ld;
    unsigned voffA[2], voffB[2];
#pragma unroll
    for (int i = 0; i < 2; ++i) { int R, C; stage_rc(tid * 16 + i * 8192, R, C); const int Rb = Epi::PERM ? ((R & ~31) + perm32(R & 31)) : R;
        voffA[i] = (unsigned)(R * K + C) * 2u; voffB[i] = (unsigned)(Rb * K + C) * 2u; }
    const size_t kstep = (size_t)(BK * 2);
    const size_t hstep = (size_t)HALF * K * 2;
    const size_t tstep = 2 * hstep;
    const size_t hstepB = g.bh ? g.bh : hstep, tstepB = g.bt ? g.bt : tstep;
    const unsigned ldsw = (unsigned)wid * 1024u;
    const int aoff = lds_byte(wr * 64 + fr, fq * 8), boff = lds_byte(wc * 32 + fr, fq * 8);
#define PG8_SA(b, h) (((b) * 2 + (h)) * HTB)
#define PG8_SB(b, h) ((4 + (b) * 2 + (h)) * HTB)
#define PG8_STAGE(bufoff, gbase, voff) do { _Pragma("unroll") for (int _i = 0; _i < 2; ++_i) \
        __builtin_amdgcn_global_load_lds((const unsigned*)((const char*)(gbase) + (voff)[_i]), (PG8_LAS unsigned*)(lds + (bufoff) + ldsw + _i * 8192), 16, 0, 0); } while (0)
#define PG8_LDA(dst, b, h) do { if constexpr (T8) { _Pragma("unroll") for (int m = 0; m < 4; ++m) { \
            const v4i_ lo_ = *(const PG8_LAS v4i_*)(lds + PG8_SA(b, h) + aoff + m * 2048), hi_ = *(const PG8_LAS v4i_*)(lds + PG8_SA(b, h) + aoff + m * 2048 + 1024); \
            dst##8[m] = __builtin_shufflevector(lo_, hi_, 0, 1, 2, 3, 4, 5, 6, 7); } } \
        else { _Pragma("unroll") for (int m = 0; m < 4; ++m) _Pragma("unroll") for (int k = 0; k < 2; ++k) dst[m][k] = *(const PG8_LAS bf16x8*)(lds + PG8_SA(b, h) + aoff + m * 2048 + k * 1024); } } while (0)
#define PG8_LDB(dst, b, h) do { if constexpr (T8) { _Pragma("unroll") for (int n = 0; n < 2; ++n) { \
            const v4i_ lo_ = *(const PG8_LAS v4i_*)(lds + PG8_SB(b, h) + boff + n * 2048), hi_ = *(const PG8_LAS v4i_*)(lds + PG8_SB(b, h) + boff + n * 2048 + 1024); \
            dst##8[n] = __builtin_shufflevector(lo_, hi_, 0, 1, 2, 3, 4, 5, 6, 7); } } \
        else { _Pragma("unroll") for (int n = 0; n < 2; ++n) _Pragma("unroll") for (int k = 0; k < 2; ++k) dst[n][k] = *(const PG8_LAS bf16x8*)(lds + PG8_SB(b, h) + boff + n * 2048 + k * 1024); } } while (0)
#define PG8_MMA(ai, bj, At, Bt) do { __builtin_amdgcn_s_setprio(1); \
        if constexpr (FP8) { \
            _Pragma("unroll") for (int m = 0; m < 4; ++m) _Pragma("unroll") for (int n = 0; n < 2; ++n) \
                asm volatile("v_mfma_scale_f32_16x16x128_f8f6f4 %0, %1, %2, %0, %3, %3 op_sel_hi:[0,0,0]" : "+v"(acc[ai][bj][m][n]) : "v"(Bt##8[n]), "v"(At##8[m]), "v"(fp8_unit_scale)); \
        } else if constexpr (MIXED) { if constexpr (F8SEG) { \
            _Pragma("unroll") for (int m = 0; m < 4; ++m) _Pragma("unroll") for (int n = 0; n < 2; ++n) \
                asm volatile("v_mfma_scale_f32_16x16x128_f8f6f4 %0, %1, %2, %0, %3, %3 op_sel_hi:[0,0,0]" : "+v"(acc[ai][bj][m][n]) : "v"(Bt##8[n]), "v"(At##8[m]), "v"(fp8_unit_scale)); \
          } else { _Pragma("unroll") for (int m = 0; m < 4; ++m) _Pragma("unroll") for (int n = 0; n < 2; ++n) { \
                asm volatile("v_mfma_f32_16x16x32_bf16 %0, %1, %2, %0" : "+v"(acc[ai][bj][m][n]) : "v"(Bt##8[n].lo), "v"(At##8[m].lo)); } \
            _Pragma("unroll") for (int m = 0; m < 4; ++m) _Pragma("unroll") for (int n = 0; n < 2; ++n) { \
                asm volatile("v_mfma_f32_16x16x32_bf16 %0, %1, %2, %0" : "+v"(acc[ai][bj][m][n]) : "v"(Bt##8[n].hi), "v"(At##8[m].hi)); } } \
        } else if constexpr (I8) { _Pragma("unroll") for (int k = 0; k < 2; ++k) _Pragma("unroll") for (int m = 0; m < 4; ++m) _Pragma("unroll") for (int n = 0; n < 2; ++n) \
            acc[ai][bj][m][n] = __builtin_bit_cast(f32x4, __builtin_amdgcn_mfma_i32_16x16x64_i8(__builtin_bit_cast(v4i_, Bt[n][k]), __builtin_bit_cast(v4i_, At[m][k]), __builtin_bit_cast(v4i_, acc[ai][bj][m][n]), 0, 0, 0)); \
        } else { _Pragma("unroll") for (int m = 0; m < 4; ++m) _Pragma("unroll") for (int n = 0; n < 2; ++n) _Pragma("unroll") for (int k = 0; k < 2; ++k) \
            acc[ai][bj][m][n] = __builtin_amdgcn_mfma_f32_16x16x32_bf16(Bt[n][k], At[m][k], acc[ai][bj][m][n], 0, 0, 0); } \
        __builtin_amdgcn_s_setprio(0); } while (0)
#define PG8_WAIT_V(n) asm volatile("s_waitcnt vmcnt(" #n ")" ::: "memory")
#define PG8_WAIT_L(n) asm volatile("s_waitcnt lgkmcnt(" #n ")" ::: "memory")
#define PG8_BAR __builtin_amdgcn_s_barrier()
#define PG8_SCHED __builtin_amdgcn_sched_barrier(0)
    Unit cur, nxt; int ui = 0;
    if (!S.next(0, cur)) return;
    f32x4 acc[2][2][4][2];
#pragma unroll
    for (int a = 0; a < 2; ++a)
#pragma unroll
        for (int b = 0; b < 2; ++b)
#pragma unroll
            for (int m = 0; m < 4; ++m)
#pragma unroll
                for (int n = 0; n < 2; ++n) acc[a][b][m][n] = (f32x4){0.f, 0.f, 0.f, 0.f};
    typedef int v8i_ __attribute__((ext_vector_type(8))); typedef int v4i_ __attribute__((ext_vector_type(4)));
    int fp8_unit_scale = 0x7f7f7f7f; asm volatile("" : "+v"(fp8_unit_scale));
    bf16x8 At[4][2], B0[2][2], B1[2][2]; v8i_ At8[4], B08[2], B18[2];
    bool seg8 = MIXED && cur.f8();
    const char* cA = (const char*)((MIXED && cur.f8()) ? g.A8 : g.A) + (size_t)cur.pm() * tstep + (size_t)cur.k0() * 2; const char* cB = (const char*)((MIXED && cur.f8()) ? g.B8 : g.Bt) + (size_t)cur.pn() * tstepB + (size_t)cur.k0() * 2;
    S.a_ready(cur);
    if constexpr (SP2) {
        PG8_STAGE(PG8_SB(0, 0), cB, voffB); PG8_STAGE(PG8_SB(0, 1), cB + hstepB, voffB); PG8_STAGE(PG8_SA(0, 0), cA, voffA); PG8_STAGE(PG8_SA(0, 1), cA + hstep, voffA);
        if (wr == 1) PG8_BAR;
        PG8_WAIT_V(2); PG8_BAR;
        PG8_STAGE(PG8_SB(1, 0), cB + kstep, voffB); PG8_STAGE(PG8_SA(1, 0), cA + kstep, voffA); PG8_STAGE(PG8_SB(1, 1), cB + hstepB + kstep, voffB);
        PG8_WAIT_V(6); PG8_BAR;
    } else {
        PG8_STAGE(PG8_SB(0, 0), cB, voffB); PG8_STAGE(PG8_SA(0, 0), cA, voffA); PG8_STAGE(PG8_SB(0, 1), cB + hstepB, voffB); PG8_STAGE(PG8_SA(0, 1), cA + hstep, voffA);
        if (wr == 1) PG8_BAR;
        PG8_WAIT_V(4); PG8_BAR;
        PG8_STAGE(PG8_SB(1, 0), cB + kstep, voffB); PG8_STAGE(PG8_SA(1, 0), cA + kstep, voffA); PG8_STAGE(PG8_SB(1, 1), cB + hstepB + kstep, voffB);
        PG8_WAIT_V(6); PG8_BAR;
    }
    if constexpr (MIXED) {
    auto seg_ = [&](auto tag_) __attribute__((always_inline)) -> bool { constexpr bool F8SEG = decltype(tag_)::value; (void)F8SEG;
        const bool has_next = S.next(ui + 1, nxt);
        const char* nA = has_next ? (const char*)((MIXED && nxt.f8()) ? g.A8 : g.A) + (size_t)nxt.pm() * tstep + (size_t)nxt.k0() * 2 : cA; const char* nB = has_next ? (const char*)((MIXED && nxt.f8()) ? g.B8 : g.Bt) + (size_t)nxt.pn() * tstepB + (size_t)nxt.k0() * 2 : cB;
        const int nt = cur.nt();
        for (int t = 0; t < nt; t += 2) {
            const bool last = (t == nt - 2);
            const char* a1 = cA + (size_t)(t + 1) * kstep;
            const char* a2 = last ? nA : cA + (size_t)(t + 2) * kstep; const char* b2 = last ? nB : cB + (size_t)(t + 2) * kstep;
            const char* a3 = a2 + kstep; const char* b3 = b2 + kstep;
            if (last && has_next) S.a_ready(nxt);
            if constexpr (SP2) {
            PG8_LDB(B0, 0, 0); PG8_LDB(B1, 0, 1); PG8_SCHED; PG8_LDA(At, 0, 0); PG8_STAGE(PG8_SA(1, 1), a1 + hstep, voffA);
            PG8_WAIT_V(8); PG8_WAIT_L(0); PG8_BAR; PG8_MMA(0, 0, At, B0); PG8_MMA(0, 1, At, B1); PG8_BAR; PG8_SCHED;
            PG8_LDA(At, 0, 1); PG8_STAGE(PG8_SB(0, 0), b2, voffB); PG8_STAGE(PG8_SB(0, 1), b2 + hstepB, voffB); PG8_STAGE(PG8_SA(0, 0), a2, voffA);
            PG8_WAIT_V(8); PG8_WAIT_L(0); PG8_BAR; PG8_MMA(1, 0, At, B0); PG8_MMA(1, 1, At, B1); PG8_BAR; PG8_SCHED;
            PG8_LDB(B0, 1, 0); PG8_LDB(B1, 1, 1); PG8_SCHED; PG8_LDA(At, 1, 0); PG8_STAGE(PG8_SA(0, 1), a2 + hstep, voffA);
            PG8_WAIT_V(8); PG8_WAIT_L(0); PG8_BAR; PG8_MMA(0, 0, At, B0); PG8_MMA(0, 1, At, B1); PG8_BAR; PG8_SCHED;
            PG8_LDA(At, 1, 1); PG8_STAGE(PG8_SB(1, 0), b3, voffB); PG8_STAGE(PG8_SB(1, 1), b3 + hstepB, voffB); PG8_STAGE(PG8_SA(1, 0), a3, voffA);
            PG8_WAIT_V(8); PG8_WAIT_L(0); PG8_BAR; PG8_MMA(1, 0, At, B0); PG8_MMA(1, 1, At, B1); PG8_BAR; PG8_SCHED;
            } else {
            PG8_LDB(B0, 0, 0); PG8_SCHED; PG8_LDA(At, 0, 0); PG8_STAGE(PG8_SA(1, 1), a1 + hstep, voffA);
            PG8_WAIT_L(8); PG8_BAR; PG8_WAIT_L(0); PG8_MMA(0, 0, At, B0); PG8_BAR; PG8_SCHED;
            PG8_LDB(B1, 0, 1); PG8_STAGE(PG8_SB(0, 0), b2, voffB);
            PG8_BAR; PG8_WAIT_L(0); PG8_MMA(0, 1, At, B1); PG8_BAR;
            PG8_LDA(At, 0, 1); PG8_STAGE(PG8_SA(0, 0), a2, voffA);
            PG8_BAR; PG8_WAIT_L(0); PG8_MMA(1, 0, At, B0); PG8_BAR; PG8_SCHED;
            PG8_STAGE(PG8_SB(0, 1), b2 + hstepB, voffB);
            PG8_WAIT_V(6); PG8_BAR; PG8_MMA(1, 1, At, B1); PG8_BAR;
            PG8_LDB(B0, 1, 0); PG8_SCHED; PG8_LDA(At, 1, 0); PG8_STAGE(PG8_SA(0, 1), a2 + hstep, voffA);
            PG8_WAIT_L(8); PG8_BAR; PG8_WAIT_L(0); PG8_MMA(0, 0, At, B0); PG8_BAR; PG8_SCHED;
            PG8_LDB(B1, 1, 1); PG8_STAGE(PG8_SB(1, 0), b3, voffB);
            PG8_BAR; PG8_WAIT_L(0); PG8_MMA(0, 1, At, B1); PG8_BAR;
            PG8_LDA(At, 1, 1); PG8_STAGE(PG8_SA(1, 0), a3, voffA);
            PG8_BAR; PG8_WAIT_L(0); PG8_MMA(1, 0, At, B0); PG8_BAR; PG8_SCHED;
            PG8_STAGE(PG8_SB(1, 1), b3 + hstepB, voffB);
            PG8_WAIT_V(6); PG8_BAR; PG8_MMA(1, 1, At, B1); PG8_BAR;
            }
        }
        if constexpr (FP8 || MIXED) asm volatile("s_nop 15\n\ts_nop 15" ::: "memory");
        if constexpr (ALIGN_EPI) { if (wr == 0) PG8_BAR; }
        if constexpr (MIXED && F8SEG) {
            _Pragma("unroll") for (int a = 0; a < 2; ++a) _Pragma("unroll") for (int b = 0; b < 2; ++b) _Pragma("unroll") for (int m = 0; m < 4; ++m) _Pragma("unroll") for (int n = 0; n < 2; ++n) acc[a][b][m][n] = acc[a][b][m][n] * g.seam;
        } else
        if constexpr (!Epi::AFTER_DRAIN) { bool fin = true; if (cur.ns() > 1) fin = S.combine(acc, cur, wid, lane); if (fin) E(acc, cur, wr, wc, fr, fq); S.done(cur); }
        if (!has_next) return true;
        if constexpr (!(MIXED && F8SEG)) {
#pragma unroll
        for (int a = 0; a < 2; ++a)
#pragma unroll
            for (int b = 0; b < 2; ++b)
#pragma unroll
                for (int m = 0; m < 4; ++m)
#pragma unroll
                    for (int n = 0; n < 2; ++n) acc[a][b][m][n] = (f32x4){0.f, 0.f, 0.f, 0.f};
        }
        cur = nxt; cA = nA; cB = nB; ++ui; seg8 = MIXED && cur.f8();
        if constexpr (ALIGN_EPI) { if (wr == 1) PG8_BAR; }
            return false;
    };
    for (;;) {
        if constexpr (MIXED) { if (seg_(BoolTag<true>{})) break; }
        if (seg_(BoolTag<false>{})) break;
    }
    } else {
    constexpr bool F8SEG = false; (void)F8SEG;
    for (;;) {
        const bool has_next = S.next(ui + 1, nxt);
        const char* nA = has_next ? (const char*)g.A + (size_t)nxt.pm() * tstep + (size_t)nxt.k0() * 2 : cA; const char* nB = has_next ? (const char*)g.Bt + (size_t)nxt.pn() * tstepB + (size_t)nxt.k0() * 2 : cB;
        const int nt = cur.nt();
        for (int t = 0; t < nt; t += 2) {
            const bool last = (t == nt - 2);
            const char* a1 = cA + (size_t)(t + 1) * kstep;
            const char* a2 = last ? nA : cA + (size_t)(t + 2) * kstep; const char* b2 = last ? nB : cB + (size_t)(t + 2) * kstep;
            const char* a3 = a2 + kstep; const char* b3 = b2 + kstep;
            if (last && has_next) S.a_ready(nxt);
            if constexpr (SP2) {
            PG8_LDB(B0, 0, 0); PG8_LDB(B1, 0, 1); PG8_SCHED; PG8_LDA(At, 0, 0); PG8_STAGE(PG8_SA(1, 1), a1 + hstep, voffA);
            PG8_WAIT_V(8); PG8_WAIT_L(0); PG8_BAR; PG8_MMA(0, 0, At, B0); PG8_MMA(0, 1, At, B1); PG8_BAR; PG8_SCHED;
            PG8_LDA(At, 0, 1); PG8_STAGE(PG8_SB(0, 0), b2, voffB); PG8_STAGE(PG8_SB(0, 1), b2 + hstepB, voffB); PG8_STAGE(PG8_SA(0, 0), a2, voffA);
            PG8_WAIT_V(8); PG8_WAIT_L(0); PG8_BAR; PG8_MMA(1, 0, At, B0); PG8_MMA(1, 1, At, B1); PG8_BAR; PG8_SCHED;
            PG8_LDB(B0, 1, 0); PG8_LDB(B1, 1, 1); PG8_SCHED; PG8_LDA(At, 1, 0); PG8_STAGE(PG8_SA(0, 1), a2 + hstep, voffA);
            PG8_WAIT_V(8); PG8_WAIT_L(0); PG8_BAR; PG8_MMA(0, 0, At, B0); PG8_MMA(0, 1, At, B1); PG8_BAR; PG8_SCHED;
            PG8_LDA(At, 1, 1); PG8_STAGE(PG8_SB(1, 0), b3, voffB); PG8_STAGE(PG8_SB(1, 1), b3 + hstepB, voffB); PG8_STAGE(PG8_SA(1, 0), a3, voffA);
            PG8_WAIT_V(8); PG8_WAIT_L(0); PG8_BAR; PG8_MMA(1, 0, At, B0); PG8_MMA(1, 1, At, B1); PG8_BAR; PG8_SCHED;
            } else {
            PG8_LDB(B0, 0, 0); PG8_SCHED; PG8_LDA(At, 0, 0); PG8_STAGE(PG8_SA(1, 1), a1 + hstep, voffA);
            PG8_WAIT_L(8); PG8_BAR; PG8_WAIT_L(0); PG8_MMA(0, 0, At, B0); PG8_BAR; PG8_SCHED;
            PG8_LDB(B1, 0, 1); PG8_STAGE(PG8_SB(0, 0), b2, voffB);
            PG8_BAR; PG8_WAIT_L(0); PG8_MMA(0, 1, At, B1); PG8_BAR;
            PG8_LDA(At, 0, 1); PG8_STAGE(PG8_SA(0, 0), a2, voffA);
            PG8_BAR; PG8_WAIT_L(0); PG8_MMA(1, 0, At, B0); PG8_BAR; PG8_SCHED;
            PG8_STAGE(PG8_SB(0, 1), b2 + hstepB, voffB);
            PG8_WAIT_V(6); PG8_BAR; PG8_MMA(1, 1, At, B1); PG8_BAR;
            PG8_LDB(B0, 1, 0); PG8_SCHED; PG8_LDA(At, 1, 0); PG8_STAGE(PG8_SA(0, 1), a2 + hstep, voffA);
            PG8_WAIT_L(8); PG8_BAR; PG8_WAIT_L(0); PG8_MMA(0, 0, At, B0); PG8_BAR; PG8_SCHED;
            PG8_LDB(B1, 1, 1); PG8_STAGE(PG8_SB(1, 0), b3, voffB);
            PG8_BAR; PG8_WAIT_L(0); PG8_MMA(0, 1, At, B1); PG8_BAR;
            PG8_LDA(At, 1, 1); PG8_STAGE(PG8_SA(1, 0), a3, voffA);
            PG8_BAR; PG8_WAIT_L(0); PG8_MMA(1, 0, At, B0); PG8_BAR; PG8_SCHED;
            PG8_STAGE(PG8_SB(1, 1), b3 + hstepB, voffB);
            PG8_WAIT_V(6); PG8_BAR; PG8_MMA(1, 1, At, B1); PG8_BAR;
            }
        }
        if constexpr (FP8) asm volatile("s_nop 15\n\ts_nop 15" ::: "memory");
        if constexpr (ALIGN_EPI) { if (wr == 0) PG8_BAR; }
        if constexpr (!Epi::AFTER_DRAIN) { bool fin = true; if (cur.ns() > 1) fin = S.combine(acc, cur, wid, lane); if (fin) E(acc, cur, wr, wc, fr, fq); S.done(cur); }
        if (!has_next) break;
#pragma unroll
        for (int a = 0; a < 2; ++a)
#pragma unroll
            for (int b = 0; b < 2; ++b)
#pragma unroll
                for (int m = 0; m < 4; ++m)
#pragma unroll
                    for (int n = 0; n < 2; ++n) acc[a][b][m][n] = (f32x4){0.f, 0.f, 0.f, 0.f};
        cur = nxt; cA = nA; cB = nB; ++ui;
        if constexpr (ALIGN_EPI) { if (wr == 1) PG8_BAR; }
    }
    }
    PG8_WAIT_V(0);
    if constexpr (!ALIGN_EPI) { if (wr == 0) PG8_BAR; }
    PG8_BAR;
    if constexpr (Epi::AFTER_DRAIN) { E.fused(acc, cur, wr, wc, fr, fq, lds, wid, lane); S.done(cur); }
#undef PG8_SA
#undef PG8_SB
#undef PG8_STAGE
#undef PG8_LDA
#undef PG8_LDB
#undef PG8_MMA
#undef PG8_WAIT_V
#undef PG8_WAIT_L
#undef PG8_BAR
#undef PG8_SCHED
}
}
#define GAS __attribute__((address_space(1)))
#define LAS __attribute__((address_space(3)))
typedef unsigned short bf16;
typedef unsigned v4u __attribute__((ext_vector_type(4)));
typedef float f32x4 __attribute__((ext_vector_type(4)));
typedef short bf16x8 __attribute__((ext_vector_type(8)));
typedef GAS unsigned gu32;
typedef GAS unsigned long long gu64;
#define RLX_AGENT __ATOMIC_RELAXED, __HIP_MEMORY_SCOPE_AGENT
#define LDS_WAIT() asm volatile("s_waitcnt lgkmcnt(0)" ::: "memory")
#define VM_WAIT() asm volatile("s_waitcnt vmcnt(0)" ::: "memory")
__device__ __forceinline__ unsigned long long rt() { return __builtin_amdgcn_s_memrealtime(); }
__device__ __forceinline__ unsigned f2bf(float f) { unsigned u = __builtin_bit_cast(unsigned, f); return (u + 0x7fffu + ((u >> 16) & 1u)) >> 16; }
__device__ __forceinline__ unsigned pk2(float lo, float hi) { return f2bf(lo) | (f2bf(hi) << 16); }
#define XB_TMO      128
#define XB_XCNT(j)  (256  + 64 * (j))
#define XB_XSUB(j)  (1280 + 64 * (j))
#define XB_XGEN(j)  (2304 + 64 * (j))
#define XB_TOP      3328
#define XB_TOPGEN   3392
#define XCD_BAR_WORDS 3456
#define XB_SPIN_CAP (1u << 18)

__device__ __forceinline__ unsigned xb_ld(unsigned* p)              { return __hip_atomic_load(p, __ATOMIC_RELAXED, __HIP_MEMORY_SCOPE_AGENT); }
__device__ __forceinline__ unsigned xb_add(unsigned* p, unsigned v) { return __hip_atomic_fetch_add(p, v, __ATOMIC_RELAXED, __HIP_MEMORY_SCOPE_AGENT); }
__device__ __forceinline__ unsigned xb_xcc_id() { return (unsigned)__builtin_amdgcn_s_getreg((3 << 11) | 20) & 0xFu; }
#define XB_SPIN(cond, bar) do { unsigned _sp = 0; while (cond) { __builtin_amdgcn_s_sleep(1); \
    if ((++_sp & 255u) == 0u) { if (xb_ld(&(bar)[XB_TMO])) break; if (_sp > XB_SPIN_CAP) { atomicAdd(&(bar)[XB_TMO], 1u); break; } } } } while (0)

struct XcdBarrier {
    unsigned* bar; unsigned x;
    volatile LAS unsigned* st;
};

__device__ __forceinline__ XcdBarrier xcd_barrier_post(unsigned* bar, volatile LAS unsigned* st) {
    XcdBarrier b; b.bar = bar; b.x = xb_xcc_id(); b.st = st;
    if (threadIdx.x == 0) (void)xb_add(&bar[XB_XCNT(b.x)], 1u);
    return b;
}
__device__ __forceinline__ void xcd_barrier_complete(unsigned* bar, unsigned x, unsigned& nloc, unsigned& nx) {
    const unsigned G = gridDim.x * gridDim.y * gridDim.z;
    unsigned sum, cnt, mine, sp = 0u;
    for (;;) {
        sum = 0u; cnt = 0u; mine = 0u;
#pragma unroll
        for (unsigned j = 0; j < 16; ++j) { const unsigned c = xb_ld(&bar[XB_XCNT(j)]); sum += c; cnt += (c > 0u) ? 1u : 0u; mine = (j == x) ? c : mine; }
        if (sum == G) break;
        __builtin_amdgcn_s_sleep(1);
        if ((++sp & 255u) == 0u) { if (xb_ld(&bar[XB_TMO])) break; if (sp > XB_SPIN_CAP) { atomicAdd(&bar[XB_TMO], 1u); break; } }
    }
    nloc = mine > 0u ? mine : 1u; nx = cnt > 0u ? cnt : 1u;
}

__device__ __forceinline__ void xcd_barrier(const XcdBarrier& b) {
    asm volatile("s_waitcnt vmcnt(0)" ::: "memory");
    __syncthreads();
    if (threadIdx.x == 0) {
        unsigned* bar = b.bar;
        __builtin_amdgcn_s_waitcnt(0);
        unsigned nloc = b.st[0], nx = b.st[1];
        if (nloc == 0u) { xcd_barrier_complete(bar, b.x, nloc, nx); b.st[0] = nloc; b.st[1] = nx; }
        const unsigned old = xb_add(&bar[XB_XSUB(b.x)], 1u);
        const unsigned gen = old / nloc;
        if (old + 1u == (gen + 1u) * nloc) {
            __builtin_amdgcn_fence(__ATOMIC_RELEASE, "agent");
            asm volatile("s_waitcnt vmcnt(0)" ::: "memory");
            (void)xb_add(&bar[XB_TOP], 1u);
        }
        XB_SPIN(xb_ld(&bar[XB_TOP]) < (gen + 1u) * nx, bar);
        __builtin_amdgcn_fence(__ATOMIC_ACQUIRE, "agent");
        asm volatile("s_waitcnt vmcnt(0)" ::: "memory");
    }
    __syncthreads();
}
__device__ __forceinline__ float wave_sum(float v) {
#pragma unroll
    for (int o = 1; o < 64; o <<= 1) v += __shfl_xor(v, o);
    return v;
}
__device__ __forceinline__ void p0_transpose_item(const float* W, int K, int N, bf16* WT, int ldt, LAS float* scr, int item, int lane, int gu_half = 0) {
    const int nblk = N / 32, kb = item / nblk, nb = item % nblk, k0 = 64 * kb, n0 = 32 * nb;
    const int d0 = gu_half ? ((n0 < gu_half) ? ((n0 >> 7) * 256 + (n0 & 127)) : (((n0 - gu_half) >> 7) * 256 + 128 + ((n0 - gu_half) & 127))) : n0;
#pragma unroll 8
    for (int i = 0; i < 32; ++i) { const int kk = 2 * i + (lane >> 5); scr[kk * 33 + (lane & 31)] = W[(size_t)(k0 + kk) * N + n0 + (lane & 31)]; }
    LDS_WAIT(); asm volatile("" ::: "memory");
    const int c = lane & 7;
#pragma unroll
    for (int j = 0; j < 4; ++j) { const int n = (lane >> 3) + 8 * j; const LAS float* s = scr + (8 * c) * 33 + n;
        v4u o; o.x = pk2(s[0 * 33], s[1 * 33]); o.y = pk2(s[2 * 33], s[3 * 33]); o.z = pk2(s[4 * 33], s[5 * 33]); o.w = pk2(s[6 * 33], s[7 * 33]);
        *(GAS v4u*)(WT + (size_t)(d0 + n) * ldt + k0 + 8 * c) = o; }
    LDS_WAIT(); asm volatile("" ::: "memory");
}

constexpr int NWAVES = 8;
constexpr int DM = 4096, SEQ = 4096, NTOKP = 8192, NTOKS = 1024, MTOT = 9216, NCOND = 130;
constexpr int NIN = 8704, NPR = 2560  , DFF = 11008, NGU = 22016, NMOD = 24576, DCONV = 2048;
constexpr int PKB = DM + 128;
__device__ __forceinline__ bool i8_panel(int pm) { return pm < 31 && pm != 15; }
constexpr size_t WS_WGU8 = (1037 + 32) * (size_t)(1u << 20), WS_H8 = (1037 + 160) * (size_t)(1u << 20), WS_HS = (1037 + 224) * (size_t)(1u << 20)  , WS_WIN8 = (1037 + 243) * (size_t)(1u << 20)  , WS_HST = (1037 + 285) * (size_t)(1u << 20)  ,
                 WS_WOUT8A = (1037 + 289) * (size_t)(1u << 20)  , WS_MIX8A = 716 * (size_t)(1u << 20)  ;
constexpr int PFB = DFF + 128;
constexpr int PK = DM + 64, PF = DFF + 64;
constexpr int COL_K = 2048, COL_V = 2304, COL_B = 2560, COL_C = 4608, COL_HC = 6656;
constexpr float RMS_EPS = 1e-5f;
constexpr float LOG2E = 1.4426950408889634f;
constexpr size_t O_Y = 0, O_KP = 37748736, O_VP = O_KP + 65536, O_CP = O_VP + 65536, O_FP = O_CP + 8192, O_KS = O_FP + 44032, O_VS = O_KS + 4194304,
                 O_CS = O_VS + 4194304, O_FS = O_CS + 524288, O_END = O_FS + 2818048;
static_assert(O_END == 49662976, "d_out map");
constexpr size_t MiB = 1u << 20;
constexpr size_t WS_CTL = 0, CTL_ZERO_BYTES = 256 * 1024;
constexpr size_t WS_SC = 2 * MiB, WS_MOD = 5 * MiB, WS_WIN = 32 * MiB, WS_WOUT = 102 * MiB, WS_WGU = 135 * MiB, WS_WDN = 310 * MiB, WS_WMOD = 397 * MiB,
                 WS_H = 592 * MiB, WS_PROJ = 666 * MiB, WS_MIX = 819 * MiB, WS_X1 = 893 * MiB, WS_GU = 1037 * MiB, WS_SLAB = 1424 * MiB, WS_END = 1488 * MiB, WS_ACT = 397 * MiB;
static_assert(WS_SC + (size_t)256 * PK * 2 <= WS_MOD && WS_WIN + (size_t)NIN * PK * 2 <= WS_WOUT && WS_WOUT + (size_t)DM * PK * 2 <= WS_WGU && WS_WGU + (size_t)NGU * PK * 2 <= WS_WDN && WS_WDN + (size_t)DM * PF * 2 <= WS_WMOD && WS_WMOD + (size_t)NMOD * PK * 2 <= WS_H &&
              WS_H + (size_t)MTOT * PK * 2 <= WS_PROJ && WS_PROJ + (size_t)MTOT * NIN * 2 <= WS_MIX && WS_MIX + (size_t)MTOT * PK * 2 <= WS_X1 && WS_X1 + (size_t)MTOT * DM * 4 <= WS_GU &&
              WS_GU + (size_t)MTOT * NGU * 2 <= WS_SLAB && WS_ACT + (size_t)MTOT * PF * 2 <= WS_H && WS_MOD + (size_t)256 * NMOD * 4 <= WS_WIN, "d_ws map");
constexpr int CW_CONVQ = 1024  , CW_SCRDY = 1408  , CW_MODRDY = 1472  , CW_XRANK = 2048  , CW_BAR = 4096, CW_TICK = 16384, TICK_WORDS = 8192;
constexpr int RING_OFF = 0, RING_BYTES = 131072;
constexpr int LDSCTL_OFF = RING_BYTES, MISC_OFF = LDSCTL_OFF + 320;
constexpr int HALO_OFF = LDSCTL_OFF + 1024;
constexpr int LDS_BYTES = 147456;

typedef float f32x16 __attribute__((ext_vector_type(16)));
typedef float f32x2_t __attribute__((ext_vector_type(2)));
typedef __bf16 bf16x2_t __attribute__((ext_vector_type(2)));
typedef short s16x4 __attribute__((ext_vector_type(4)));
#define DI __device__ __forceinline__
DI int opaque_tid() { int t_ = threadIdx.x; asm volatile("" : "+v"(t_)); return t_; }
DI unsigned cvtpk(float lo, float hi) { f32x2_t v = {lo, hi}; bf16x2_t b = __builtin_convertvector(v, bf16x2_t); return __builtin_bit_cast(unsigned, b); }
DI float bf_lo(unsigned w) { return __uint_as_float(w << 16); }
DI float bf_hi(unsigned w) { return __uint_as_float(w & 0xffff0000u); }
DI void unpack8(const v4u w, float (&f)[8]) { f[0] = bf_lo(w.x); f[1] = bf_hi(w.x); f[2] = bf_lo(w.y); f[3] = bf_hi(w.y); f[4] = bf_lo(w.z); f[5] = bf_hi(w.z); f[6] = bf_lo(w.w); f[7] = bf_hi(w.w); }
DI v4u pack8(const float (&f)[8]) { v4u w; w.x = cvtpk(f[0], f[1]); w.y = cvtpk(f[2], f[3]); w.z = cvtpk(f[4], f[5]); w.w = cvtpk(f[6], f[7]); return w; }
DI float silu_f(float x) { return x / (1.0f + __expf(-x)); }

struct Frame {
    LAS unsigned char* lds;
    volatile LAS unsigned* MISC;
    gu32* ctl;
    int wave, vcu, G;
};
struct Args { const float* in[20]; float* out; unsigned char* ws; int ph_lo, ph_hi, li, pad; };

struct ConvMat { const float* W; bf16* WT; int K, N, ldt, gu_half; int f8 = 0; unsigned char* WT8 = nullptr; int ldt8 = 0; int c8fp = 0; };
DI int inproj_row(int n) {
    if (n < 2048) return ((n >> 6) << 8) + 128 + ((n >> 4) & 3) * 32 + ((n >> 2) & 3) * 8 + 4 + (n & 3);
    if (n < 2560) return 8192 + (n - 2048);
    const int reg = (n - 2560) >> 11, ch = (n - 2560) & 2047;
    return ((ch >> 6) << 8) + (reg == 2 ? 128 : 0) + ((ch >> 4) & 3) * 32 + ((ch >> 2) & 3) * 8 + (reg == 1 ? 4 : 0) + (ch & 3);
}
DI void tr_load(const ConvMat& m, int item, int lane, float (&v)[32]) {
    const int nblk = m.N / 32, kb = item / nblk, nb = item - kb * nblk;
    const GAS float* p = (const GAS float*)m.W + (size_t)(64 * kb + 32 * (lane >> 5)) * m.N + 32 * nb + (lane & 31);
#pragma unroll
    for (int i = 0; i < 32; ++i) v[i] = __builtin_nontemporal_load(p + (size_t)i * m.N);
}
DI void tr_store(const ConvMat& m, int item, int lane, const float (&v)[32], LAS unsigned* scr) {
    const int nblk = m.N / 32, kb = item / nblk, nb = item - kb * nblk, k0 = 64 * kb, n0 = 32 * nb;
    const int d0 = m.gu_half > 0 ? ((n0 < m.gu_half) ? ((n0 >> 7) * 256 + (n0 & 127)) : (((n0 - m.gu_half) >> 7) * 256 + 128 + ((n0 - m.gu_half) & 127))) : n0;
    LAS unsigned* sw = scr + (lane & 31) * 34 + 16 * (lane >> 5);
#pragma unroll
    for (int ip = 0; ip < 16; ++ip) sw[ip] = cvtpk(v[2 * ip], v[2 * ip + 1]);
    LDS_WAIT(); asm volatile("" ::: "memory");
    const int c = lane & 7;
#pragma unroll
    for (int j = 0; j < 4; ++j) { const int nn = (lane >> 3) + 8 * j; typedef unsigned u32x2 __attribute__((ext_vector_type(2)));
        const LAS u32x2* sp = (const LAS u32x2*)(scr + nn * 34 + 4 * c); const u32x2 x = sp[0], y = sp[1];
        const int drow = m.gu_half < 0 ? inproj_row(n0 + nn) : d0 + nn;
        *(GAS v4u*)(m.WT + (size_t)drow * m.ldt + k0 + 8 * c) = (v4u){x.x, x.y, y.x, y.y}; }
    LDS_WAIT(); asm volatile("" ::: "memory");
}
DI unsigned pack_fp8x4(float a, float b, float c, float d) {
    int w = 0;
    w = __builtin_amdgcn_cvt_pk_fp8_f32(__builtin_amdgcn_fmed3f(a, -448.0f, 448.0f), __builtin_amdgcn_fmed3f(b, -448.0f, 448.0f), w, false);
    w = __builtin_amdgcn_cvt_pk_fp8_f32(__builtin_amdgcn_fmed3f(c, -448.0f, 448.0f), __builtin_amdgcn_fmed3f(d, -448.0f, 448.0f), w, true);
    return (unsigned)w;
}
DI unsigned pack_i8x4(float a, float b, float c, float d) {
    const int ia = (int)__builtin_rintf(__builtin_amdgcn_fmed3f(a, -127.0f, 127.0f)), ib = (int)__builtin_rintf(__builtin_amdgcn_fmed3f(b, -127.0f, 127.0f));
    const int ic = (int)__builtin_rintf(__builtin_amdgcn_fmed3f(c, -127.0f, 127.0f)), id = (int)__builtin_rintf(__builtin_amdgcn_fmed3f(d, -127.0f, 127.0f));
    return ((unsigned)ia & 255u) | (((unsigned)ib & 255u) << 8) | (((unsigned)ic & 255u) << 16) | ((unsigned)id << 24);
}
DI void tr_store_f8(const ConvMat& m, int item, int lane, const float (&v)[32], LAS unsigned* scr) {
    const int nblk = m.N / 32, kb = item / nblk, nb = item - kb * nblk, k0 = 64 * kb, n0 = 32 * nb;
    const int d0 = m.gu_half > 0 ? ((n0 < m.gu_half) ? ((n0 >> 7) * 256 + (n0 & 127)) : (((n0 - m.gu_half) >> 7) * 256 + 128 + ((n0 - m.gu_half) & 127))) : n0;
    GAS unsigned char* dst = m.WT8 ? (GAS unsigned char*)m.WT8 : (GAS unsigned char*)m.WT; const int ld_ = m.WT8 ? m.ldt8 : m.ldt;
    LAS unsigned* sw = scr + (lane & 31) * 20 + 8 * (lane >> 5);
    const float S_ = m.WT8 ? (m.c8fp ? pg8::WOUT_PRESCALE : pg8::WGU_I8SCALE) : pg8::WDN_PRESCALE; const bool i8c_ = m.WT8 && !m.c8fp;
#pragma unroll
    for (int q = 0; q < 8; ++q) sw[q] = i8c_ ? pack_i8x4(v[4 * q] * S_, v[4 * q + 1] * S_, v[4 * q + 2] * S_, v[4 * q + 3] * S_) : pack_fp8x4(v[4 * q] * S_, v[4 * q + 1] * S_, v[4 * q + 2] * S_, v[4 * q + 3] * S_);
    LDS_WAIT(); asm volatile("" ::: "memory");
#pragma unroll
    for (int j = 0; j < 2; ++j) { const int p_ = lane + 64 * j, nn = p_ >> 2, c = p_ & 3;
        const v4u x = *(const LAS v4u*)(scr + nn * 20 + 4 * c);
        const int drow = m.gu_half < 0 ? inproj_row(n0 + nn) : d0 + nn;
        *(GAS v4u*)(dst + (size_t)drow * ld_ + k0 + 16 * c) = x; }
    LDS_WAIT(); asm volatile("" ::: "memory");
}
constexpr int I_IN = (DM / 64) * (NIN / 32), I_OUT = (DM / 64) * (DM / 32), I_GU = (DM / 64) * (NGU / 32), I_DN = (DFF / 64) * (DM / 32);
constexpr int I_DN_P5 = (I_DN / 4) & ~7;
constexpr int I_END0 = I_IN, I_END1 = I_IN + I_OUT, I_END2 = I_END1 + I_GU, I_END3 = I_END2 + I_DN;
DI ConvMat conv_mat(const Args& a, int& item) {
    unsigned char* ws = a.ws;
    const float* w0_ = a.in[12]; const float* w1_ = a.in[15]; const float* w2_ = a.in[16]; const float* w3_ = a.in[18];
    asm volatile("" : "+s"(w0_), "+s"(w1_), "+s"(w2_), "+s"(w3_));
    if (item < I_END0) return ConvMat{w0_, (bf16*)(ws + WS_WIN), DM, NIN, PK, -1, 0, ws + WS_WIN8, PKB};
    if (item < I_END1) { item -= I_END0; return ConvMat{w1_, (bf16*)(ws + WS_WOUT), DM, DM, PK, 0, 0, ws + WS_WOUT8A, 2 * PK, 1}; }
    if (item < I_END2) { item -= I_END1; return ConvMat{w2_, (bf16*)(ws + WS_WGU), DM, NGU, PK, DFF, 0, ws + WS_WGU8, PKB}; }
    item -= I_END2; return ConvMat{w3_, (bf16*)(ws + WS_WDN), DFF, DM, PFB, 0, 1};
}
struct PairRegs { float a[32], b[32]; };
DI void pair_load(const Args& a, int it, int hi, int lane, PairRegs& r) {
    int ia = it, ib = (it + 1 < hi) ? it + 1 : it;
    const ConvMat ma = conv_mat(a, ia), mb = conv_mat(a, ib);
    tr_load(ma, ia, lane, r.a); tr_load(mb, ib, lane, r.b);
}
DI void pair_store(const Args& a, int it, int hi, int lane, const PairRegs& r, LAS unsigned* scrA, LAS unsigned* scrB) {
    int ia = it, ib = it + 1; const bool hasb = ib < hi; if (!hasb) ib = it;
    const ConvMat ma = conv_mat(a, ia), mb = conv_mat(a, ib);
    if (ma.f8) tr_store_f8(ma, ia, lane, r.a, scrA); else { tr_store(ma, ia, lane, r.a, scrA); if (ma.WT8) tr_store_f8(ma, ia, lane, r.a, scrA); }
    if (hasb) { if (mb.f8) tr_store_f8(mb, ib, lane, r.b, scrB); else { tr_store(mb, ib, lane, r.b, scrB); if (mb.WT8) tr_store_f8(mb, ib, lane, r.b, scrB); } }
}
DI void convert_range(const Args& a, LAS unsigned char* lds_wave  , int lo, int hi, int w, int nw) {
    LAS unsigned* scrA = (LAS unsigned*)lds_wave; LAS unsigned* scrB = scrA + 32 * 34;
    int it = lo + 2 * w; if (it >= hi) return;
    const int lane = opaque_tid() & 63;
    PairRegs p0, p1;
    pair_load(a, it, hi, lane, p0);
    for (;;) {
        int nx = it + 2 * nw; bool more = nx < hi;
        pair_load(a, more ? nx : it, hi, lane, p1); __builtin_amdgcn_sched_barrier(0);
        pair_store(a, it, hi, lane, p0, scrA, scrB);
        if (!more) break;
        it = nx; nx = it + 2 * nw; more = nx < hi;
        pair_load(a, more ? nx : it, hi, lane, p0); __builtin_amdgcn_sched_barrier(0);
        pair_store(a, it, hi, lane, p1, scrA, scrB);
        if (!more) break;
        it = nx;
    }
}
DI unsigned cq_claim_n(unsigned* head, int lane, unsigned n) { unsigned t = 0u; if (lane == 0) t = __hip_atomic_fetch_add(head, n, __ATOMIC_RELAXED, __HIP_MEMORY_SCOPE_AGENT); return t; }
DI unsigned cq_claim(unsigned* head, int lane) { unsigned t = 0u; if (lane == 0) t = __hip_atomic_fetch_add(head, 8u, __ATOMIC_RELAXED, __HIP_MEMORY_SCOPE_AGENT); return t; }
DI void convert_queue(const Args& a, LAS unsigned char* lds_wave, int lo, int hi, unsigned* head) {
    LAS unsigned* scrA = (LAS unsigned*)lds_wave; LAS unsigned* scrB = scrA + 32 * 34;
    const int lane = opaque_tid() & 63;
    int base = lo + __builtin_amdgcn_readfirstlane((int)cq_claim(head, lane));
    if (base >= hi) return;
    unsigned pend = cq_claim(head, lane);
    int q = 0;
#define CQ_ADVANCE(vb, vq, ok) do { ok = true; if (vq < 3 && vb + 2 * (vq + 1) < hi) { vq = vq + 1; } else { vb = lo + __builtin_amdgcn_readfirstlane((int)pend); vq = 0; ok = vb < hi; if (ok) pend = cq_claim(head, lane); } } while (0)
    PairRegs p0, p1;
    pair_load(a, base, hi, lane, p0);
    for (;;) {
        int nb_ = base, nq_ = q; bool ok; CQ_ADVANCE(nb_, nq_, ok);
        pair_load(a, ok ? nb_ + 2 * nq_ : base + 2 * q, hi, lane, p1); __builtin_amdgcn_sched_barrier(0);
        pair_store(a, base + 2 * q, hi, lane, p0, scrA, scrB);
        if (!ok) break;
        base = nb_; q = nq_; CQ_ADVANCE(nb_, nq_, ok);
        pair_load(a, ok ? nb_ + 2 * nq_ : base + 2 * q, hi, lane, p0); __builtin_amdgcn_sched_barrier(0);
        pair_store(a, base + 2 * q, hi, lane, p1, scrA, scrB);
        if (!ok) break;
        base = nb_; q = nq_;
    }
#undef CQ_ADVANCE
}
DI void p0_prologue(Frame& F, const Args& a) {
    const int lane_ = opaque_tid() & 63;
    const int gw = F.vcu * NWAVES + F.wave, NGW = F.G * NWAVES;
    unsigned char* ws = a.ws;
    bf16* SC = (bf16*)(ws + WS_SC);
    for (int m = gw; m < 256; m += NGW) {
        const float* crow_ = m < 2 ? a.in[6] + (size_t)m * DM : a.in[7] + (size_t)(m - 2) * DM;
        unsigned long long* o8 = (unsigned long long*)(SC + (size_t)m * PK) + lane_;
        f32x4 cv_[16];
#pragma unroll
        for (int j = 0; j < 16; ++j) cv_[j] = (m < NCOND) ? ((const GAS f32x4*)crow_)[lane_ + 64 * j] : (f32x4){0.f, 0.f, 0.f, 0.f};
        __builtin_amdgcn_sched_barrier(0);
#pragma unroll
        for (int j = 0; j < 16; ++j) { const f32x4 v = cv_[j];
            __hip_atomic_store(o8 + 64 * j, (m < NCOND) ? ((unsigned long long)cvtpk(silu_f(v.x), silu_f(v.y)) | ((unsigned long long)cvtpk(silu_f(v.z), silu_f(v.w)) << 32)) : 0ull, __ATOMIC_RELAXED, __HIP_MEMORY_SCOPE_AGENT); }
        asm volatile("s_waitcnt vmcnt(0)" ::: "memory");
        if (lane_ == 0) (void)__hip_atomic_fetch_add((unsigned*)(F.ctl + CW_SCRDY), 1u, __ATOMIC_RELAXED, __HIP_MEMORY_SCOPE_AGENT);
    }
    convert_range(a, F.lds + RING_OFF + F.wave * 16384, 0, I_END0, gw, NGW);
}

DI void row_load(const float* xrow, int lane, f32x4 (&v)[16]) {
    const GAS f32x4* xr = (const GAS f32x4*)xrow + lane;
#pragma unroll
    for (int j = 0; j < 16; ++j) v[j] = xr[64 * j];
}
DI void row_load_bf16(const bf16* xrow, int lane, f32x4 (&v)[16]) {
    const GAS unsigned long long* xr = (const GAS unsigned long long*)xrow + lane;
#pragma unroll
    for (int j = 0; j < 16; ++j) { const unsigned long long w = xr[64 * j]; v[j] = (f32x4){bf_lo((unsigned)w), bf_hi((unsigned)w), bf_lo((unsigned)(w >> 32)), bf_hi((unsigned)(w >> 32))}; }
}
DI float row_rstd(const f32x4 (&v)[16]) {
    float s = 0.f;
#pragma unroll
    for (int j = 0; j < 16; ++j) s += (v[j].x * v[j].x + v[j].y * v[j].y) + (v[j].z * v[j].z + v[j].w * v[j].w);
    return 1.0f / sqrtf(wave_sum(s) * (1.0f / DM) + RMS_EPS);
}
DI void row_store_mod_bf16(f32x4 (&v)[16], float rstd, const float* g, const float* shift, const float* scale, bf16* orow, int lane, unsigned char* orow8 = nullptr, float* hs = nullptr, bf16* orowx = nullptr  ) {
    GAS unsigned long long* o8 = (GAS unsigned long long*)orow + lane; GAS unsigned* o4 = (GAS unsigned*)orow8 + lane;
    const bool i8 = orow8 != nullptr; float mx = 0.f;
#pragma unroll
    for (int j0 = 0; j0 < 16; j0 += 4) {
        f32x4 gg[4], sc[4], sh[4];
#pragma unroll
        for (int j = 0; j < 4; ++j) { gg[j] = ((const GAS f32x4*)g)[lane + 64 * (j0 + j)]; sc[j] = ((const GAS f32x4*)scale)[lane + 64 * (j0 + j)]; sh[j] = ((const GAS f32x4*)shift)[lane + 64 * (j0 + j)]; }
        __builtin_amdgcn_sched_barrier(0);
#pragma unroll
        for (int j = 0; j < 4; ++j) { const f32x4 o = (v[j0 + j] * rstd) * gg[j] * (sc[j] + 1.0f) + sh[j]; v[j0 + j] = o;
            mx = fmaxf(fmaxf(mx, fmaxf(fabsf(o.x), fabsf(o.y))), fmaxf(fabsf(o.z), fabsf(o.w))); }
        __builtin_amdgcn_sched_barrier(0);
    }
    if (i8) {
#pragma unroll
        for (int d = 32; d >= 1; d >>= 1) mx = fmaxf(mx, __shfl_xor(mx, d));
        const float inv = mx > 0.f ? 127.0f / mx : 0.f;
        if (lane == 0) *hs = mx * (1.0f / 127.0f);
#pragma unroll
        for (int j = 0; j < 16; ++j) o4[64 * j] = pack_i8x4(v[j].x * inv, v[j].y * inv, v[j].z * inv, v[j].w * inv);
        if (orowx) { GAS unsigned long long* ox = (GAS unsigned long long*)orowx + lane;
#pragma unroll
            for (int j = 0; j < 16; ++j) ox[64 * j] = (unsigned long long)cvtpk(v[j].x, v[j].y) | ((unsigned long long)cvtpk(v[j].z, v[j].w) << 32); }
    } else {
#pragma unroll
        for (int j = 0; j < 16; ++j) o8[64 * j] = (unsigned long long)cvtpk(v[j].x, v[j].y) | ((unsigned long long)cvtpk(v[j].z, v[j].w) << 32);
    }
}
DI int cond_of_row(int row) { return row < NTOKP ? (row >> 12) : 2 + ((row - NTOKP) >> 3); }
template <int SRC, int SLOT> DI void norm_mod_phase(const Args& a, const bf16* X1, const float* MOD, const float* g, bf16* H, int gw, int NGW, int lane, unsigned char* H8 = nullptr  , float* HS = nullptr  , bf16* HST = nullptr) {
    auto ldrow = [&](int m, f32x4 (&v)[16]) { if (SRC == 1) row_load_bf16(X1 + (size_t)m * DM, lane, v); else row_load(m < NTOKP ? a.in[0] + (size_t)m * DM : a.in[1] + (size_t)(m - NTOKP) * DM, lane, v); };
    f32x4 cur[16], nxt[16];
    int m = gw; if (m >= MTOT) return;
    ldrow(m, cur);
    for (;;) {
        const int mn = m + NGW; const bool more = mn < MTOT;
        ldrow(more ? mn : m, nxt);
        const float rstd = row_rstd(cur);
        const float* mod = MOD + (size_t)cond_of_row(m) * NMOD;
        { const int pm_ = m >> 8; const bool q8_ = H8 && (SRC == 1 ? (pm_ != 15 && pm_ != 31) : i8_panel(pm_));
          bf16* ox_ = (SRC == 1 && HST && m >= NTOKP && ((m & 7) >= 6)) ? HST + (size_t)(2 * ((m - NTOKP) >> 3) + ((m & 7) - 6)) * PK : nullptr;
          row_store_mod_bf16(cur, rstd, g, mod + SLOT * DM, mod + (SLOT + 1) * DM, H + (size_t)m * PK, lane, q8_ ? H8 + (size_t)m * PKB : nullptr, HS ? HS + m : nullptr, ox_); }
        if (!more) break;
#pragma unroll
        for (int j = 0; j < 16; ++j) cur[j] = nxt[j];
        m = mn;
    }
}
DI void final_norm_phase(const bf16* X2, float* Y, const float* g, int gw, int NGW, int lane) {
    f32x4 cur[16], nxt[16];
    int m = gw; if (m >= MTOT) return;
    row_load_bf16(X2 + (size_t)m * DM, lane, cur);
    for (;;) {
        const int mn = m + NGW; const bool more = mn < MTOT;
        row_load_bf16(X2 + (size_t)(more ? mn : m) * DM, lane, nxt);
        const float rstd = row_rstd(cur);
        GAS f32x4* xr = (GAS f32x4*)(Y + (size_t)m * DM) + lane;
#pragma unroll
        for (int j0 = 0; j0 < 16; j0 += 8) {
            f32x4 gg[8];
#pragma unroll
            for (int j = 0; j < 8; ++j) gg[j] = ((const GAS f32x4*)g)[lane + 64 * (j0 + j)];
            __builtin_amdgcn_sched_barrier(0);
#pragma unroll
            for (int j = 0; j < 8; ++j) xr[64 * (j0 + j)] = (cur[j0 + j] * rstd) * gg[j];
            __builtin_amdgcn_sched_barrier(0);
        }
        if (!more) break;
#pragma unroll
        for (int j = 0; j < 16; ++j) cur[j] = nxt[j];
        m = mn;
    }
}

namespace att {
constexpr int KROW = 72, VROW = 260;
constexpr int VT_OFF = 256 * KROW * 2;
constexpr float C2 = 0.125f * LOG2E;
DI int crow(int i, int h) { return (i & 3) + 8 * (i >> 2) + 4 * h; }
#define ATT_MFMA(a, b, c) __builtin_amdgcn_mfma_f32_32x32x16_bf16((a), (b), (c), 0, 0, 0)
template <bool GENERIC> DI float softmax5(f32x16 (&sc)[5], int kb0, int jmin, int jmax, float sink2, int h, bf16x8 (&pf)[5][2]) {
    float mx = -INFINITY;
#pragma unroll
    for (int b = 0; b < 5; ++b)
#pragma unroll
        for (int i = 0; i < 16; ++i) { const int j = 32 * (kb0 + b) + crow(i, h);
            if (GENERIC) { if (!(j >= jmin && j <= jmax)) sc[b][i] = -INFINITY; }
            else { if (b == 0) { if (j < jmin) sc[b][i] = -INFINITY; } if (b == 4) { if (j > jmax) sc[b][i] = -INFINITY; } }
            mx = fmaxf(mx, sc[b][i]); }
    mx = fmaxf(mx, __shfl_xor(mx, 32));
    const float m2 = fmaxf(mx * C2, sink2);
    float sum = 0.f;
#pragma unroll
    for (int b = 0; b < 5; ++b)
#pragma unroll
        for (int i = 0; i < 16; ++i) { const float p = __builtin_amdgcn_exp2f(__builtin_fmaf(sc[b][i], C2, -m2)); sc[b][i] = p; sum += p; }
    sum += __shfl_xor(sum, 32); sum += __builtin_amdgcn_exp2f(sink2 - m2);
#pragma unroll
    for (int b = 0; b < 5; ++b)
#pragma unroll
        for (int s = 0; s < 2; ++s) { v4u w; w.x = cvtpk(sc[b][8 * s], sc[b][8 * s + 1]); w.y = cvtpk(sc[b][8 * s + 2], sc[b][8 * s + 3]);
            w.z = cvtpk(sc[b][8 * s + 4], sc[b][8 * s + 5]); w.w = cvtpk(sc[b][8 * s + 6], sc[b][8 * s + 7]); pf[b][s] = __builtin_bit_cast(bf16x8, w); }
    return 1.0f / sum;
}
DI void store_o(const f32x16& o, unsigned char* orow, int dblk, int h) {
    constexpr float S_ = pg8::ATT_PRESCALE;
#pragma unroll
    for (int g = 0; g < 4; ++g) *(GAS unsigned*)(orow + 32 * dblk + 8 * g + 4 * h) = pack_fp8x4(o[4 * g] * S_, o[4 * g + 1] * S_, o[4 * g + 2] * S_, o[4 * g + 3] * S_);
}
DI void q_load(const bf16* qp, int h, bf16x8 (&qf)[4]) {
#pragma unroll
    for (int d0 = 0; d0 < 4; ++d0) qf[d0] = *(const GAS bf16x8*)(qp + 16 * d0 + 8 * h);
}
template <int VR, bool GENERIC> DI void lds_chunk(const LAS bf16* Kl, const LAS bf16* Vt, int kb0, int jmin, int jmax, float sink2, const bf16x8 (&qf)[4], unsigned char* op, int r, int h) {
    const f32x16 zero = {};
    f32x16 sc[5];
#pragma unroll
    for (int b = 0; b < 5; ++b) {
        const LAS bf16* kp = Kl + ((kb0 + b) * 32 + r) * KROW + 8 * h;
#pragma unroll
        for (int d0 = 0; d0 < 4; ++d0) { const bf16x8 a = *(const LAS bf16x8*)(kp + 16 * d0); sc[b] = ATT_MFMA(a, qf[d0], d0 == 0 ? zero : sc[b]); }
    }
    bf16x8 pf[5][2];
    const float inv = softmax5<GENERIC>(sc, kb0, jmin, jmax, sink2, h, pf);
#pragma unroll
    for (int dblk = 0; dblk < 2; ++dblk) {
        f32x16 o = zero;
#pragma unroll
        for (int b = 0; b < 5; ++b)
#pragma unroll
            for (int s = 0; s < 2; ++s) {
                const LAS bf16* vp = Vt + (dblk * 32 + r) * VR + (kb0 + b) * 32 + 16 * s + 4 * h;
                const s16x4 lo = *(const LAS s16x4*)vp, hi = *(const LAS s16x4*)(vp + 8);
                const bf16x8 a = __builtin_shufflevector(lo, hi, 0, 1, 2, 3, 4, 5, 6, 7);
                o = ATT_MFMA(a, pf[b][s], o);
            }
        o = o * inv;
        store_o(o, op, dblk, h);
    }
}
DI void vt_scatter(LAS bf16* vd, int VR, const v4u vvv) {
    vd[0 * VR] = (bf16)(vvv.x & 0xffffu); vd[1 * VR] = (bf16)(vvv.x >> 16); vd[2 * VR] = (bf16)(vvv.y & 0xffffu); vd[3 * VR] = (bf16)(vvv.y >> 16);
    vd[4 * VR] = (bf16)(vvv.z & 0xffffu); vd[5 * VR] = (bf16)(vvv.z >> 16); vd[6 * VR] = (bf16)(vvv.w & 0xffffu); vd[7 * VR] = (bf16)(vvv.w >> 16);
}
DI void prompt_unit(LAS unsigned char* lds, const bf16* PROJ, unsigned char* MIX, const float* sinks, int n, int blk, int kv, int tid) {
    const int lane = tid & 63, w = __builtin_amdgcn_readfirstlane(tid >> 6), r = lane & 31, h = lane >> 5;
    LAS bf16* Kl = (LAS bf16*)lds; LAS bf16* Vt = (LAS bf16*)(lds + VT_OFF);
    v4u kst[4], vst[4];
#pragma unroll
    for (int i = 0; i < 4; ++i) {
        const int c = tid + 512 * i, key = c >> 3, ch = c & 7, kpos = blk * 128 - 128 + key;
        const bf16* src = PROJ + (size_t)(n * SEQ + (kpos < 0 ? 0 : kpos)) * NPR + kv * 64 + ch * 8; kst[i] = *(const GAS v4u*)(src + COL_K); vst[i] = *(const GAS v4u*)(src + COL_V);
    }
    __builtin_amdgcn_sched_barrier(0);
#pragma unroll
    for (int i = 0; i < 4; ++i) {
        const int c = tid + 512 * i, key = c >> 3, ch = c & 7, kpos = blk * 128 - 128 + key;
        const v4u z = (v4u){0u, 0u, 0u, 0u};
        *(LAS v4u*)(Kl + key * KROW + ch * 8) = kpos < 0 ? z : kst[i];
        vt_scatter(Vt + (ch * 8) * VROW + key, VROW, kpos < 0 ? z : vst[i]);
    }
    const int hq = kv * 8 + w; const float sink2 = sinks[hq] * LOG2E;
    const bf16* qbase = PROJ + (size_t)(n * SEQ + blk * 128 + r) * NPR + hq * 64;
    unsigned char* obase = MIX + (size_t)(n * SEQ + blk * 128 + r) * (2 * PK) + hq * 64;
    bf16x8 qc[4], qn[4];
    q_load(qbase, h, qn);
    __syncthreads();
#pragma unroll 1
    for (int c = 0; c < 4; ++c) {
#pragma unroll
        for (int d0 = 0; d0 < 4; ++d0) qc[d0] = qn[d0];
        q_load(qbase + (size_t)(32 * ((c + 1) & 3)) * NPR, h, qn);
        const int qi = 32 * c + r;
        if (blk == 0) lds_chunk<VROW, true>(Kl, Vt, c, 128, qi + 128, sink2, qc, obase + (size_t)(32 * c) * (2 * PK), r, h);
        else lds_chunk<VROW, false>(Kl, Vt, c, qi, qi + 128, sink2, qc, obase + (size_t)(32 * c) * (2 * PK), r, h);
    }
    __syncthreads();
}
constexpr int KS_BYTES = 160 * KROW * 2, VROW_S = 172, VS_OFF = 2 * KS_BYTES, VS_BYTES = 64 * VROW_S * 2;
DI void sample_unit(LAS unsigned char* lds, const bf16* PROJ, const float* ck, const float* cv, unsigned char* MIX, const float* sinks, int s, int kp, int tid) {
    const int lane = tid & 63, w = __builtin_amdgcn_readfirstlane(tid >> 6), r = lane & 31, h = lane >> 5;
    f32x4 kf[5][2], vf[5][2]; v4u kb_[5], vb_[5];
#pragma unroll
    for (int i = 0; i < 5; ++i) {
        const int c = tid + 512 * i, kvl = c / 1280, rem = c - kvl * 1280, key = rem >> 3, ch = rem & 7, kv = kp * 2 + kvl;
        const size_t o = ((size_t)(s * 128 + (key < 128 ? key : 127)) * 4 + kv) * 64 + ch * 8;
        kf[i][0] = *(const GAS f32x4*)(ck + o); kf[i][1] = *(const GAS f32x4*)(ck + o + 4); vf[i][0] = *(const GAS f32x4*)(cv + o); vf[i][1] = *(const GAS f32x4*)(cv + o + 4);
        if (i == 2 || i == 4) { const int nk = (key >= 128 && key < 136) ? key - 128 : 0;     const bf16* src = PROJ + (size_t)(NTOKP + s * 8 + nk) * NPR + kv * 64 + ch * 8; kb_[i] = *(const GAS v4u*)(src + COL_K); vb_[i] = *(const GAS v4u*)(src + COL_V); }
    }
    __builtin_amdgcn_sched_barrier(0);
#pragma unroll
    for (int i = 0; i < 5; ++i) {
        const int c = tid + 512 * i, kvl = c / 1280, rem = c - kvl * 1280, key = rem >> 3, ch = rem & 7;
        v4u kvv = (v4u){cvtpk(kf[i][0].x, kf[i][0].y), cvtpk(kf[i][0].z, kf[i][0].w), cvtpk(kf[i][1].x, kf[i][1].y), cvtpk(kf[i][1].z, kf[i][1].w)};
        v4u vvv = (v4u){cvtpk(vf[i][0].x, vf[i][0].y), cvtpk(vf[i][0].z, vf[i][0].w), cvtpk(vf[i][1].x, vf[i][1].y), cvtpk(vf[i][1].z, vf[i][1].w)};
        if (i == 2 || i == 4) { const v4u z = (v4u){0u, 0u, 0u, 0u}; kvv = key < 128 ? kvv : (key < 136 ? kb_[i] : z); vvv = key < 128 ? vvv : (key < 136 ? vb_[i] : z); }
        *(LAS v4u*)((LAS bf16*)(lds + kvl * KS_BYTES) + key * KROW + ch * 8) = kvv;
        vt_scatter((LAS bf16*)(lds + VS_OFF + kvl * VS_BYTES) + (ch * 8) * VROW_S + key, VROW_S, vvv);
    }
    const int kvl_ = (w >> 1) & 1, c_ = w & 1, kv_ = kp * 2 + kvl_, rho_ = 32 * c_ + r, g_ = rho_ >> 3, t_ = rho_ & 7, hq_ = kv_ * 8 + g_;
    const size_t qrow_ = (size_t)(NTOKP + s * 8 + t_);
    bf16x8 qf[4]; q_load(PROJ + qrow_ * NPR + hq_ * 64, h, qf);
    const float sink2_ = sinks[hq_] * LOG2E;
    __syncthreads();
    if (w < 4) lds_chunk<VROW_S, false>((const LAS bf16*)(lds + kvl_ * KS_BYTES), (const LAS bf16*)(lds + VS_OFF + kvl_ * VS_BYTES), 0, t_, 128 + t_, sink2_, qf, MIX + qrow_ * (2 * PK) + hq_ * 64, r, h);
    __syncthreads();
}
}

DI void convfix_item(const Args& a, const float* SB2, bf16* MIX, int ti, int cg, int lane) {
    const int pm = 1 + ti + (ti >= 15 ? 1 : 0), ch = cg * 512 + lane * 8;
    const float* cw = a.in[13];
    const float* cur = SB2 + (size_t)pm * 6 * DCONV + ch; const float* prv = SB2 + (size_t)(pm - 1) * 6 * DCONV + ch;
    float o0[8], o1[8];
#pragma unroll
    for (int e = 0; e < 8; ++e) {
        const float w0 = cw[ch + e], w1 = cw[DCONV + ch + e], w2 = cw[2 * DCONV + ch + e];
        const float um2 = prv[4 * DCONV + e], um1 = prv[5 * DCONV + e], u0 = cur[e], u1 = cur[DCONV + e], b0 = cur[2 * DCONV + e], b1 = cur[3 * DCONV + e];
        o0[e] = b0 * (w0 * um2 + w1 * um1 + w2 * u0); o1[e] = b1 * (w0 * um1 + w1 * u0 + w2 * u1);
    }
    *(GAS v4u*)(MIX + (size_t)(pm * 256) * PK + DCONV + ch) = pack8(o0);
    *(GAS v4u*)(MIX + (size_t)(pm * 256 + 1) * PK + DCONV + ch) = pack8(o1);
}
DI void kvcopy_queue(const Args& a, unsigned* head) {
    const int lane = opaque_tid() & 63;
    for (;;) {
        const int base = __builtin_amdgcn_readfirstlane((int)cq_claim_n(head, lane, 32u));
        if (base >= 30720) break;
#pragma unroll 1
        for (int q0 = 0; q0 < 32; q0 += 8) {
            f32x4 v[8]; float* dst[8];
#pragma unroll
            for (int q = 0; q < 8; ++q) { const int r = base + q0 + q, tsr = r / 15360, rr = r - tsr * 15360, s_ = rr / 120, i = rr - s_ * 120;
                v[q] = ((const GAS f32x4*)((tsr ? a.in[3] : a.in[2]) + (size_t)(s_ * 128 + i + 8) * 256))[lane];
                dst[q] = a.out + (tsr ? O_VS : O_KS) + (size_t)(s_ * 128 + i) * 256; }
            __builtin_amdgcn_sched_barrier(0);
#pragma unroll
            for (int q = 0; q < 8; ++q) ((GAS f32x4*)dst[q])[lane] = v[q];
        }
    }
}
DI void kvstate_item4(const Args& a, const bf16* PROJ, int it, int lane) {
    unsigned long long vb_[4]; float* dst[4];
#pragma unroll
    for (int q = 0; q < 4; ++q) {
        const bf16* sb_;
        if (it < 128) { const int tsr = it >> 6, n = (it >> 5) & 1, i = 4 * (it & 31) + q;
            sb_ = PROJ + (size_t)(n * SEQ + SEQ - 128 + i) * NPR + (tsr ? COL_V : COL_K); dst[q] = a.out + (tsr ? O_VP : O_KP) + (size_t)(n * 128 + i) * 256; }
        else { const int j = it - 128, tsr = j >> 8, s_ = (j >> 1) & 127, i = 4 * (j & 1) + q;
            sb_ = PROJ + (size_t)(NTOKP + s_ * 8 + i) * NPR + (tsr ? COL_V : COL_K); dst[q] = a.out + (tsr ? O_VS : O_KS) + (size_t)(s_ * 128 + 120 + i) * 256; }
        vb_[q] = ((const GAS unsigned long long*)sb_)[lane];
    }
    __builtin_amdgcn_sched_barrier(0);
#pragma unroll
    for (int q = 0; q < 4; ++q) { const unsigned long long w = vb_[q];
        ((GAS f32x4*)dst[q])[lane] = (f32x4){bf_lo((unsigned)w), bf_hi((unsigned)w), bf_lo((unsigned)(w >> 32)), bf_hi((unsigned)(w >> 32))}; }
}
DI void fixup_item(const Args& a, const float* SB, unsigned char* ACT, int ti, int cg, int lane) {
    const int pm = 1 + ti + (ti >= 15 ? 1 : 0), ch = cg * 512 + lane * 8;
    if (ch >= DFF) return;
    const float* cw = a.in[17];
    const float* cur = SB + (size_t)pm * 6 * DFF + ch; const float* prv = SB + (size_t)(pm - 1) * 6 * DFF + ch;
    float o0[8], o1[8];
#pragma unroll
    for (int e = 0; e < 8; ++e) {
        const float w0 = cw[ch + e], w1 = cw[DFF + ch + e], w2 = cw[2 * DFF + ch + e];
        const float gm2 = prv[4 * DFF + e], gm1 = prv[5 * DFF + e], g0 = cur[e], g1 = cur[DFF + e], u0 = cur[2 * DFF + e], u1 = cur[3 * DFF + e];
        o0[e] = silu_f(w0 * gm2 + w1 * gm1 + w2 * g0) * u0; o1[e] = silu_f(w0 * gm1 + w1 * g0 + w2 * g1) * u1;
    }
    constexpr float S_ = pg8::ACT_PRESCALE; typedef unsigned u32x2_ __attribute__((ext_vector_type(2)));
    *(GAS u32x2_*)(ACT + (size_t)(pm * 256) * PFB + ch) = (u32x2_){pack_fp8x4(o0[0] * S_, o0[1] * S_, o0[2] * S_, o0[3] * S_), pack_fp8x4(o0[4] * S_, o0[5] * S_, o0[6] * S_, o0[7] * S_)};
    *(GAS u32x2_*)(ACT + (size_t)(pm * 256 + 1) * PFB + ch) = (u32x2_){pack_fp8x4(o1[0] * S_, o1[1] * S_, o1[2] * S_, o1[3] * S_), pack_fp8x4(o1[4] * S_, o1[5] * S_, o1[6] * S_, o1[7] * S_)};
}
typedef float f32x2v __attribute__((ext_vector_type(2)));
constexpr int MODA_ROW = 144  , MODA_SLOT = 144 * MODA_ROW;
template <bool ACTIVE> DI void mod_phase_wave(const Args& a, const bf16* SC, float* MOD, LAS unsigned char* lds, int nb, int tid, unsigned* rdy  ) {
    const int lane = tid & 63, c = lane & 15, kq = lane >> 4;
    constexpr int NAP = ACTIVE ? 1 : 4;
    unsigned asrc[NAP], adst[NAP];
#pragma unroll
    for (int i = 0; i < NAP; ++i) { int p_ = (tid - 192) + 320 * i; p_ = p_ < 0 ? 0 : (p_ > 1151 ? 1151 : p_); asrc[i] = (unsigned)((p_ >> 3) * PK + (p_ & 7) * 8) * 2u; adst[i] = (unsigned)((p_ >> 3) * MODA_ROW + (p_ & 7) * 16); }
    const GAS char* scb = (const GAS char*)SC;
    const int n0 = nb * 32;
    const GAS char* wb = (const GAS char*)(a.in[8] + n0);
    const unsigned woff = (unsigned)((8 * kq) * NMOD + 2 * c) * 4u;
    const unsigned aoff = (unsigned)(c * MODA_ROW + 16 * kq);
    f32x4 acc[9][2];
#pragma unroll
    for (int mb = 0; mb < 9; ++mb) { acc[mb][0] = (f32x4){0.f, 0.f, 0.f, 0.f}; acc[mb][1] = (f32x4){0.f, 0.f, 0.f, 0.f}; }
    v4u ap[3][NAP]; f32x2v br[3][2][8];
#define MOD_ISSUE(slot, q) do { if (!ACTIVE) { _Pragma("unroll") for (int i = 0; i < NAP; ++i) ap[slot][i] = *(const GAS v4u*)(scb + (size_t)(q) * 128 + asrc[i]); } \
        if (ACTIVE) { _Pragma("unroll") for (int ks = 0; ks < 2; ++ks) { const GAS char* p_ = wb + (size_t)((q) * 2 + ks) * 32 * NMOD * 4; \
            _Pragma("unroll") for (int j = 0; j < 8; ++j) br[slot][ks][j] = __builtin_nontemporal_load((const GAS f32x2v*)(p_ + (size_t)j * NMOD * 4 + woff)); } } \
        __builtin_amdgcn_sched_barrier(0); } while (0)
#define MOD_CHUNK(u, q) do { \
        LAS unsigned char* slot = lds + ((q) & 3) * MODA_SLOT; \
        if (!ACTIVE) { _Pragma("unroll") for (int i = 0; i < NAP; ++i) *(LAS v4u*)(slot + adst[i]) = ap[u][i]; } \
        asm volatile("s_waitcnt lgkmcnt(0)" ::: "memory"); __builtin_amdgcn_s_barrier(); asm volatile("" ::: "memory"); \
        if (ACTIVE) { _Pragma("unroll") for (int ks = 0; ks < 2; ++ks) { \
            v4u w0, w1; \
            w0.x = cvtpk(br[u][ks][0].x, br[u][ks][1].x); w0.y = cvtpk(br[u][ks][2].x, br[u][ks][3].x); w0.z = cvtpk(br[u][ks][4].x, br[u][ks][5].x); w0.w = cvtpk(br[u][ks][6].x, br[u][ks][7].x); \
            w1.x = cvtpk(br[u][ks][0].y, br[u][ks][1].y); w1.y = cvtpk(br[u][ks][2].y, br[u][ks][3].y); w1.z = cvtpk(br[u][ks][4].y, br[u][ks][5].y); w1.w = cvtpk(br[u][ks][6].y, br[u][ks][7].y); \
            const bf16x8 b0 = __builtin_bit_cast(bf16x8, w0), b1 = __builtin_bit_cast(bf16x8, w1); \
            _Pragma("unroll") for (int mb = 0; mb < 9; ++mb) { const bf16x8 af = *(const LAS bf16x8*)(slot + mb * 16 * MODA_ROW + ks * 64 + aoff); \
                acc[mb][0] = __builtin_amdgcn_mfma_f32_16x16x32_bf16(af, b0, acc[mb][0], 0, 0, 0); acc[mb][1] = __builtin_amdgcn_mfma_f32_16x16x32_bf16(af, b1, acc[mb][1], 0, 0, 0); } } } \
        __builtin_amdgcn_sched_barrier(0); \
        { const int qn_ = ((q) + 3 < 64) ? (q) + 3 : 63; MOD_ISSUE(u, qn_); } } while (0)
    MOD_ISSUE(0, 0); MOD_ISSUE(1, 1); MOD_ISSUE(2, 2);
    for (int q0 = 0; q0 < 63; q0 += 3) { MOD_CHUNK(0, q0); MOD_CHUNK(1, q0 + 1); MOD_CHUNK(2, q0 + 2); }
    MOD_CHUNK(0, 63);
#undef MOD_CHUNK
#undef MOD_ISSUE
    if (ACTIVE) {
        const f32x2v bias = *(const GAS f32x2v*)(a.in[9] + n0 + 2 * c);
#pragma unroll
        for (int mb = 0; mb < 9; ++mb)
#pragma unroll
            for (int i = 0; i < 4; ++i) { const int row = mb * 16 + 4 * kq + i;
                if (row < NCOND) { const f32x2v o_ = (f32x2v){acc[mb][0][i] + bias.x, acc[mb][1][i] + bias.y};
                    __hip_atomic_store((unsigned long long*)(MOD + (size_t)row * NMOD + n0 + 2 * c), __builtin_bit_cast(unsigned long long, o_), __ATOMIC_RELAXED, __HIP_MEMORY_SCOPE_AGENT); } }
        asm volatile("s_waitcnt vmcnt(0)" ::: "memory");
        if (rdy && lane == 0) (void)__hip_atomic_fetch_add(rdy, 1u, __ATOMIC_RELAXED, __HIP_MEMORY_SCOPE_AGENT);
    }
}

#ifndef MK_PER_PHASE
#define MK_PER_PHASE 0
#endif
constexpr int NPHASE = 11;
__global__ void __launch_bounds__(NWAVES * 64, 2) mega_fwd(Args args) {
    extern __shared__ __attribute__((aligned(16))) unsigned char lds[];
    Frame F;
    F.lds = (LAS unsigned char*)lds;
    F.MISC = (volatile LAS unsigned*)(F.lds + MISC_OFF);
    F.wave = __builtin_amdgcn_readfirstlane((int)threadIdx.x >> 6);
    F.G = gridDim.x; { const int bx = blockIdx.x; F.vcu = (F.G % 8 == 0) ? (bx % 8) * (F.G / 8) + bx / 8 : bx; }
    unsigned char* ws = args.ws;
    F.ctl = (gu32*)(ws + WS_CTL);
    for (int u = (int)threadIdx.x; u < (LDS_BYTES - LDSCTL_OFF) / 4; u += NWAVES * 64) ((LAS unsigned*)(F.lds + LDSCTL_OFF))[u] = 0u;
    __syncthreads();
    if (threadIdx.x == 0) { const unsigned x_ = xb_xcc_id(); F.MISC[16] = x_; F.MISC[17] = xb_add((unsigned*)(F.ctl + CW_XRANK) + 64 * x_, 1u); }
    XcdBarrier bar; bar.bar = (unsigned*)(F.ctl + CW_BAR); bar.x = 0; bar.st = nullptr;
    if (!MK_PER_PHASE) bar = xcd_barrier_post((unsigned*)(F.ctl + CW_BAR), F.MISC + 8);
#define GRID_BAR() do { if (!MK_PER_PHASE) xcd_barrier(bar); } while (0)
    const int lo = args.ph_lo, hi = args.ph_hi;
#ifndef PHASE_MASK
#define PHASE_MASK 0x7ff
#endif
#define IN(k) (((PHASE_MASK >> (k)) & 1) && lo <= (k) && (k) < hi)
#define BOTH(k) (IN(k) && IN((k) + 1))
    const int gw = F.vcu * NWAVES + F.wave, NGW = F.G * NWAVES;
    bf16* const SC = (bf16*)(ws + WS_SC); float* const MOD = (float*)(ws + WS_MOD);
    bf16* const H = (bf16*)(ws + WS_H); bf16* const PROJ = (bf16*)(ws + WS_PROJ); bf16* const MIX = (bf16*)(ws + WS_MIX);
    bf16* const X2 = (bf16*)(ws + WS_H);        bf16* const X1 = (bf16*)(ws + WS_X1);       unsigned char* const ACT = ws + WS_ACT;

    if (IN(0)) { p0_prologue(F, args); }
    if (IN(1)) {
        if (F.wave == 0) {
            unsigned sp_ = 0u; unsigned* tmo_ = (unsigned*)(F.ctl + CW_BAR) + XB_TMO;
            while (xb_ld((unsigned*)(F.ctl + CW_SCRDY)) < 256u) { __builtin_amdgcn_s_sleep(4); if ((++sp_ & 255u) == 0u) { if (xb_ld(tmo_)) break; if (sp_ > XB_SPIN_CAP) { atomicAdd(tmo_, 1u); break; } } }
            __builtin_amdgcn_fence(__ATOMIC_ACQUIRE, "agent"); asm volatile("s_waitcnt vmcnt(0)" ::: "memory");
        }
        __syncthreads();
        for (int nb0 = 3 * F.vcu; nb0 < NMOD / 32; nb0 += 3 * F.G) {
            const int t_ = opaque_tid();
            if (F.wave < 3) mod_phase_wave<true>(args, SC, MOD, F.lds + RING_OFF, (nb0 + F.wave < NMOD / 32) ? nb0 + F.wave : nb0, t_, (nb0 + F.wave < 2 * DM / 32) ? (unsigned*)(F.ctl + CW_MODRDY) : nullptr);
            else mod_phase_wave<false>(args, SC, MOD, F.lds + RING_OFF, 0, t_, nullptr);
            __syncthreads();
        }
    }
    if (IN(2)) {
        if (F.wave == 0) {
            unsigned sp_ = 0u; unsigned* tmo_ = (unsigned*)(F.ctl + CW_BAR) + XB_TMO;
            while (xb_ld((unsigned*)(F.ctl + CW_MODRDY)) < 256u) { __builtin_amdgcn_s_sleep(4); if ((++sp_ & 255u) == 0u) { if (xb_ld(tmo_)) break; if (sp_ > XB_SPIN_CAP) { atomicAdd(tmo_, 1u); break; } } }
            __builtin_amdgcn_fence(__ATOMIC_ACQUIRE, "agent"); asm volatile("s_waitcnt vmcnt(0)" ::: "memory");
        }
        __syncthreads();
        const int l_ = opaque_tid() & 63;
        norm_mod_phase<0, 0>(args, X1, MOD, args.in[10], H, gw, NGW, l_, ws + WS_H8, (float*)(ws + WS_HS));
        if (BOTH(2)) GRID_BAR();
    }
    int cid = (int)blockIdx.x;
    if (!MK_PER_PHASE && lo == 0 && (F.G & 7) == 0) {
        bool even = true;
        for (int j = 0; j < 8; ++j) even = even && (xb_ld((unsigned*)(F.ctl + CW_XRANK) + 64 * j) == (unsigned)(F.G >> 3));
        const int x_ = __builtin_amdgcn_readfirstlane((int)F.MISC[16]), r_ = __builtin_amdgcn_readfirstlane((int)F.MISC[17]);
        if (even && x_ < 8 && r_ < (F.G >> 3)) cid = r_ * 8 + x_;
    }
    float* const SB2 = (float*)(ws + WS_GU + 16 * MiB);
    if (IN(3)) {
        { pg8::Gemm g{(const bf16*)(ws + WS_H8), (const bf16*)(ws + WS_WIN8), 30 * 256, NIN, DM / 2, PKB / 2}; pg8::StaticOrder S; S.init(30 * 256, NIN, DM / 2, F.G, cid); S.pmode = 2;
          pg8::EpiInProjT<true> E{PROJ, NPR, MIX, PK, args.in[13], args.in[4], SB2, args.out + O_CP, args.out + O_CS, (LAS float*)(F.lds + HALO_OFF), 1.0f / pg8::WGU_I8SCALE, (const float*)(ws + WS_HS)};
          pg8::gemm_phase<pg8::EpiInProjT<true>, pg8::StaticOrder, true, true, 2>(F.lds + RING_OFF, g, S, E); }
        __syncthreads();
        { pg8::Gemm g{H, (const bf16*)(ws + WS_WIN), 6 * 256, NIN, DM, PK}; pg8::StaticOrder S; S.init(6 * 256, NIN, DM, F.G, cid); S.pmode = 1;
          pg8::EpiInProj E{PROJ, NPR, MIX, PK, args.in[13], args.in[4], SB2, args.out + O_CP, args.out + O_CS, (LAS float*)(F.lds + HALO_OFF)};
          pg8::gemm_phase<pg8::EpiInProj, pg8::StaticOrder, true, true, 0>(F.lds + RING_OFF, g, S, E); }
        convert_queue(args, F.lds + RING_OFF + F.wave * 16384, I_END0, I_END1, (unsigned*)(F.ctl + CW_CONVQ + 128));
        kvcopy_queue(args, (unsigned*)(F.ctl + CW_CONVQ + 256));
        if (BOTH(3)) GRID_BAR();
    }
    if (IN(4)) {
        const int first_ = ((int)blockIdx.x >> 3) & 1;
#pragma unroll 1
        for (int pass = 0; pass < 2; ++pass) {
            if ((pass ^ first_) == 0) {
                for (int u = (int)blockIdx.x; u < 256; u += F.G) { const int t_ = opaque_tid(); att::prompt_unit(F.lds + RING_OFF, PROJ, ws + WS_MIX8A, args.in[14], u >> 7, (u >> 2) & 31, u & 3, t_); }
                for (int u = (int)blockIdx.x; u < 256; u += F.G) { const int t_ = opaque_tid(); att::sample_unit(F.lds + RING_OFF, PROJ, args.in[2], args.in[3], ws + WS_MIX8A, args.in[14], u >> 1, u & 1, t_); }
            } else {
                for (int it = gw; it < 30 * 4; it += NGW) { const int l_ = opaque_tid() & 63; convfix_item(args, SB2, MIX, it >> 2, it & 3, l_); }
                for (int it = gw; it < 640; it += NGW) { const int l_ = opaque_tid() & 63; kvstate_item4(args, PROJ, it, l_); }
            }
        }
        if (BOTH(4)) GRID_BAR();
    }
    if (IN(5)) {
        const int Gg = (F.G & 31) ? F.G : F.G - (F.G >> 2);
        if (cid < Gg) {
            pg8::Gemm g{MIX, (const bf16*)(ws + WS_WOUT), MTOT, DM, DM, PK, 0, 0, (const bf16*)(ws + WS_MIX8A), (const bf16*)(ws + WS_WOUT8A), 1.0f / (pg8::ATT_PRESCALE * pg8::WOUT_PRESCALE)}; pg8::PairOrder S; S.init(MTOT, DM, DM, Gg, cid);
            pg8::EpiResGate<false, true> E{args.in[0], args.in[1], X1, MOD + 2 * DM};
            pg8::gemm_phase<pg8::EpiResGate<false, true>, pg8::PairOrder, true, true, 3>(F.lds + RING_OFF, g, S, E);
        }
        convert_queue(args, F.lds + RING_OFF + F.wave * 16384, I_END1, I_END2 + I_DN_P5, (unsigned*)(F.ctl + CW_CONVQ));
        if (BOTH(5)) GRID_BAR();
    }
    if (IN(6)) {
        const int l_ = opaque_tid() & 63;
        norm_mod_phase<1, 3>(args, X1, MOD, args.in[11], H, gw, NGW, l_, ws + WS_H8, (float*)(ws + WS_HS), (bf16*)(ws + WS_HST));
        if (BOTH(6)) GRID_BAR();
    }
    float* const SB = (float*)(ws + WS_GU);
    if (IN(7)) {
        { pg8::Gemm g{(const bf16*)(ws + WS_H8), (const bf16*)(ws + WS_WGU8), 34 * 256, NGU, DM / 2, PKB / 2}; pg8::SplitOrder S; S.init2(34 * 256, NGU, DM / 2, F.G, cid, 8, (float*)(ws + WS_SLAB), (unsigned*)(F.ctl + CW_TICK + 3 * TICK_WORDS)); S.pmode = 3; S.ints = true; S.wgflag = (LAS unsigned*)(F.lds + MISC_OFF + 80);
          pg8::EpiGateUpT<true> E{ACT, PFB, args.in[17], args.in[5], SB, args.out + O_FP, args.out + O_FS, (LAS float*)(F.lds + HALO_OFF), 1.0f / pg8::WGU_I8SCALE, (const float*)(ws + WS_HS)};
          pg8::gemm_phase<pg8::EpiGateUpT<true>, pg8::SplitOrder, true, true, 2>(F.lds + RING_OFF, g, S, E); }
        __syncthreads();
        { pg8::Gemm g{H, (const bf16*)(ws + WS_WGU), 2 * 256, NGU, DM, PK}; pg8::StaticOrder S; S.init(2 * 256, NGU, DM, F.G, cid); S.pmode = 4;
          pg8::EpiGateUp E{ACT, PFB, args.in[17], args.in[5], SB, args.out + O_FP, args.out + O_FS, (LAS float*)(F.lds + HALO_OFF), 1.0f};
          pg8::gemm_phase<pg8::EpiGateUp, pg8::StaticOrder, true, true, 0>(F.lds + RING_OFF, g, S, E); }
        __syncthreads();
        { pg8::Gemm g{(const bf16*)(ws + WS_HST), (const bf16*)(ws + WS_WGU), 256, 43 * 256, DM, PK, (size_t)512 * PK, (size_t)1024 * PK}; pg8::StaticOrder S; S.init(256, 43 * 256, DM, F.G, (cid + F.G - 172) % F.G);
          pg8::EpiGateState E{args.out + O_FS};
          pg8::gemm_phase<pg8::EpiGateState, pg8::StaticOrder, true, true, 0>(F.lds + RING_OFF, g, S, E); }
        convert_queue(args, F.lds + RING_OFF + F.wave * 16384, I_END2 + I_DN_P5, I_END3, (unsigned*)(F.ctl + CW_CONVQ + 192));
        if (BOTH(7)) GRID_BAR();
    }
    if (IN(8)) {
        for (int it = gw; it < 30 * 22; it += NGW) { const int l_ = opaque_tid() & 63; fixup_item(args, SB, ACT, it / 22, it % 22, l_); }
        if (BOTH(8)) GRID_BAR();
    }
    if (IN(9)) {
        pg8::Gemm g{(const bf16*)ACT, (const bf16*)(ws + WS_WDN), MTOT, DM, DFF / 2, PFB / 2}; pg8::SplitOrder S; S.init2(MTOT, DM, DFF / 2, F.G, cid, 4, (float*)(ws + WS_SLAB), (unsigned*)(F.ctl + CW_TICK + 2 * TICK_WORDS));
        pg8::EpiResGate<true, true> E{X1, X1 + (size_t)NTOKP * DM, X2, MOD + 5 * DM, 1.0f / (pg8::ACT_PRESCALE * pg8::WDN_PRESCALE)};
        pg8::gemm_phase<pg8::EpiResGate<true, true>, pg8::SplitOrder, true, true, true>(F.lds + RING_OFF, g, S, E);
        if (BOTH(9)) GRID_BAR();
    }
    if (IN(10)) {
        const int l_ = opaque_tid() & 63;
        final_norm_phase(X2, args.out + O_Y, args.in[19], gw, NGW, l_);
    }
#undef IN
#undef BOTH
#undef GRID_BAR
}

extern "C" void kernel_launch(void* const* d_in, const int* in_sizes, int n_in, void* d_out, int out_size, void* d_ws, size_t ws_size, hipStream_t stream) {
    static int grid = 0;
    if (grid == 0) {
        if (n_in != 20 || in_sizes[0] != NTOKP * DM || (size_t)out_size != O_END || ws_size < WS_END) {
            fprintf(stderr, "kernel_launch: unexpected shapes: n_in %d in0 %d out %d ws %zu (need %zu); nothing launched\n", n_in, n_in > 0 ? in_sizes[0] : -1, out_size, ws_size, (size_t)WS_END); grid = -1; return; }
        int dev = 0, cus = 0, per_cu = 0;
        if (hipGetDevice(&dev) != hipSuccess || hipDeviceGetAttribute(&cus, hipDeviceAttributeMultiprocessorCount, dev) != hipSuccess) { fprintf(stderr, "kernel_launch: device query failed\n"); grid = -1; return; }
        if (hipFuncSetAttribute((const void*)mega_fwd, hipFuncAttributeMaxDynamicSharedMemorySize, LDS_BYTES) != hipSuccess) { fprintf(stderr, "kernel_launch: hipFuncSetAttribute failed\n"); grid = -1; return; }
        if (hipOccupancyMaxActiveBlocksPerMultiprocessor(&per_cu, (const void*)mega_fwd, NWAVES * 64, LDS_BYTES) != hipSuccess || per_cu < 1)
            fprintf(stderr, "kernel_launch: note: occupancy query reports %d workgroups per CU\n", per_cu);
        (void)hipGetLastError();
        grid = cus;
    }
    if (grid < 0) return;
    if (hipMemsetAsync((char*)d_ws + WS_CTL, 0, CTL_ZERO_BYTES, stream) != hipSuccess) { fprintf(stderr, "kernel_launch: memset failed\n"); return; }
    Args a{};
    for (int i = 0; i < 20; ++i) a.in[i] = (const float*)d_in[i];
    a.out = (float*)d_out; a.ws = (unsigned char*)d_ws; a.li = 0; a.pad = 0;
#if MK_PER_PHASE
    for (int p = 0; p < NPHASE; ++p) { a.ph_lo = p; a.ph_hi = p + 1; hipLaunchKernelGGL(mega_fwd, dim3(grid), dim3(NWAVES * 64), LDS_BYTES, stream, a); }
#else
    a.ph_lo = 0; a.ph_hi = NPHASE;
    hipLaunchKernelGGL(mega_fwd, dim3(grid), dim3(NWAVES * 64), LDS_BYTES, stream, a);
#endif
    const hipError_t le = hipPeekAtLastError();
    if (le != hipSuccess) fprintf(stderr, "kernel_launch: launch failed: %s\n", hipGetErrorName(le));
}
```

```cpp
#include <hip/hip_runtime.h>
#include <hip/hip_bf16.h>
#include <cstdio>
#include <cstdint>
#include <cmath>
#define MK_PER_PHASE 0
namespace pg8 {
#define PG8_LAS __attribute__((address_space(3)))
typedef unsigned short bf16_t;
typedef short bf16x8 __attribute__((ext_vector_type(8)));
typedef float f32x4 __attribute__((ext_vector_type(4)));
typedef unsigned u32x4 __attribute__((ext_vector_type(4)));
constexpr int BM = 256, BK = 64, HALF = 128, HTB = HALF * BK * 2  , STAGE_BYTES = 8 * HTB, NXCD = 8, WGM = 8;

__host__ __device__ __forceinline__ int lds_byte(int r, int c) { const int st = (r >> 4) * 2 + (c >> 5), rr = r & 15, cc = c & 31, ob = rr * 64 + cc * 2; return st * 1024 + (ob ^ (((ob >> 9) & 1) << 5)); }
__host__ __device__ __forceinline__ void stage_rc(int b, int& R, int& C) { const int st = b / 1024, sb = b % 1024, swz = sb ^ (((sb >> 9) & 1) << 5); R = (st >> 1) * 16 + swz / 64; C = (st & 1) * 32 + (swz % 64) / 2; }
__host__ __device__ __forceinline__ int perm32(int rho) { const int n = rho >> 4, i = rho & 15; return 8 * (i >> 2) + 4 * n + (i & 3); }

struct Unit { unsigned w0, w1;
    __host__ __device__ __forceinline__ int pm() const { return (int)(w0 & 255u); } __host__ __device__ __forceinline__ int pn() const { return (int)((w0 >> 8) & 255u); }
    __host__ __device__ __forceinline__ int k0() const { return (int)((w0 >> 16) & 255u) * 128; } __host__ __device__ __forceinline__ int nt() const { return (int)(w0 >> 24) * 2; }
    __host__ __device__ __forceinline__ int ns() const { return (int)(w1 & 255u); } __host__ __device__ __forceinline__ int sp() const { return (int)((w1 >> 8) & 255u); } __host__ __device__ __forceinline__ int sid() const { return (int)((w1 >> 16) & 0x7fffu); } __host__ __device__ __forceinline__ bool f8() const { return (w1 >> 31) != 0u; }
    __host__ __device__ __forceinline__ void set(int pm_, int pn_, int k0_, int nt_, int ns_, int sp_, int sid_) { w0 = (unsigned)pm_ | ((unsigned)pn_ << 8) | ((unsigned)(k0_ >> 7) << 16) | ((unsigned)(nt_ >> 1) << 24); w1 = (unsigned)ns_ | ((unsigned)sp_ << 8) | ((unsigned)sid_ << 16); }
};
struct Gemm { const bf16_t* A; const bf16_t* Bt; int M, N, K, ld; size_t bh = 0, bt = 0; const bf16_t* A8 = nullptr; const bf16_t* B8 = nullptr; float seam = 1.0f; };

struct StaticOrder {
    int nM, nN, nwg, G, c, ntK; int pm0 = 0; int pmode = 0;
    __host__ __device__ void init(int M, int N, int K, int G_, int c_) { nM = M / BM; nN = N / BM; nwg = nM * nN; G = G_; c = c_; ntK = K / BK; }
    __host__ __device__ bool next(int i, Unit& u) const { return at((long)i * G + c, u); }
    __host__ __device__ bool at(const long L, Unit& u) const {
        if (L >= nwg) return false;
        int wgid = (int)L; { const int q = nwg / NXCD, r = nwg % NXCD, xcd = wgid % NXCD, off = wgid / NXCD; wgid = (xcd < r ? xcd * (q + 1) : r * (q + 1) + (xcd - r) * q) + off; }
        const int nig = WGM * nN, gid = wgid / nig, fm = gid * WGM, gsz = (nM - fm) < WGM ? (nM - fm) : WGM;
        int pm_ = pm0 + fm + ((wgid % nig) % gsz); if (pmode == 1) pm_ = (pm_ == 0) ? 15 : 30 + pm_; else if (pmode == 2) pm_ = (pm_ < 15) ? pm_ : pm_ + 1;
        else if (pmode == 3) pm_ = (pm_ < 15) ? pm_ : (pm_ < 30 ? pm_ + 1 : pm_ + 2); else if (pmode == 4) pm_ = 15 + 16 * pm_;
        u.set(pm_, (wgid % nig) / gsz, 0, ntK, 1, 0, 0); return true;
    }
    __device__ __forceinline__ void a_ready(const Unit&) const {}
    __device__ __forceinline__ void done(const Unit&) const {}
    __device__ __forceinline__ bool combine(f32x4 (&)[2][2][4][2], const Unit&, int, int) const { return true; }
};
struct PairOrder : StaticOrder {
    int nt8 = 16, k1 = 2048, nt16 = 32;
    __device__ __forceinline__ bool next(int i, Unit& u) const {
        if (!at((long)(i >> 1) * G + c, u)) return false;
        if ((i & 1) == 0) { u.set(u.pm(), u.pn(), 0, nt8, 1, 0, 0); u.w1 |= 0x80000000u; } else u.set(u.pm(), u.pn(), k1, nt16, 1, 0, 0);
        return true;
    }
};
struct SplitOrder : StaticOrder {
    bool ints = false;
    int S, full, rem; float* slab; unsigned* tick; PG8_LAS unsigned* wgflag = nullptr;
    __device__ __forceinline__ void init2(int M, int N, int K, int G_, int c_, int S_, float* slab_, unsigned* tick_) {
        init(M, N, K, G_, c_); full = nwg / G; rem = nwg - full * G; slab = slab_; tick = tick_;
        const int grp = (rem + 7) >> 3; S = S_; if (grp > 0 && grp * S * 8 > G) S = (G >> 3) / grp; if (S < 1 || (G & 7)) S = 1; if (S > (ntK >> 1)) S = ntK >> 1;
    }
    __device__ __forceinline__ bool next(int i, Unit& u) const {
        if (i < full) return at((long)i * G + c, u);
        if (i > full || rem == 0) return false;
        if (S == 1) return at((long)i * G + c, u);
        const int x = c & 7, y = c >> 3, jhi = y / S, s = y - jhi * S, j = jhi * 8 + x;
        if (j >= rem) return false;
        at((long)full * G + j, u);
        const int pairs = ntK >> 1, p = pairs / S, r = pairs - p * S, np = p + (s < r ? 1 : 0), p0 = s * p + (s < r ? s : r);
        u.set(u.pm(), u.pn(), p0 * 2 * BK, np * 2, S, s, j); return true;
    }
    __device__ __forceinline__ bool combine(f32x4 (&acc)[2][2][4][2], const Unit& u, int wid, int lane) const {
        float* mine = slab + ((size_t)(u.sid() * S + u.sp()) * 8 + wid) * 8192;
        const __amdgpu_buffer_rsrc_t rs = __builtin_amdgcn_make_buffer_rsrc(mine, 0, 32768, 0x00020000);
        const unsigned voff = (unsigned)lane * 16u;
#pragma unroll
        for (int ai = 0; ai < 2; ++ai)
#pragma unroll
            for (int bj = 0; bj < 2; ++bj)
#pragma unroll
                for (int m = 0; m < 4; ++m)
#pragma unroll
                    for (int n = 0; n < 2; ++n) __builtin_amdgcn_raw_buffer_store_b128(__builtin_bit_cast(u32x4, acc[ai][bj][m][n]), rs, voff, ((((ai * 2 + bj) * 4 + m) * 2 + n) * 1024),   16);
        asm volatile("s_waitcnt vmcnt(0)" ::: "memory");
        unsigned old = 0u;
        if (wgflag) {
            asm volatile("" ::: "memory"); __builtin_amdgcn_s_barrier(); asm volatile("" ::: "memory");
            if (wid == 0) { if (lane == 0) old = __hip_atomic_fetch_add(tick + (size_t)(u.sid() * 8) * 16, 1u, __ATOMIC_RELAXED, __HIP_MEMORY_SCOPE_AGENT);
                old = (unsigned)__builtin_amdgcn_readfirstlane((int)old); if (lane == 0) *wgflag = old; }
            asm volatile("s_waitcnt vmcnt(0) lgkmcnt(0)" ::: "memory"); __builtin_amdgcn_s_barrier(); asm volatile("" ::: "memory");
            old = (unsigned)__builtin_amdgcn_readfirstlane((int)*wgflag);
        } else {
            if (lane == 0) old = __hip_atomic_fetch_add(tick + (size_t)(u.sid() * 8 + wid) * 16, 1u, __ATOMIC_RELAXED, __HIP_MEMORY_SCOPE_AGENT);
            old = (unsigned)__builtin_amdgcn_readfirstlane((int)old);
        }
        if (old + 1u != (unsigned)S) { __builtin_amdgcn_s_waitcnt(0); return false; }
        __builtin_amdgcn_fence(__ATOMIC_ACQUIRE, "agent"); asm volatile("s_waitcnt vmcnt(0)" ::: "memory");
        for (int s = 0; s < S; ++s) {
            const __amdgpu_buffer_rsrc_t rr = __builtin_amdgcn_make_buffer_rsrc(slab + ((size_t)(u.sid() * S + s) * 8 + wid) * 8192, 0, 32768, 0x00020000);
#pragma unroll
            for (int ai = 0; ai < 2; ++ai) {
                f32x4 t[2][4][2];
#pragma unroll
                for (int bj = 0; bj < 2; ++bj)
#pragma unroll
                    for (int m = 0; m < 4; ++m)
#pragma unroll
                        for (int n = 0; n < 2; ++n) t[bj][m][n] = __builtin_bit_cast(f32x4, __builtin_amdgcn_raw_buffer_load_b128(rr, voff, ((((ai * 2 + bj) * 4 + m) * 2 + n) * 1024), 0));
                __builtin_amdgcn_sched_barrier(0);
#pragma unroll
                for (int bj = 0; bj < 2; ++bj)
#pragma unroll
                    for (int m = 0; m < 4; ++m)
#pragma unroll
                        for (int n = 0; n < 2; ++n) { typedef int i32x4_ __attribute__((ext_vector_type(4)));
                            acc[ai][bj][m][n] = (s == 0) ? t[bj][m][n] : (ints ? __builtin_bit_cast(f32x4, __builtin_bit_cast(i32x4_, acc[ai][bj][m][n]) + __builtin_bit_cast(i32x4_, t[bj][m][n])) : acc[ai][bj][m][n] + t[bj][m][n]); }
                __builtin_amdgcn_sched_barrier(0);
            }
        }
        __builtin_amdgcn_s_waitcnt(0);
        return true;
    }
};

__device__ __forceinline__ unsigned cvt_pk_bf16(float lo, float hi) { unsigned r; asm volatile("v_cvt_pk_bf16_f32 %0, %1, %2" : "=v"(r) : "v"(lo), "v"(hi)); return r; }
typedef float f32x2 __attribute__((ext_vector_type(2)));
__device__ __forceinline__ f32x2 gelu_pk(f32x2 v) {
    const f32x2 av = __builtin_elementwise_abs(v), d = av * 0.2316418882f + 1.0f;
    f32x2 t; t.x = __builtin_amdgcn_rcpf(d.x); t.y = __builtin_amdgcn_rcpf(d.y);
    f32x2 q = t * 0.5307027145f + (-0.7265760135f); q = q * t + 0.7107068705f; q = q * t + (-0.142248368f); q = q * t + 0.127414796f; q = q * t;
    const f32x2 s = (v * v) * (-0.72134752044f);
    f32x2 e; e.x = __builtin_amdgcn_exp2f(s.x); e.y = __builtin_amdgcn_exp2f(s.y);
    const f32x2 m = v * (q * e), r = v - m;
    f32x2 o; o.x = v.x < 0.f ? m.x : r.x; o.y = v.y < 0.f ? m.y : r.y; return o;
}

template <int ACT  > struct EpiBf16 {
    static constexpr bool PERM = true, AFTER_DRAIN = false; static_assert(ACT == 0 || ACT == 1, "EpiBf16: ACT is 0 (none) or 1 (gelu_pk)");
    bf16_t* O; int ldc; const float* bias; int split_cols; size_t split_stride; float scale0;
    __device__ __forceinline__ void operator()(const f32x4 (&acc)[2][2][4][2], const Unit& u, int wr, int wc, int fr, int fq) const {
        const int row0 = u.pm() * BM + wr * 64 + fr; int colt = u.pn() * BM; bf16_t* base = O;
        float sc = 1.f; if (split_cols) { const int t = colt / split_cols; base += (size_t)t * split_stride; colt -= t * split_cols; if (t == 0) sc = scale0; }
        const int col0 = colt + wc * 32 + 8 * fq, bcol0 = u.pn() * BM + wc * 32 + 8 * fq;
        f32x4 bv[2][2];
#pragma unroll
        for (int bj = 0; bj < 2; ++bj)
#pragma unroll
            for (int n = 0; n < 2; ++n) bv[bj][n] = bias ? *(const f32x4*)(bias + bcol0 + bj * HALF + 4 * n) : (f32x4){0.f, 0.f, 0.f, 0.f};
#pragma unroll
        for (int ai = 0; ai < 2; ++ai)
#pragma unroll
            for (int m = 0; m < 4; ++m) { bf16_t* rowp = base + (size_t)(row0 + ai * HALF + m * 16) * ldc + col0;
#pragma unroll
                for (int bj = 0; bj < 2; ++bj) { f32x4 v0 = acc[ai][bj][m][0] + bv[bj][0], v1 = acc[ai][bj][m][1] + bv[bj][1];
                    if (ACT == 1) { f32x2 a = gelu_pk((f32x2){v0[0], v0[1]}), b = gelu_pk((f32x2){v0[2], v0[3]}), c = gelu_pk((f32x2){v1[0], v1[1]}), d = gelu_pk((f32x2){v1[2], v1[3]});
                        v0 = (f32x4){a.x, a.y, b.x, b.y}; v1 = (f32x4){c.x, c.y, d.x, d.y}; }
                    v0 = v0 * sc; v1 = v1 * sc; u32x4 w; w.x = cvt_pk_bf16(v0[0], v0[1]); w.y = cvt_pk_bf16(v0[2], v0[3]); w.z = cvt_pk_bf16(v1[0], v1[1]); w.w = cvt_pk_bf16(v1[2], v1[3]);
                    *(u32x4*)(rowp + bj * HALF) = w; } }
    }
};
struct EpiF32 {
    static constexpr bool PERM = false, AFTER_DRAIN = false;
    float* C; int ldc; const float* bias;
    __device__ __forceinline__ void operator()(const f32x4 (&acc)[2][2][4][2], const Unit& u, int wr, int wc, int fr, int fq) const {
        const int row0 = u.pm() * BM + wr * 64 + fr, col0 = u.pn() * BM + wc * 32 + 4 * fq;
        f32x4 bv[2][2];
#pragma unroll
        for (int bj = 0; bj < 2; ++bj)
#pragma unroll
            for (int n = 0; n < 2; ++n) bv[bj][n] = bias ? *(const f32x4*)(bias + col0 + bj * HALF + n * 16) : (f32x4){0.f, 0.f, 0.f, 0.f};
#pragma unroll
        for (int ai = 0; ai < 2; ++ai)
#pragma unroll
            for (int m = 0; m < 4; ++m) { float* rowp = C + (size_t)(row0 + ai * HALF + m * 16) * ldc + col0;
#pragma unroll
                for (int bj = 0; bj < 2; ++bj)
#pragma unroll
                    for (int n = 0; n < 2; ++n) *(f32x4*)(rowp + bj * HALF + n * 16) = acc[ai][bj][m][n] + bv[bj][n]; }
    }
};
template <bool BASE_BF16, bool OUT_BF16> struct EpiResGate {
    static constexpr bool PERM = false, AFTER_DRAIN = false;
    const void* base_p; const void* base_s; void* out; const float* gate; float accs = 1.0f;
    __device__ __forceinline__ void ldgrp(int gi, const Unit& u, int wr, int fr, int col0, f32x4 (&b)[4], f32x4 (&g)[4]) const {
        const int ai = gi >> 2, m = gi & 3, r = u.pm() * BM + ai * HALF + wr * 64 + m * 16 + fr;
        const int cond = r < 8192 ? (r >> 12) : 2 + ((r - 8192) >> 3);
        const float* gp = gate + (size_t)cond * 24576 + col0;
        if (BASE_BF16) {
            typedef unsigned u32x2 __attribute__((ext_vector_type(2)));
            const bf16_t* bp = (r < 8192 ? (const bf16_t*)base_p + (size_t)r * 4096 : (const bf16_t*)base_s + (size_t)(r - 8192) * 4096) + col0;
#pragma unroll
            for (int q = 0; q < 4; ++q) { const u32x2 w = *(const u32x2*)(bp + (q >> 1) * HALF + (q & 1) * 16);
                b[q] = (f32x4){__uint_as_float(w.x << 16), __uint_as_float(w.x & 0xffff0000u), __uint_as_float(w.y << 16), __uint_as_float(w.y & 0xffff0000u)}; g[q] = *(const f32x4*)(gp + (q >> 1) * HALF + (q & 1) * 16); }
        } else {
            const float* bp = (r < 8192 ? (const float*)base_p + (size_t)r * 4096 : (const float*)base_s + (size_t)(r - 8192) * 4096) + col0;
#pragma unroll
            for (int q = 0; q < 4; ++q) { b[q] = *(const f32x4*)(bp + (q >> 1) * HALF + (q & 1) * 16); g[q] = *(const f32x4*)(gp + (q >> 1) * HALF + (q & 1) * 16); }
        }
        __builtin_amdgcn_sched_barrier(0);
    }
    __device__ __forceinline__ void operator()(const f32x4 (&acc)[2][2][4][2], const Unit& u, int wr, int wc, int fr, int fq) const {
        const int col0 = u.pn() * BM + wc * 32 + 4 * fq;
        f32x4 b[2][4], g[2][4];
        ldgrp(0, u, wr, fr, col0, b[0], g[0]);
#pragma unroll
        for (int gi = 0; gi < 8; ++gi) {
            if (gi + 1 < 8) ldgrp(gi + 1, u, wr, fr, col0, b[(gi + 1) & 1], g[(gi + 1) & 1]);
            const int ai = gi >> 2, m = gi & 3, r = u.pm() * BM + ai * HALF + wr * 64 + m * 16 + fr;
#pragma unroll
            for (int q = 0; q < 4; ++q) { const f32x4 o = b[gi & 1][q] + (g[gi & 1][q] * accs) * acc[ai][q >> 1][m][q & 1];
                if (OUT_BF16) { typedef unsigned u32x2 __attribute__((ext_vector_type(2))); u32x2 w; w.x = cvt_pk_bf16(o[0], o[1]); w.y = cvt_pk_bf16(o[2], o[3]);
                    *(u32x2*)((bf16_t*)out + (size_t)r * 4096 + col0 + (q >> 1) * HALF + (q & 1) * 16) = w; }
                else *(f32x4*)((float*)out + (size_t)r * 4096 + col0 + (q >> 1) * HALF + (q & 1) * 16) = o; }
            __builtin_amdgcn_sched_barrier(0);
        }
    }
};
__device__ __forceinline__ float dpp_ror1(float x) { return __builtin_bit_cast(float, __builtin_amdgcn_mov_dpp(__builtin_bit_cast(int, x), 0x121, 0xf, 0xf, true)); }
__device__ __forceinline__ float dpp_ror2(float x) { return __builtin_bit_cast(float, __builtin_amdgcn_mov_dpp(__builtin_bit_cast(int, x), 0x122, 0xf, 0xf, true)); }
__device__ __forceinline__ float dpp_shr1(float old, float x) { return __builtin_bit_cast(float, __builtin_amdgcn_update_dpp(__builtin_bit_cast(int, old), __builtin_bit_cast(int, x), 0x111, 0xf, 0xf, false)); }
__device__ __forceinline__ float dpp_shr2(float old, float x) { return __builtin_bit_cast(float, __builtin_amdgcn_update_dpp(__builtin_bit_cast(int, old), __builtin_bit_cast(int, x), 0x112, 0xf, 0xf, false)); }
constexpr float WGU_I8SCALE = 2048.0f;
constexpr float ATT_PRESCALE = 16.0f, WOUT_PRESCALE = 2048.0f;
constexpr float ACT_PRESCALE = 8.0f, WDN_PRESCALE = 4096.0f;
template <bool I8> struct EpiGateUpT {
    static constexpr bool PERM = true, AFTER_DRAIN = false;
    unsigned char* ACT; int ldact  ; const float* cw; const float* st; float* sb; float* out_fp; float* out_fs; PG8_LAS float* halo; float accs = 1.0f; const float* rowscale = nullptr;
    template <bool SAMP> __device__ __forceinline__ void body(const f32x4 (&acc)[2][2][4][2], const Unit& u, int wr, int wc, int fr, int fq) const {
        constexpr int DFF_ = 11008;
        const int pm = u.pm(), ch0 = 128 * u.pn() + 32 * wc + 8 * fq;
        PG8_LAS float* RS = halo + 1024;
        if (I8) { const int t_ = (wr * 4 + wc) * 64 + fq * 16 + fr; if (t_ < 256) RS[t_] = rowscale[pm * BM + t_] * accs; }
        auto cv = [](const f32x4& a_, float f_) -> f32x4 { if (I8) { typedef int i32x4_ __attribute__((ext_vector_type(4))); const i32x4_ i_ = __builtin_bit_cast(i32x4_, a_);
            return (f32x4){(float)i_[0] * f_, (float)i_[1] * f_, (float)i_[2] * f_, (float)i_[3] * f_}; } else return a_ * f_; };
        if (fr >= 14) {
#pragma unroll
            for (int ai = 0; ai < 2; ++ai) { PG8_LAS f32x4* hp = (PG8_LAS f32x4*)(halo + ((((ai * 2 + wr) * 4 + wc) * 2 + (fr - 14)) * 4 + fq) * 8); const float f_ = I8 ? rowscale[pm * BM + ai * HALF + wr * 64 + 48 + fr] * accs : accs; f32x4 t0_ = acc[ai][0][3][0], t1_ = acc[ai][0][3][1]; if (I8) asm volatile("" : "+v"(t0_), "+v"(t1_));
                hp[0] = cv(t0_, f_); hp[1] = cv(t1_, f_); }
        }
        f32x2 w0[4], w1[4], w2[4];
        { const f32x4 a0 = *(const f32x4*)(cw + ch0), a1 = *(const f32x4*)(cw + ch0 + 4), b0 = *(const f32x4*)(cw + DFF_ + ch0), b1 = *(const f32x4*)(cw + DFF_ + ch0 + 4), c0 = *(const f32x4*)(cw + 2 * DFF_ + ch0), c1 = *(const f32x4*)(cw + 2 * DFF_ + ch0 + 4);
          w0[0] = (f32x2){a0[0], a0[1]}; w0[1] = (f32x2){a0[2], a0[3]}; w0[2] = (f32x2){a1[0], a1[1]}; w0[3] = (f32x2){a1[2], a1[3]};
          w1[0] = (f32x2){b0[0], b0[1]}; w1[1] = (f32x2){b0[2], b0[3]}; w1[2] = (f32x2){b1[0], b1[1]}; w1[3] = (f32x2){b1[2], b1[3]};
          w2[0] = (f32x2){c0[0], c0[1]}; w2[1] = (f32x2){c0[2], c0[3]}; w2[2] = (f32x2){c1[0], c1[1]}; w2[3] = (f32x2){c1[2], c1[3]}; }
        asm volatile("s_waitcnt lgkmcnt(0)" ::: "memory"); __builtin_amdgcn_s_barrier(); asm volatile("" ::: "memory");
#pragma unroll
        for (int ai = 0; ai < 2; ++ai) {
            float o1[8], o2[8];
            if (wr == 1 || ai == 1) {
                const int sa = (wr == 1) ? ai : 0, sw = (wr == 1) ? 0 : 1;
                const PG8_LAS f32x4* h1 = (const PG8_LAS f32x4*)(halo + ((((sa * 2 + sw) * 4 + wc) * 2 + 1) * 4 + fq) * 8);
                const PG8_LAS f32x4* h0 = (const PG8_LAS f32x4*)(halo + ((((sa * 2 + sw) * 4 + wc) * 2 + 0) * 4 + fq) * 8);
                const f32x4 x0 = h1[0], x1 = h1[1], y0 = h0[0], y1 = h0[1];
#pragma unroll
                for (int j = 0; j < 4; ++j) { o1[j] = x0[j]; o1[4 + j] = x1[j]; o2[j] = (fr == 0) ? y0[j] : x0[j]; o2[4 + j] = (fr == 0) ? y1[j] : x1[j]; }
            } else {
#pragma unroll
                for (int j = 0; j < 8; ++j) { o1[j] = 0.f; o2[j] = 0.f; }
            }
#pragma unroll
            for (int m = 0; m < 4; ++m) {
                const int r = pm * BM + ai * HALF + wr * 64 + m * 16 + fr;
                float g[8], p1[8], p2[8];
                const float rs_c = I8 ? RS[ai * HALF + wr * 64 + m * 16 + fr] : accs;
                const f32x4 ga_ = cv(acc[ai][0][m][0], rs_c), gb_ = cv(acc[ai][0][m][1], rs_c);
#pragma unroll
                for (int j = 0; j < 4; ++j) { g[j] = ga_[j]; g[4 + j] = gb_[j]; }
#pragma unroll
                for (int j = 0; j < 8; ++j) { p1[j] = dpp_shr1(o1[j], g[j]); p2[j] = dpp_shr2(o2[j], g[j]); }
                if (m < 3) {
#pragma unroll
                    for (int j = 0; j < 8; ++j) { o1[j] = dpp_ror1(g[j]); o2[j] = dpp_ror2(g[j]); }
                }
                if (SAMP) {
                    const int t = fr & 7, seq = (r - 8192) >> 3;
                    const float* sp = st + (size_t)seq * 2 * DFF_ + ch0;
                    f32x4 s00 = {0.f, 0.f, 0.f, 0.f}, s01 = s00, s10 = s00, s11 = s00;
                    if (t < 2) { s10 = *(const f32x4*)(sp + DFF_); s11 = *(const f32x4*)(sp + DFF_ + 4); if (t == 0) { s00 = *(const f32x4*)(sp); s01 = *(const f32x4*)(sp + 4); } }
#pragma unroll
                    for (int j = 0; j < 4; ++j) { p1[j] = (t == 0) ? s10[j] : p1[j]; p1[4 + j] = (t == 0) ? s11[j] : p1[4 + j];
                        p2[j] = (t == 0) ? s00[j] : ((t == 1) ? s10[j] : p2[j]); p2[4 + j] = (t == 0) ? s01[j] : ((t == 1) ? s11[j] : p2[4 + j]); }
                    if (!I8 && t >= 6) { float* so = out_fs + ((size_t)seq * 2 + (t - 6)) * DFF_ + ch0; *(f32x4*)(so) = ga_; *(f32x4*)(so + 4) = gb_; }
                } else {
                    if (ai == 0 && m == 0) { if (wr == 0 && fr < 2) { float* q = sb + ((size_t)pm * 6 + fr) * DFF_ + ch0; *(f32x4*)(q) = ga_; *(f32x4*)(q + 4) = gb_;
                        q += 2 * DFF_; *(f32x4*)(q) = cv(acc[0][1][0][0], rs_c); *(f32x4*)(q + 4) = cv(acc[0][1][0][1], rs_c); } }
                    if (ai == 1 && m == 3) { if (wr == 1 && fr >= 14) { float* q = sb + ((size_t)pm * 6 + 4 + (fr - 14)) * DFF_ + ch0; *(f32x4*)(q) = ga_; *(f32x4*)(q + 4) = gb_;
                        if ((pm & 15) == 15) { float* so = out_fp + ((size_t)(pm >> 4) * 2 + (fr - 14)) * DFF_ + ch0; *(f32x4*)(so) = ga_; *(f32x4*)(so + 4) = gb_; } } }
                }
                int q0 = 0, q1 = 0;
#pragma unroll
                for (int jp = 0; jp < 4; ++jp) {
                    const f32x2 gv = (f32x2){g[2 * jp], g[2 * jp + 1]}, p1v = (f32x2){p1[2 * jp], p1[2 * jp + 1]}, p2v = (f32x2){p2[2 * jp], p2[2 * jp + 1]};
                    const f32x2 ur_ = (jp < 2) ? (f32x2){acc[ai][1][m][0][2 * jp], acc[ai][1][m][0][2 * jp + 1]} : (f32x2){acc[ai][1][m][1][2 * jp - 4], acc[ai][1][m][1][2 * jp - 3]};
                    const float ux_ = ur_.x, uy_ = ur_.y;
                    const f32x2 uv = I8 ? (f32x2){(float)__float_as_int(ux_), (float)__float_as_int(uy_)} * rs_c : ur_ * rs_c;
                    const f32x2 gc = w0[jp] * p2v + w1[jp] * p1v + w2[jp] * gv, ea = gc * (-1.4426950408889634f);
                    f32x2 e; e.x = __builtin_amdgcn_exp2f(ea.x); e.y = __builtin_amdgcn_exp2f(ea.y);
                    const f32x2 d = e + 1.0f; f32x2 rc; rc.x = __builtin_amdgcn_rcpf(d.x); rc.y = __builtin_amdgcn_rcpf(d.y);
                    const f32x2 o = ((gc * rc) * uv) * ACT_PRESCALE;
                    const float ox = __builtin_amdgcn_fmed3f(o.x, -448.0f, 448.0f), oy = __builtin_amdgcn_fmed3f(o.y, -448.0f, 448.0f);
                    if (jp == 0) q0 = __builtin_amdgcn_cvt_pk_fp8_f32(ox, oy, q0, false); else if (jp == 1) q0 = __builtin_amdgcn_cvt_pk_fp8_f32(ox, oy, q0, true);
                    else if (jp == 2) q1 = __builtin_amdgcn_cvt_pk_fp8_f32(ox, oy, q1, false); else q1 = __builtin_amdgcn_cvt_pk_fp8_f32(ox, oy, q1, true);
                }
                { typedef unsigned u32x2 __attribute__((ext_vector_type(2))); *(u32x2*)(ACT + (size_t)r * ldact + ch0) = (u32x2){(unsigned)q0, (unsigned)q1}; }
            }
        }
    }
    __device__ __forceinline__ void operator()(const f32x4 (&acc)[2][2][4][2], const Unit& u, int wr, int wc, int fr, int fq) const {
        if (u.pm() >= 32) body<true>(acc, u, wr, wc, fr, fq); else body<false>(acc, u, wr, wc, fr, fq);
    }
};
typedef EpiGateUpT<false> EpiGateUp;
struct EpiGateState {
    static constexpr bool PERM = true, AFTER_DRAIN = false;
    float* out_fs;
    __device__ __forceinline__ void operator()(const f32x4 (&acc)[2][2][4][2], const Unit& u, int wr, int wc, int fr, int fq) const {
        constexpr int DFF_ = 11008;
#pragma unroll
        for (int ai = 0; ai < 2; ++ai)
#pragma unroll
            for (int m = 0; m < 4; ++m) { float* rowp = out_fs + (size_t)(ai * HALF + wr * 64 + m * 16 + fr) * DFF_;
#pragma unroll
                for (int bj = 0; bj < 2; ++bj) { const int tile = 2 * u.pn() + bj;
                    float* q = rowp + 128 * tile + 32 * wc + 8 * fq; *(f32x4*)(q) = acc[ai][bj][m][0]; *(f32x4*)(q + 4) = acc[ai][bj][m][1]; } }
    }
};
template <bool I8> struct EpiInProjT {
    static constexpr bool PERM = true, AFTER_DRAIN = false;
    bf16_t* PROJ; int ldp; bf16_t* MIX; int ldm; const float* cw; const float* st; float* sb; float* out_cp; float* out_cs; PG8_LAS float* halo; float accs = 1.0f; const float* rowscale = nullptr;
    static __device__ __forceinline__ f32x4 cv(const f32x4& a_, float f_) { if (I8) { typedef int i32x4_ __attribute__((ext_vector_type(4))); const i32x4_ i_ = __builtin_bit_cast(i32x4_, a_);
        return (f32x4){(float)i_[0] * f_, (float)i_[1] * f_, (float)i_[2] * f_, (float)i_[3] * f_}; } else return a_; }
    __device__ __forceinline__ void plain(const f32x4 (&acc)[2][2][4][2], const Unit& u, int wr, int wc, int fr, int fq) const {
        const int row0 = u.pm() * BM + wr * 64 + fr, col0 = 2048 + (u.pn() - 32) * BM + wc * 32 + 8 * fq;
#pragma unroll
        for (int ai = 0; ai < 2; ++ai)
#pragma unroll
            for (int m = 0; m < 4; ++m) { bf16_t* rowp = PROJ + (size_t)(row0 + ai * HALF + m * 16) * ldp + col0; const float rs_c = I8 ? rowscale[row0 + ai * HALF + m * 16] * accs : 1.0f;
#pragma unroll
                for (int bj = 0; bj < 2; ++bj) { const f32x4 v0 = cv(acc[ai][bj][m][0], rs_c), v1 = cv(acc[ai][bj][m][1], rs_c);
                    u32x4 w; w.x = cvt_pk_bf16(v0[0], v0[1]); w.y = cvt_pk_bf16(v0[2], v0[3]); w.z = cvt_pk_bf16(v1[0], v1[1]); w.w = cvt_pk_bf16(v1[2], v1[3]);
                    *(u32x4*)(rowp + bj * HALF) = w; } }
    }
    template <bool SAMP> __device__ __forceinline__ void body(const f32x4 (&acc)[2][2][4][2], const Unit& u, int wr, int wc, int fr, int fq) const {
        constexpr int DC = 2048;
        typedef unsigned u32x2 __attribute__((ext_vector_type(2)));
        const int pm = u.pm(), ch0 = 64 * u.pn() + 16 * wc + 4 * fq;
        PG8_LAS float* RS = halo + 1024;
        if (I8) { const int t_ = (wr * 4 + wc) * 64 + fq * 16 + fr; if (t_ < 256) RS[t_] = rowscale[pm * BM + t_] * accs; }
        if (fr >= 14) {
#pragma unroll
            for (int ai = 0; ai < 2; ++ai) { const float f_ = I8 ? rowscale[pm * BM + ai * HALF + wr * 64 + 48 + fr] * accs : 1.0f; f32x4 t0_ = acc[ai][0][3][1], t1_ = acc[ai][1][3][0]; if (I8) asm volatile("" : "+v"(t0_), "+v"(t1_));
                *(PG8_LAS f32x4*)(halo + ((((ai * 2 + wr) * 4 + wc) * 2 + (fr - 14)) * 4 + fq) * 4) = cv(t0_, f_) * cv(t1_, f_); }
        }
        const f32x4 w0 = *(const f32x4*)(cw + ch0), w1 = *(const f32x4*)(cw + DC + ch0), w2 = *(const f32x4*)(cw + 2 * DC + ch0);
        asm volatile("s_waitcnt lgkmcnt(0)" ::: "memory"); __builtin_amdgcn_s_barrier(); asm volatile("" ::: "memory");
#pragma unroll
        for (int ai = 0; ai < 2; ++ai) {
            float o1[4], o2[4];
            if (wr == 1 || ai == 1) {
                const int sa = (wr == 1) ? ai : 0, sw = (wr == 1) ? 0 : 1;
                const f32x4 x = *(const PG8_LAS f32x4*)(halo + ((((sa * 2 + sw) * 4 + wc) * 2 + 1) * 4 + fq) * 4);
                const f32x4 y = *(const PG8_LAS f32x4*)(halo + ((((sa * 2 + sw) * 4 + wc) * 2 + 0) * 4 + fq) * 4);
#pragma unroll
                for (int j = 0; j < 4; ++j) { o1[j] = x[j]; o2[j] = (fr == 0) ? y[j] : x[j]; }
            } else {
#pragma unroll
                for (int j = 0; j < 4; ++j) { o1[j] = 0.f; o2[j] = 0.f; }
            }
#pragma unroll
            for (int m = 0; m < 4; ++m) {
                const int r = pm * BM + ai * HALF + wr * 64 + m * 16 + fr;
                const float rs_c = I8 ? RS[ai * HALF + wr * 64 + m * 16 + fr] : 1.0f;
                const f32x4 Bv = cv(acc[ai][0][m][0], rs_c), uu = cv(acc[ai][0][m][1], rs_c) * cv(acc[ai][1][m][0], rs_c), Qv = cv(acc[ai][1][m][1], rs_c);
                { u32x2 wq; wq.x = cvt_pk_bf16(Qv[0], Qv[1]); wq.y = cvt_pk_bf16(Qv[2], Qv[3]); *(u32x2*)(PROJ + (size_t)r * ldp + ch0) = wq; }
                f32x4 p1, p2;
#pragma unroll
                for (int j = 0; j < 4; ++j) { p1[j] = dpp_shr1(o1[j], uu[j]); p2[j] = dpp_shr2(o2[j], uu[j]); }
                if (m < 3) {
#pragma unroll
                    for (int j = 0; j < 4; ++j) { o1[j] = dpp_ror1(uu[j]); o2[j] = dpp_ror2(uu[j]); }
                }
                if (SAMP) {
                    const int t = fr & 7, seq = (r - 8192) >> 3;
                    const float* sp = st + (size_t)seq * 2 * DC + ch0;
                    f32x4 s0 = {0.f, 0.f, 0.f, 0.f}, s1 = s0;
                    if (t < 2) { s1 = *(const f32x4*)(sp + DC); if (t == 0) s0 = *(const f32x4*)(sp); }
#pragma unroll
                    for (int j = 0; j < 4; ++j) { p1[j] = (t == 0) ? s1[j] : p1[j]; p2[j] = (t == 0) ? s0[j] : ((t == 1) ? s1[j] : p2[j]); }
                    if (t >= 6) *(f32x4*)(out_cs + ((size_t)seq * 2 + (t - 6)) * DC + ch0) = uu;
                } else {
                    if (ai == 0 && m == 0) { if (wr == 0 && fr < 2) { float* q = sb + ((size_t)pm * 6 + fr) * DC + ch0; *(f32x4*)(q) = uu; *(f32x4*)(q + 2 * DC) = Bv; } }
                    if (ai == 1 && m == 3) { if (wr == 1 && fr >= 14) { *(f32x4*)(sb + ((size_t)pm * 6 + 4 + (fr - 14)) * DC + ch0) = uu;
                        if ((pm & 15) == 15) *(f32x4*)(out_cp + ((size_t)(pm >> 4) * 2 + (fr - 14)) * DC + ch0) = uu; } }
                }
                const f32x4 o = Bv * (w0 * p2 + w1 * p1 + w2 * uu);
                u32x2 wo; wo.x = cvt_pk_bf16(o[0], o[1]); wo.y = cvt_pk_bf16(o[2], o[3]);
                *(u32x2*)(MIX + (size_t)r * ldm + DC + ch0) = wo;
            }
        }
    }
    __device__ __forceinline__ void operator()(const f32x4 (&acc)[2][2][4][2], const Unit& u, int wr, int wc, int fr, int fq) const {
        if (u.pn() >= 32) plain(acc, u, wr, wc, fr, fq); else if (!I8 && u.pm() >= 32) body<true>(acc, u, wr, wc, fr, fq); else body<false>(acc, u, wr, wc, fr, fq);
    }
};
typedef EpiInProjT<false> EpiInProj;
template <bool B_> struct BoolTag { static constexpr bool value = B_; };
template <class Epi, class Sched, bool ALIGN_EPI = false, bool SP2 = false, int PREC = 0>
__device__ __forceinline__ void gemm_phase(PG8_LAS unsigned char* lds, const Gemm g, const Sched& S, const Epi& E) {
    constexpr bool FP8 = (PREC == 1), I8 = (PREC == 2), MIXED = (PREC == 3);
    constexpr bool T8 = FP8 || MIXED;
    int tid_ = threadIdx.x; asm volatile("" : "+v"(tid_));
    const int tid = tid_, wid = __builtin_amdgcn_readfirstlane(tid >> 6), lane = tid & 63, wr = wid >> 2, wc = wid & 3, fr = lane & 15, fq = lane >> 4;
    const int K = g.ld;
    unsigned voffA[2], voffB[2];
#pragma unroll
    for (int i = 0; i < 2; ++i) { int R, C; stage_rc(tid * 16 + i * 8192, R, C); const int Rb = Epi::PERM ? ((R & ~31) + perm32(R & 31)) : R;
        voffA[i] = (unsigned)(R * K + C) * 2u; voffB[i] = (unsigned)(Rb * K + C) * 2u; }
    const size_t kstep = (size_t)(BK * 2);
    const size_t hstep = (size_t)HALF * K * 2;
    const size_t tstep = 2 * hstep;
    const size_t hstepB = g.bh ? g.bh : hstep, tstepB = g.bt ? g.bt : tstep;
    const unsigned ldsw = (unsigned)wid * 1024u;
    const int aoff = lds_byte(wr * 64 + fr, fq * 8), boff = lds_byte(wc * 32 + fr, fq * 8);
#define PG8_SA(b, h) (((b) * 2 + (h)) * HTB)
#define PG8_SB(b, h) ((4 + (b) * 2 + (h)) * HTB)
#define PG8_STAGE(bufoff, gbase, voff) do { _Pragma("unroll") for (int _i = 0; _i < 2; ++_i) \
        __builtin_amdgcn_global_load_lds((const unsigned*)((const char*)(gbase) + (voff)[_i]), (PG8_LAS unsigned*)(lds + (bufoff) + ldsw + _i * 8192), 16, 0, 0); } while (0)
#define PG8_LDA(dst, b, h) do { if constexpr (T8) { _Pragma("unroll") for (int m = 0; m < 4; ++m) { \
            const v4i_ lo_ = *(const PG8_LAS v4i_*)(lds + PG8_SA(b, h) + aoff + m * 2048), hi_ = *(const PG8_LAS v4i_*)(lds + PG8_SA(b, h) + aoff + m * 2048 + 1024); \
            dst##8[m] = __builtin_shufflevector(lo_, hi_, 0, 1, 2, 3, 4, 5, 6, 7); } } \
        else { _Pragma("unroll") for (int m = 0; m < 4; ++m) _Pragma("unroll") for (int k = 0; k < 2; ++k) dst[m][k] = *(const PG8_LAS bf16x8*)(lds + PG8_SA(b, h) + aoff + m * 2048 + k * 1024); } } while (0)
#define PG8_LDB(dst, b, h) do { if constexpr (T8) { _Pragma("unroll") for (int n = 0; n < 2; ++n) { \
            const v4i_ lo_ = *(const PG8_LAS v4i_*)(lds + PG8_SB(b, h) + boff + n * 2048), hi_ = *(const PG8_LAS v4i_*)(lds + PG8_SB(b, h) + boff + n * 2048 + 1024); \
            dst##8[n] = __builtin_shufflevector(lo_, hi_, 0, 1, 2, 3, 4, 5, 6, 7); } } \
        else { _Pragma("unroll") for (int n = 0; n < 2; ++n) _Pragma("unroll") for (int k = 0; k < 2; ++k) dst[n][k] = *(const PG8_LAS bf16x8*)(lds + PG8_SB(b, h) + boff + n * 2048 + k * 1024); } } while (0)
#define PG8_MMA(ai, bj, At, Bt) do { __builtin_amdgcn_s_setprio(1); \
        if constexpr (FP8) { \
            _Pragma("unroll") for (int m = 0; m < 4; ++m) _Pragma("unroll") for (int n = 0; n < 2; ++n) \
                asm volatile("v_mfma_scale_f32_16x16x128_f8f6f4 %0, %1, %2, %0, %3, %3 op_sel_hi:[0,0,0]" : "+v"(acc[ai][bj][m][n]) : "v"(Bt##8[n]), "v"(At##8[m]), "v"(fp8_unit_scale)); \
        } else if constexpr (MIXED) { if constexpr (F8SEG) { \
            _Pragma("unroll") for (int m = 0; m < 4; ++m) _Pragma("unroll") for (int n = 0; n < 2; ++n) \
                asm volatile("v_mfma_scale_f32_16x16x128_f8f6f4 %0, %1, %2, %0, %3, %3 op_sel_hi:[0,0,0]" : "+v"(acc[ai][bj][m][n]) : "v"(Bt##8[n]), "v"(At##8[m]), "v"(fp8_unit_scale)); \
          } else { _Pragma("unroll") for (int m = 0; m < 4; ++m) _Pragma("unroll") for (int n = 0; n < 2; ++n) { \
                asm volatile("v_mfma_f32_16x16x32_bf16 %0, %1, %2, %0" : "+v"(acc[ai][bj][m][n]) : "v"(Bt##8[n].lo), "v"(At##8[m].lo)); } \
            _Pragma("unroll") for (int m = 0; m < 4; ++m) _Pragma("unroll") for (int n = 0; n < 2; ++n) { \
                asm volatile("v_mfma_f32_16x16x32_bf16 %0, %1, %2, %0" : "+v"(acc[ai][bj][m][n]) : "v"(Bt##8[n].hi), "v"(At##8[m].hi)); } } \
        } else if constexpr (I8) { _Pragma("unroll") for (int k = 0; k < 2; ++k) _Pragma("unroll") for (int m = 0; m < 4; ++m) _Pragma("unroll") for (int n = 0; n < 2; ++n) \
            acc[ai][bj][m][n] = __builtin_bit_cast(f32x4, __builtin_amdgcn_mfma_i32_16x16x64_i8(__builtin_bit_cast(v4i_, Bt[n][k]), __builtin_bit_cast(v4i_, At[m][k]), __builtin_bit_cast(v4i_, acc[ai][bj][m][n]), 0, 0, 0)); \
        } else { _Pragma("unroll") for (int m = 0; m < 4; ++m) _Pragma("unroll") for (int n = 0; n < 2; ++n) _Pragma("unroll") for (int k = 0; k < 2; ++k) \
            acc[ai][bj][m][n] = __builtin_amdgcn_mfma_f32_16x16x32_bf16(Bt[n][k], At[m][k], acc[ai][bj][m][n], 0, 0, 0); } \
        __builtin_amdgcn_s_setprio(0); } while (0)
#define PG8_WAIT_V(n) asm volatile("s_waitcnt vmcnt(" #n ")" ::: "memory")
#define PG8_WAIT_L(n) asm volatile("s_waitcnt lgkmcnt(" #n ")" ::: "memory")
#define PG8_BAR __builtin_amdgcn_s_barrier()
#define PG8_SCHED __builtin_amdgcn_sched_barrier(0)
    Unit cur, nxt; int ui = 0;
    if (!S.next(0, cur)) return;
    f32x4 acc[2][2][4][2];
#pragma unroll
    for (int a = 0; a < 2; ++a)
#pragma unroll
        for (int b = 0; b < 2; ++b)
#pragma unroll
            for (int m = 0; m < 4; ++m)
#pragma unroll
                for (int n = 0; n < 2; ++n) acc[a][b][m][n] = (f32x4){0.f, 0.f, 0.f, 0.f};
    typedef int v8i_ __attribute__((ext_vector_type(8))); typedef int v4i_ __attribute__((ext_vector_type(4)));
    int fp8_unit_scale = 0x7f7f7f7f; asm volatile("" : "+v"(fp8_unit_scale));
    bf16x8 At[4][2], B0[2][2], B1[2][2]; v8i_ At8[4], B08[2], B18[2];
    bool seg8 = MIXED && cur.f8();
    const char* cA = (const char*)((MIXED && cur.f8()) ? g.A8 : g.A) + (size_t)cur.pm() * tstep + (size_t)cur.k0() * 2; const char* cB = (const char*)((MIXED && cur.f8()) ? g.B8 : g.Bt) + (size_t)cur.pn() * tstepB + (size_t)cur.k0() * 2;
    S.a_ready(cur);
    if constexpr (SP2) {
        PG8_STAGE(PG8_SB(0, 0), cB, voffB); PG8_STAGE(PG8_SB(0, 1), cB + hstepB, voffB); PG8_STAGE(PG8_SA(0, 0), cA, voffA); PG8_STAGE(PG8_SA(0, 1), cA + hstep, voffA);
        if (wr == 1) PG8_BAR;
        PG8_WAIT_V(2); PG8_BAR;
        PG8_STAGE(PG8_SB(1, 0), cB + kstep, voffB); PG8_STAGE(PG8_SA(1, 0), cA + kstep, voffA); PG8_STAGE(PG8_SB(1, 1), cB + hstepB + kstep, voffB);
        PG8_WAIT_V(6); PG8_BAR;
    } else {
        PG8_STAGE(PG8_SB(0, 0), cB, voffB); PG8_STAGE(PG8_SA(0, 0), cA, voffA); PG8_STAGE(PG8_SB(0, 1), cB + hstepB, voffB); PG8_STAGE(PG8_SA(0, 1), cA + hstep, voffA);
        if (wr == 1) PG8_BAR;
        PG8_WAIT_V(4); PG8_BAR;
        PG8_STAGE(PG8_SB(1, 0), cB + kstep, voffB); PG8_STAGE(PG8_SA(1, 0), cA + kstep, voffA); PG8_STAGE(PG8_SB(1, 1), cB + hstepB + kstep, voffB);
        PG8_WAIT_V(6); PG8_BAR;
    }
    if constexpr (MIXED) {
    auto seg_ = [&](auto tag_) __attribute__((always_inline)) -> bool { constexpr bool F8SEG = decltype(tag_)::value; (void)F8SEG;
        const bool has_next = S.next(ui + 1, nxt);
        const char* nA = has_next ? (const char*)((MIXED && nxt.f8()) ? g.A8 : g.A) + (size_t)nxt.pm() * tstep + (size_t)nxt.k0() * 2 : cA; const char* nB = has_next ? (const char*)((MIXED && nxt.f8()) ? g.B8 : g.Bt) + (size_t)nxt.pn() * tstepB + (size_t)nxt.k0() * 2 : cB;
        const int nt = cur.nt();
        for (int t = 0; t < nt; t += 2) {
            const bool last = (t == nt - 2);
            const char* a1 = cA + (size_t)(t + 1) * kstep;
            const char* a2 = last ? nA : cA + (size_t)(t + 2) * kstep; const char* b2 = last ? nB : cB + (size_t)(t + 2) * kstep;
            const char* a3 = a2 + kstep; const char* b3 = b2 + kstep;
            if (last && has_next) S.a_ready(nxt);
            if constexpr (SP2) {
            PG8_LDB(B0, 0, 0); PG8_LDB(B1, 0, 1); PG8_SCHED; PG8_LDA(At, 0, 0); PG8_STAGE(PG8_SA(1, 1), a1 + hstep, voffA);
            PG8_WAIT_V(8); PG8_WAIT_L(0); PG8_BAR; PG8_MMA(0, 0, At, B0); PG8_MMA(0, 1, At, B1); PG8_BAR; PG8_SCHED;
            PG8_LDA(At, 0, 1); PG8_STAGE(PG8_SB(0, 0), b2, voffB); PG8_STAGE(PG8_SB(0, 1), b2 + hstepB, voffB); PG8_STAGE(PG8_SA(0, 0), a2, voffA);
            PG8_WAIT_V(8); PG8_WAIT_L(0); PG8_BAR; PG8_MMA(1, 0, At, B0); PG8_MMA(1, 1, At, B1); PG8_BAR; PG8_SCHED;
            PG8_LDB(B0, 1, 0); PG8_LDB(B1, 1, 1); PG8_SCHED; PG8_LDA(At, 1, 0); PG8_STAGE(PG8_SA(0, 1), a2 + hstep, voffA);
            PG8_WAIT_V(8); PG8_WAIT_L(0); PG8_BAR; PG8_MMA(0, 0, At, B0); PG8_MMA(0, 1, At, B1); PG8_BAR; PG8_SCHED;
            PG8_LDA(At, 1, 1); PG8_STAGE(PG8_SB(1, 0), b3, voffB); PG8_STAGE(PG8_SB(1, 1), b3 + hstepB, voffB); PG8_STAGE(PG8_SA(1, 0), a3, voffA);
            PG8_WAIT_V(8); PG8_WAIT_L(0); PG8_BAR; PG8_MMA(1, 0, At, B0); PG8_MMA(1, 1, At, B1); PG8_BAR; PG8_SCHED;
            } else {
            PG8_LDB(B0, 0, 0); PG8_SCHED; PG8_LDA(At, 0, 0); PG8_STAGE(PG8_SA(1, 1), a1 + hstep, voffA);
            PG8_WAIT_L(8); PG8_BAR; PG8_WAIT_L(0); PG8_MMA(0, 0, At, B0); PG8_BAR; PG8_SCHED;
            PG8_LDB(B1, 0, 1); PG8_STAGE(PG8_SB(0, 0), b2, voffB);
            PG8_BAR; PG8_WAIT_L(0); PG8_MMA(0, 1, At, B1); PG8_BAR;
            PG8_LDA(At, 0, 1); PG8_STAGE(PG8_SA(0, 0), a2, voffA);
            PG8_BAR; PG8_WAIT_L(0); PG8_MMA(1, 0, At, B0); PG8_BAR; PG8_SCHED;
            PG8_STAGE(PG8_SB(0, 1), b2 + hstepB, voffB);
            PG8_WAIT_V(6); PG8_BAR; PG8_MMA(1, 1, At, B1); PG8_BAR;
            PG8_LDB(B0, 1, 0); PG8_SCHED; PG8_LDA(At, 1, 0); PG8_STAGE(PG8_SA(0, 1), a2 + hstep, voffA);
            PG8_WAIT_L(8); PG8_BAR; PG8_WAIT_L(0); PG8_MMA(0, 0, At, B0); PG8_BAR; PG8_SCHED;
            PG8_LDB(B1, 1, 1); PG8_STAGE(PG8_SB(1, 0), b3, voffB);
            PG8_BAR; PG8_WAIT_L(0); PG8_MMA(0, 1, At, B1); PG8_BAR;
            PG8_LDA(At, 1, 1); PG8_STAGE(PG8_SA(1, 0), a3, voffA);
            PG8_BAR; PG8_WAIT_L(0); PG8_MMA(1, 0, At, B0); PG8_BAR; PG8_SCHED;
            PG8_STAGE(PG8_SB(1, 1), b3 + hstepB, voffB);
            PG8_WAIT_V(6); PG8_BAR; PG8_MMA(1, 1, At, B1); PG8_BAR;
            }
        }
        if constexpr (FP8 || MIXED) asm volatile("s_nop 15\n\ts_nop 15" ::: "memory");
        if constexpr (ALIGN_EPI) { if (wr == 0) PG8_BAR; }
        if constexpr (MIXED && F8SEG) {
            _Pragma("unroll") for (int a = 0; a < 2; ++a) _Pragma("unroll") for (int b = 0; b < 2; ++b) _Pragma("unroll") for (int m = 0; m < 4; ++m) _Pragma("unroll") for (int n = 0; n < 2; ++n) acc[a][b][m][n] = acc[a][b][m][n] * g.seam;
        } else
        if constexpr (!Epi::AFTER_DRAIN) { bool fin = true; if (cur.ns() > 1) fin = S.combine(acc, cur, wid, lane); if (fin) E(acc, cur, wr, wc, fr, fq); S.done(cur); }
        if (!has_next) return true;
        if constexpr (!(MIXED && F8SEG)) {
#pragma unroll
        for (int a = 0; a < 2; ++a)
#pragma unroll
            for (int b = 0; b < 2; ++b)
#pragma unroll
                for (int m = 0; m < 4; ++m)
#pragma unroll
                    for (int n = 0; n < 2; ++n) acc[a][b][m][n] = (f32x4){0.f, 0.f, 0.f, 0.f};
        }
        cur = nxt; cA = nA; cB = nB; ++ui; seg8 = MIXED && cur.f8();
        if constexpr (ALIGN_EPI) { if (wr == 1) PG8_BAR; }
            return false;
    };
    for (;;) {
        if constexpr (MIXED) { if (seg_(BoolTag<true>{})) break; }
        if (seg_(BoolTag<false>{})) break;
    }
    } else {
    constexpr bool F8SEG = false; (void)F8SEG;
    for (;;) {
        const bool has_next = S.next(ui + 1, nxt);
        const char* nA = has_next ? (const char*)g.A + (size_t)nxt.pm() * tstep + (size_t)nxt.k0() * 2 : cA; const char* nB = has_next ? (const char*)g.Bt + (size_t)nxt.pn() * tstepB + (size_t)nxt.k0() * 2 : cB;
        const int nt = cur.nt();
        for (int t = 0; t < nt; t += 2) {
            const bool last = (t == nt - 2);
            const char* a1 = cA + (size_t)(t + 1) * kstep;
            const char* a2 = last ? nA : cA + (size_t)(t + 2) * kstep; const char* b2 = last ? nB : cB + (size_t)(t + 2) * kstep;
            const char* a3 = a2 + kstep; const char* b3 = b2 + kstep;
            if (last && has_next) S.a_ready(nxt);
            if constexpr (SP2) {
            PG8_LDB(B0, 0, 0); PG8_LDB(B1, 0, 1); PG8_SCHED; PG8_LDA(At, 0, 0); PG8_STAGE(PG8_SA(1, 1), a1 + hstep, voffA);
            PG8_WAIT_V(8); PG8_WAIT_L(0); PG8_BAR; PG8_MMA(0, 0, At, B0); PG8_MMA(0, 1, At, B1); PG8_BAR; PG8_SCHED;
            PG8_LDA(At, 0, 1); PG8_STAGE(PG8_SB(0, 0), b2, voffB); PG8_STAGE(PG8_SB(0, 1), b2 + hstepB, voffB); PG8_STAGE(PG8_SA(0, 0), a2, voffA);
            PG8_WAIT_V(8); PG8_WAIT_L(0); PG8_BAR; PG8_MMA(1, 0, At, B0); PG8_MMA(1, 1, At, B1); PG8_BAR; PG8_SCHED;
            PG8_LDB(B0, 1, 0); PG8_LDB(B1, 1, 1); PG8_SCHED; PG8_LDA(At, 1, 0); PG8_STAGE(PG8_SA(0, 1), a2 + hstep, voffA);
            PG8_WAIT_V(8); PG8_WAIT_L(0); PG8_BAR; PG8_MMA(0, 0, At, B0); PG8_MMA(0, 1, At, B1); PG8_BAR; PG8_SCHED;
            PG8_LDA(At, 1, 1); PG8_STAGE(PG8_SB(1, 0), b3, voffB); PG8_STAGE(PG8_SB(1, 1), b3 + hstepB, voffB); PG8_STAGE(PG8_SA(1, 0), a3, voffA);
            PG8_WAIT_V(8); PG8_WAIT_L(0); PG8_BAR; PG8_MMA(1, 0, At, B0); PG8_MMA(1, 1, At, B1); PG8_BAR; PG8_SCHED;
            } else {
            PG8_LDB(B0, 0, 0); PG8_SCHED; PG8_LDA(At, 0, 0); PG8_STAGE(PG8_SA(1, 1), a1 + hstep, voffA);
            PG8_WAIT_L(8); PG8_BAR; PG8_WAIT_L(0); PG8_MMA(0, 0, At, B0); PG8_BAR; PG8_SCHED;
            PG8_LDB(B1, 0, 1); PG8_STAGE(PG8_SB(0, 0), b2, voffB);
            PG8_BAR; PG8_WAIT_L(0); PG8_MMA(0, 1, At, B1); PG8_BAR;
            PG8_LDA(At, 0, 1); PG8_STAGE(PG8_SA(0, 0), a2, voffA);
            PG8_BAR; PG8_WAIT_L(0); PG8_MMA(1, 0, At, B0); PG8_BAR; PG8_SCHED;
            PG8_STAGE(PG8_SB(0, 1), b2 + hstepB, voffB);
            PG8_WAIT_V(6); PG8_BAR; PG8_MMA(1, 1, At, B1); PG8_BAR;
            PG8_LDB(B0, 1, 0); PG8_SCHED; PG8_LDA(At, 1, 0); PG8_STAGE(PG8_SA(0, 1), a2 + hstep, voffA);
            PG8_WAIT_L(8); PG8_BAR; PG8_WAIT_L(0); PG8_MMA(0, 0, At, B0); PG8_BAR; PG8_SCHED;
            PG8_LDB(B1, 1, 1); PG8_STAGE(PG8_SB(1, 0), b3, voffB);
            PG8_BAR; PG8_WAIT_L(0); PG8_MMA(0, 1, At, B1); PG8_BAR;
            PG8_LDA(At, 1, 1); PG8_STAGE(PG8_SA(1, 0), a3, voffA);
            PG8_BAR; PG8_WAIT_L(0); PG8_MMA(1, 0, At, B0); PG8_BAR; PG8_SCHED;
            PG8_STAGE(PG8_SB(1, 1), b3 + hstepB, voffB);
            PG8_WAIT_V(6); PG8_BAR; PG8_MMA(1, 1, At, B1); PG8_BAR;
            }
        }
        if constexpr (FP8) asm volatile("s_nop 15\n\ts_nop 15" ::: "memory");
        if constexpr (ALIGN_EPI) { if (wr == 0) PG8_BAR; }
        if constexpr (!Epi::AFTER_DRAIN) { bool fin = true; if (cur.ns() > 1) fin = S.combine(acc, cur, wid, lane); if (fin) E(acc, cur, wr, wc, fr, fq); S.done(cur); }
        if (!has_next) break;
#pragma unroll
        for (int a = 0; a < 2; ++a)
#pragma unroll
            for (int b = 0; b < 2; ++b)
#pragma unroll
                for (int m = 0; m < 4; ++m)
#pragma unroll
                    for (int n = 0; n < 2; ++n) acc[a][b][m][n] = (f32x4){0.f, 0.f, 0.f, 0.f};
        cur = nxt; cA = nA; cB = nB; ++ui;
        if constexpr (ALIGN_EPI) { if (wr == 1) PG8_BAR; }
    }
    }
    PG8_WAIT_V(0);
    if constexpr (!ALIGN_EPI) { if (wr == 0) PG8_BAR; }
    PG8_BAR;
    if constexpr (Epi::AFTER_DRAIN) { E.fused(acc, cur, wr, wc, fr, fq, lds, wid, lane); S.done(cur); }
#undef PG8_SA
#undef PG8_SB
#undef PG8_STAGE
#undef PG8_LDA
#undef PG8_LDB
#undef PG8_MMA
#undef PG8_WAIT_V
#undef PG8_WAIT_L
#undef PG8_BAR
#undef PG8_SCHED
}
}
#define GAS __attribute__((address_space(1)))
#define LAS __attribute__((address_space(3)))
typedef unsigned short bf16;
typedef unsigned v4u __attribute__((ext_vector_type(4)));
typedef float f32x4 __attribute__((ext_vector_type(4)));
typedef short bf16x8 __attribute__((ext_vector_type(8)));
typedef GAS unsigned gu32;
typedef GAS unsigned long long gu64;
#define RLX_AGENT __ATOMIC_RELAXED, __HIP_MEMORY_SCOPE_AGENT
#define LDS_WAIT() asm volatile("s_waitcnt lgkmcnt(0)" ::: "memory")
#define VM_WAIT() asm volatile("s_waitcnt vmcnt(0)" ::: "memory")
__device__ __forceinline__ unsigned long long rt() { return __builtin_amdgcn_s_memrealtime(); }
__device__ __forceinline__ unsigned f2bf(float f) { unsigned u = __builtin_bit_cast(unsigned, f); return (u + 0x7fffu + ((u >> 16) & 1u)) >> 16; }
__device__ __forceinline__ unsigned pk2(float lo, float hi) { return f2bf(lo) | (f2bf(hi) << 16); }
#define XB_TMO      128
#define XB_XCNT(j)  (256  + 64 * (j))
#define XB_XSUB(j)  (1280 + 64 * (j))
#define XB_XGEN(j)  (2304 + 64 * (j))
#define XB_TOP      3328
#define XB_TOPGEN   3392
#define XCD_BAR_WORDS 3456
#define XB_SPIN_CAP (1u << 18)

__device__ __forceinline__ unsigned xb_ld(unsigned* p)              { return __hip_atomic_load(p, __ATOMIC_RELAXED, __HIP_MEMORY_SCOPE_AGENT); }
__device__ __forceinline__ unsigned xb_add(unsigned* p, unsigned v) { return __hip_atomic_fetch_add(p, v, __ATOMIC_RELAXED, __HIP_MEMORY_SCOPE_AGENT); }
__device__ __forceinline__ unsigned xb_xcc_id() { return (unsigned)__builtin_amdgcn_s_getreg((3 << 11) | 20) & 0xFu; }
#define XB_SPIN(cond, bar) do { unsigned _sp = 0; while (cond) { __builtin_amdgcn_s_sleep(1); \
    if ((++_sp & 255u) == 0u) { if (xb_ld(&(bar)[XB_TMO])) break; if (_sp > XB_SPIN_CAP) { atomicAdd(&(bar)[XB_TMO], 1u); break; } } } } while (0)

struct XcdBarrier {
    unsigned* bar; unsigned x;
    volatile LAS unsigned* st;
};

__device__ __forceinline__ XcdBarrier xcd_barrier_post(unsigned* bar, volatile LAS unsigned* st) {
    XcdBarrier b; b.bar = bar; b.x = xb_xcc_id(); b.st = st;
    if (threadIdx.x == 0) (void)xb_add(&bar[XB_XCNT(b.x)], 1u);
    return b;
}
__device__ __forceinline__ void xcd_barrier_complete(unsigned* bar, unsigned x, unsigned& nloc, unsigned& nx) {
    const unsigned G = gridDim.x * gridDim.y * gridDim.z;
    unsigned sum, cnt, mine, sp = 0u;
    for (;;) {
        sum = 0u; cnt = 0u; mine = 0u;
#pragma unroll
        for (unsigned j = 0; j < 16; ++j) { const unsigned c = xb_ld(&bar[XB_XCNT(j)]); sum += c; cnt += (c > 0u) ? 1u : 0u; mine = (j == x) ? c : mine; }
        if (sum == G) break;
        __builtin_amdgcn_s_sleep(1);
        if ((++sp & 255u) == 0u) { if (xb_ld(&bar[XB_TMO])) break; if (sp > XB_SPIN_CAP) { atomicAdd(&bar[XB_TMO], 1u); break; } }
    }
    nloc = mine > 0u ? mine : 1u; nx = cnt > 0u ? cnt : 1u;
}

__device__ __forceinline__ void xcd_barrier(const XcdBarrier& b) {
    asm volatile("s_waitcnt vmcnt(0)" ::: "memory");
    __syncthreads();
    if (threadIdx.x == 0) {
        unsigned* bar = b.bar;
        __builtin_amdgcn_s_waitcnt(0);
        unsigned nloc = b.st[0], nx = b.st[1];
        if (nloc == 0u) { xcd_barrier_complete(bar, b.x, nloc, nx); b.st[0] = nloc; b.st[1] = nx; }
        const unsigned old = xb_add(&bar[XB_XSUB(b.x)], 1u);
        const unsigned gen = old / nloc;
        if (old + 1u == (gen + 1u) * nloc) {
            __builtin_amdgcn_fence(__ATOMIC_RELEASE, "agent");
            asm volatile("s_waitcnt vmcnt(0)" ::: "memory");
            (void)xb_add(&bar[XB_TOP], 1u);
        }
        XB_SPIN(xb_ld(&bar[XB_TOP]) < (gen + 1u) * nx, bar);
        __builtin_amdgcn_fence(__ATOMIC_ACQUIRE, "agent");
        asm volatile("s_waitcnt vmcnt(0)" ::: "memory");
    }
    __syncthreads();
}
__device__ __forceinline__ float wave_sum(float v) {
#pragma unroll
    for (int o = 1; o < 64; o <<= 1) v += __shfl_xor(v, o);
    return v;
}
__device__ __forceinline__ void p0_transpose_item(const float* W, int K, int N, bf16* WT, int ldt, LAS float* scr, int item, int lane, int gu_half = 0) {
    const int nblk = N / 32, kb = item / nblk, nb = item % nblk, k0 = 64 * kb, n0 = 32 * nb;
    const int d0 = gu_half ? ((n0 < gu_half) ? ((n0 >> 7) * 256 + (n0 & 127)) : (((n0 - gu_half) >> 7) * 256 + 128 + ((n0 - gu_half) & 127))) : n0;
#pragma unroll 8
    for (int i = 0; i < 32; ++i) { const int kk = 2 * i + (lane >> 5); scr[kk * 33 + (lane & 31)] = W[(size_t)(k0 + kk) * N + n0 + (lane & 31)]; }
    LDS_WAIT(); asm volatile("" ::: "memory");
    const int c = lane & 7;
#pragma unroll
    for (int j = 0; j < 4; ++j) { const int n = (lane >> 3) + 8 * j; const LAS float* s = scr + (8 * c) * 33 + n;
        v4u o; o.x = pk2(s[0 * 33], s[1 * 33]); o.y = pk2(s[2 * 33], s[3 * 33]); o.z = pk2(s[4 * 33], s[5 * 33]); o.w = pk2(s[6 * 33], s[7 * 33]);
        *(GAS v4u*)(WT + (size_t)(d0 + n) * ldt + k0 + 8 * c) = o; }
    LDS_WAIT(); asm volatile("" ::: "memory");
}

constexpr int NWAVES = 8;
constexpr int DM = 4096, SEQ = 4096, NTOKP = 8192, NTOKS = 1024, MTOT = 9216, NCOND = 130;
constexpr int NIN = 8704, NPR = 2560  , DFF = 11008, NGU = 22016, NMOD = 24576, DCONV = 2048;
constexpr int PKB = DM + 128;
__device__ __forceinline__ bool i8_panel(int pm) { return pm < 31 && pm != 15; }
constexpr size_t WS_WGU8 = (1037 + 32) * (size_t)(1u << 20), WS_H8 = (1037 + 160) * (size_t)(1u << 20), WS_HS = (1037 + 224) * (size_t)(1u << 20)  , WS_WIN8 = (1037 + 243) * (size_t)(1u << 20)  , WS_HST = (1037 + 285) * (size_t)(1u << 20)  ,
                 WS_WOUT8A = (1037 + 289) * (size_t)(1u << 20)  , WS_MIX8A = 716 * (size_t)(1u << 20)  ;
constexpr int PFB = DFF + 128;
constexpr int PK = DM + 64, PF = DFF + 64;
constexpr int COL_K = 2048, COL_V = 2304, COL_B = 2560, COL_C = 4608, COL_HC = 6656;
constexpr float RMS_EPS = 1e-5f;
constexpr float LOG2E = 1.4426950408889634f;
constexpr size_t O_Y = 0, O_KP = 37748736, O_VP = O_KP + 65536, O_CP = O_VP + 65536, O_FP = O_CP + 8192, O_KS = O_FP + 44032, O_VS = O_KS + 4194304,
                 O_CS = O_VS + 4194304, O_FS = O_CS + 524288, O_END = O_FS + 2818048;
static_assert(O_END == 49662976, "d_out map");
constexpr size_t MiB = 1u << 20;
constexpr size_t WS_CTL = 0, CTL_ZERO_BYTES = 256 * 1024;
constexpr size_t WS_SC = 2 * MiB, WS_MOD = 5 * MiB, WS_WIN = 32 * MiB, WS_WOUT = 102 * MiB, WS_WGU = 135 * MiB, WS_WDN = 310 * MiB, WS_WMOD = 397 * MiB,
                 WS_H = 592 * MiB, WS_PROJ = 666 * MiB, WS_MIX = 819 * MiB, WS_X1 = 893 * MiB, WS_GU = 1037 * MiB, WS_SLAB = 1424 * MiB, WS_END = 1488 * MiB, WS_ACT = 397 * MiB;
static_assert(WS_SC + (size_t)256 * PK * 2 <= WS_MOD && WS_WIN + (size_t)NIN * PK * 2 <= WS_WOUT && WS_WOUT + (size_t)DM * PK * 2 <= WS_WGU && WS_WGU + (size_t)NGU * PK * 2 <= WS_WDN && WS_WDN + (size_t)DM * PF * 2 <= WS_WMOD && WS_WMOD + (size_t)NMOD * PK * 2 <= WS_H &&
              WS_H + (size_t)MTOT * PK * 2 <= WS_PROJ && WS_PROJ + (size_t)MTOT * NIN * 2 <= WS_MIX && WS_MIX + (size_t)MTOT * PK * 2 <= WS_X1 && WS_X1 + (size_t)MTOT * DM * 4 <= WS_GU &&
              WS_GU + (size_t)MTOT * NGU * 2 <= WS_SLAB && WS_ACT + (size_t)MTOT * PF * 2 <= WS_H && WS_MOD + (size_t)256 * NMOD * 4 <= WS_WIN, "d_ws map");
constexpr int CW_CONVQ = 1024  , CW_SCRDY = 1408  , CW_MODRDY = 1472  , CW_XRANK = 2048  , CW_BAR = 4096, CW_TICK = 16384, TICK_WORDS = 8192;
constexpr int RING_OFF = 0, RING_BYTES = 131072;
constexpr int LDSCTL_OFF = RING_BYTES, MISC_OFF = LDSCTL_OFF + 320;
constexpr int HALO_OFF = LDSCTL_OFF + 1024;
constexpr int LDS_BYTES = 147456;

typedef float f32x16 __attribute__((ext_vector_type(16)));
typedef float f32x2_t __attribute__((ext_vector_type(2)));
typedef __bf16 bf16x2_t __attribute__((ext_vector_type(2)));
typedef short s16x4 __attribute__((ext_vector_type(4)));
#define DI __device__ __forceinline__
DI int opaque_tid() { int t_ = threadIdx.x; asm volatile("" : "+v"(t_)); return t_; }
DI unsigned cvtpk(float lo, float hi) { f32x2_t v = {lo, hi}; bf16x2_t b = __builtin_convertvector(v, bf16x2_t); return __builtin_bit_cast(unsigned, b); }
DI float bf_lo(unsigned w) { return __uint_as_float(w << 16); }
DI float bf_hi(unsigned w) { return __uint_as_float(w & 0xffff0000u); }
DI void unpack8(const v4u w, float (&f)[8]) { f[0] = bf_lo(w.x); f[1] = bf_hi(w.x); f[2] = bf_lo(w.y); f[3] = bf_hi(w.y); f[4] = bf_lo(w.z); f[5] = bf_hi(w.z); f[6] = bf_lo(w.w); f[7] = bf_hi(w.w); }
DI v4u pack8(const float (&f)[8]) { v4u w; w.x = cvtpk(f[0], f[1]); w.y = cvtpk(f[2], f[3]); w.z = cvtpk(f[4], f[5]); w.w = cvtpk(f[6], f[7]); return w; }
DI float silu_f(float x) { return x / (1.0f + __expf(-x)); }

struct Frame {
    LAS unsigned char* lds;
    volatile LAS unsigned* MISC;
    gu32* ctl;
    int wave, vcu, G;
};
struct Args { const float* in[20]; float* out; unsigned char* ws; int ph_lo, ph_hi, li, pad; };

struct ConvMat { const float* W; bf16* WT; int K, N, ldt, gu_half; int f8 = 0; unsigned char* WT8 = nullptr; int ldt8 = 0; int c8fp = 0; };
DI int inproj_row(int n) {
    if (n < 2048) return ((n >> 6) << 8) + 128 + ((n >> 4) & 3) * 32 + ((n >> 2) & 3) * 8 + 4 + (n & 3);
    if (n < 2560) return 8192 + (n - 2048);
    const int reg = (n - 2560) >> 11, ch = (n - 2560) & 2047;
    return ((ch >> 6) << 8) + (reg == 2 ? 128 : 0) + ((ch >> 4) & 3) * 32 + ((ch >> 2) & 3) * 8 + (reg == 1 ? 4 : 0) + (ch & 3);
}
DI void tr_load(const ConvMat& m, int item, int lane, float (&v)[32]) {
    const int nblk = m.N / 32, kb = item / nblk, nb = item - kb * nblk;
    const GAS float* p = (const GAS float*)m.W + (size_t)(64 * kb + 32 * (lane >> 5)) * m.N + 32 * nb + (lane & 31);
#pragma unroll
    for (int i = 0; i < 32; ++i) v[i] = __builtin_nontemporal_load(p + (size_t)i * m.N);
}
DI void tr_store(const ConvMat& m, int item, int lane, const float (&v)[32], LAS unsigned* scr) {
    const int nblk = m.N / 32, kb = item / nblk, nb = item - kb * nblk, k0 = 64 * kb, n0 = 32 * nb;
    const int d0 = m.gu_half > 0 ? ((n0 < m.gu_half) ? ((n0 >> 7) * 256 + (n0 & 127)) : (((n0 - m.gu_half) >> 7) * 256 + 128 + ((n0 - m.gu_half) & 127))) : n0;
    LAS unsigned* sw = scr + (lane & 31) * 34 + 16 * (lane >> 5);
#pragma unroll
    for (int ip = 0; ip < 16; ++ip) sw[ip] = cvtpk(v[2 * ip], v[2 * ip + 1]);
    LDS_WAIT(); asm volatile("" ::: "memory");
    const int c = lane & 7;
#pragma unroll
    for (int j = 0; j < 4; ++j) { const int nn = (lane >> 3) + 8 * j; typedef unsigned u32x2 __attribute__((ext_vector_type(2)));
        const LAS u32x2* sp = (const LAS u32x2*)(scr + nn * 34 + 4 * c); const u32x2 x = sp[0], y = sp[1];
        const int drow = m.gu_half < 0 ? inproj_row(n0 + nn) : d0 + nn;
        *(GAS v4u*)(m.WT + (size_t)drow * m.ldt + k0 + 8 * c) = (v4u){x.x, x.y, y.x, y.y}; }
    LDS_WAIT(); asm volatile("" ::: "memory");
}
DI unsigned pack_fp8x4(float a, float b, float c, float d) {
    int w = 0;
    w = __builtin_amdgcn_cvt_pk_fp8_f32(__builtin_amdgcn_fmed3f(a, -448.0f, 448.0f), __builtin_amdgcn_fmed3f(b, -448.0f, 448.0f), w, false);
    w = __builtin_amdgcn_cvt_pk_fp8_f32(__builtin_amdgcn_fmed3f(c, -448.0f, 448.0f), __builtin_amdgcn_fmed3f(d, -448.0f, 448.0f), w, true);
    return (unsigned)w;
}
DI unsigned pack_i8x4(float a, float b, float c, float d) {
    const int ia = (int)__builtin_rintf(__builtin_amdgcn_fmed3f(a, -127.0f, 127.0f)), ib = (int)__builtin_rintf(__builtin_amdgcn_fmed3f(b, -127.0f, 127.0f));
    const int ic = (int)__builtin_rintf(__builtin_amdgcn_fmed3f(c, -127.0f, 127.0f)), id = (int)__builtin_rintf(__builtin_amdgcn_fmed3f(d, -127.0f, 127.0f));
    return ((unsigned)ia & 255u) | (((unsigned)ib & 255u) << 8) | (((unsigned)ic & 255u) << 16) | ((unsigned)id << 24);
}
DI void tr_store_f8(const ConvMat& m, int item, int lane, const float (&v)[32], LAS unsigned* scr) {
    const int nblk = m.N / 32, kb = item / nblk, nb = item - kb * nblk, k0 = 64 * kb, n0 = 32 * nb;
    const int d0 = m.gu_half > 0 ? ((n0 < m.gu_half) ? ((n0 >> 7) * 256 + (n0 & 127)) : (((n0 - m.gu_half) >> 7) * 256 + 128 + ((n0 - m.gu_half) & 127))) : n0;
    GAS unsigned char* dst = m.WT8 ? (GAS unsigned char*)m.WT8 : (GAS unsigned char*)m.WT; const int ld_ = m.WT8 ? m.ldt8 : m.ldt;
    LAS unsigned* sw = scr + (lane & 31) * 20 + 8 * (lane >> 5);
    const float S_ = m.WT8 ? (m.c8fp ? pg8::WOUT_PRESCALE : pg8::WGU_I8SCALE) : pg8::WDN_PRESCALE; const bool i8c_ = m.WT8 && !m.c8fp;
#pragma unroll
    for (int q = 0; q < 8; ++q) sw[q] = i8c_ ? pack_i8x4(v[4 * q] * S_, v[4 * q + 1] * S_, v[4 * q + 2] * S_, v[4 * q + 3] * S_) : pack_fp8x4(v[4 * q] * S_, v[4 * q + 1] * S_, v[4 * q + 2] * S_, v[4 * q + 3] * S_);
    LDS_WAIT(); asm volatile("" ::: "memory");
#pragma unroll
    for (int j = 0; j < 2; ++j) { const int p_ = lane + 64 * j, nn = p_ >> 2, c = p_ & 3;
        const v4u x = *(const LAS v4u*)(scr + nn * 20 + 4 * c);
        const int drow = m.gu_half < 0 ? inproj_row(n0 + nn) : d0 + nn;
        *(GAS v4u*)(dst + (size_t)drow * ld_ + k0 + 16 * c) = x; }
    LDS_WAIT(); asm volatile("" ::: "memory");
}
constexpr int I_IN = (DM / 64) * (NIN / 32), I_OUT = (DM / 64) * (DM / 32), I_GU = (DM / 64) * (NGU / 32), I_DN = (DFF / 64) * (DM / 32);
constexpr int I_DN_P5 = 0;
constexpr int I_END0 = I_IN, I_END1 = I_IN + I_OUT, I_END2 = I_END1 + I_GU, I_END3 = I_END2 + I_DN;
DI ConvMat conv_mat(const Args& a, int& item) {
    unsigned char* ws = a.ws;
    const float* w0_ = a.in[12]; const float* w1_ = a.in[15]; const float* w2_ = a.in[16]; const float* w3_ = a.in[18];
    asm volatile("" : "+s"(w0_), "+s"(w1_), "+s"(w2_), "+s"(w3_));
    if (item < I_END0) return ConvMat{w0_, (bf16*)(ws + WS_WIN), DM, NIN, PK, -1, 0, ws + WS_WIN8, PKB};
    if (item < I_END1) { item -= I_END0; return ConvMat{w1_, (bf16*)(ws + WS_WOUT), DM, DM, PK, 0, 0, ws + WS_WOUT8A, 2 * PK, 1}; }
    if (item < I_END2) { item -= I_END1; return ConvMat{w2_, (bf16*)(ws + WS_WGU), DM, NGU, PK, DFF, 0, ws + WS_WGU8, PKB}; }
    item -= I_END2; return ConvMat{w3_, (bf16*)(ws + WS_WDN), DFF, DM, PFB, 0, 1};
}
struct PairRegs { float a[32], b[32]; };
DI void pair_load(const Args& a, int it, int hi, int lane, PairRegs& r) {
    int ia = it, ib = (it + 1 < hi) ? it + 1 : it;
    const ConvMat ma = conv_mat(a, ia), mb = conv_mat(a, ib);
    tr_load(ma, ia, lane, r.a); tr_load(mb, ib, lane, r.b);
}
DI void pair_store(const Args& a, int it, int hi, int lane, const PairRegs& r, LAS unsigned* scrA, LAS unsigned* scrB) {
    int ia = it, ib = it + 1; const bool hasb = ib < hi; if (!hasb) ib = it;
    const ConvMat ma = conv_mat(a, ia), mb = conv_mat(a, ib);
    if (ma.f8) tr_store_f8(ma, ia, lane, r.a, scrA); else { tr_store(ma, ia, lane, r.a, scrA); if (ma.WT8) tr_store_f8(ma, ia, lane, r.a, scrA); }
    if (hasb) { if (mb.f8) tr_store_f8(mb, ib, lane, r.b, scrB); else { tr_store(mb, ib, lane, r.b, scrB); if (mb.WT8) tr_store_f8(mb, ib, lane, r.b, scrB); } }
}
DI void convert_range(const Args& a, LAS unsigned char* lds_wave  , int lo, int hi, int w, int nw) {
    LAS unsigned* scrA = (LAS unsigned*)lds_wave; LAS unsigned* scrB = scrA + 32 * 34;
    int it = lo + 2 * w; if (it >= hi) return;
    const int lane = opaque_tid() & 63;
    PairRegs p0, p1;
    pair_load(a, it, hi, lane, p0);
    for (;;) {
        int nx = it + 2 * nw; bool more = nx < hi;
        pair_load(a, more ? nx : it, hi, lane, p1); __builtin_amdgcn_sched_barrier(0);
        pair_store(a, it, hi, lane, p0, scrA, scrB);
        if (!more) break;
        it = nx; nx = it + 2 * nw; more = nx < hi;
        pair_load(a, more ? nx : it, hi, lane, p0); __builtin_amdgcn_sched_barrier(0);
        pair_store(a, it, hi, lane, p1, scrA, scrB);
        if (!more) break;
        it = nx;
    }
}
DI unsigned cq_claim_n(unsigned* head, int lane, unsigned n) { unsigned t = 0u; if (lane == 0) t = __hip_atomic_fetch_add(head, n, __ATOMIC_RELAXED, __HIP_MEMORY_SCOPE_AGENT); return t; }
DI unsigned cq_claim(unsigned* head, int lane) { unsigned t = 0u; if (lane == 0) t = __hip_atomic_fetch_add(head, 8u, __ATOMIC_RELAXED, __HIP_MEMORY_SCOPE_AGENT); return t; }
DI void convert_queue(const Args& a, LAS unsigned char* lds_wave, int lo, int hi, unsigned* head) {
    LAS unsigned* scrA = (LAS unsigned*)lds_wave; LAS unsigned* scrB = scrA + 32 * 34;
    const int lane = opaque_tid() & 63;
    int base = lo + __builtin_amdgcn_readfirstlane((int)cq_claim(head, lane));
    if (base >= hi) return;
    unsigned pend = cq_claim(head, lane);
    int q = 0;
#define CQ_ADVANCE(vb, vq, ok) do { ok = true; if (vq < 3 && vb + 2 * (vq + 1) < hi) { vq = vq + 1; } else { vb = lo + __builtin_amdgcn_readfirstlane((int)pend); vq = 0; ok = vb < hi; if (ok) pend = cq_claim(head, lane); } } while (0)
    PairRegs p0, p1;
    pair_load(a, base, hi, lane, p0);
    for (;;) {
        int nb_ = base, nq_ = q; bool ok; CQ_ADVANCE(nb_, nq_, ok);
        pair_load(a, ok ? nb_ + 2 * nq_ : base + 2 * q, hi, lane, p1); __builtin_amdgcn_sched_barrier(0);
        pair_store(a, base + 2 * q, hi, lane, p0, scrA, scrB);
        if (!ok) break;
        base = nb_; q = nq_; CQ_ADVANCE(nb_, nq_, ok);
        pair_load(a, ok ? nb_ + 2 * nq_ : base + 2 * q, hi, lane, p0); __builtin_amdgcn_sched_barrier(0);
        pair_store(a, base + 2 * q, hi, lane, p1, scrA, scrB);
        if (!ok) break;
        base = nb_; q = nq_;
    }
#undef CQ_ADVANCE
}
DI void p0_prologue(Frame& F, const Args& a) {
    const int lane_ = opaque_tid() & 63;
    const int gw = F.vcu * NWAVES + F.wave, NGW = F.G * NWAVES;
    unsigned char* ws = a.ws;
    bf16* SC = (bf16*)(ws + WS_SC);
    for (int m = gw; m < 256; m += NGW) {
        const float* crow_ = m < 2 ? a.in[6] + (size_t)m * DM : a.in[7] + (size_t)(m - 2) * DM;
        unsigned long long* o8 = (unsigned long long*)(SC + (size_t)m * PK) + lane_;
        f32x4 cv_[16];
#pragma unroll
        for (int j = 0; j < 16; ++j) cv_[j] = (m < NCOND) ? ((const GAS f32x4*)crow_)[lane_ + 64 * j] : (f32x4){0.f, 0.f, 0.f, 0.f};
        __builtin_amdgcn_sched_barrier(0);
#pragma unroll
        for (int j = 0; j < 16; ++j) { const f32x4 v = cv_[j];
            __hip_atomic_store(o8 + 64 * j, (m < NCOND) ? ((unsigned long long)cvtpk(silu_f(v.x), silu_f(v.y)) | ((unsigned long long)cvtpk(silu_f(v.z), silu_f(v.w)) << 32)) : 0ull, __ATOMIC_RELAXED, __HIP_MEMORY_SCOPE_AGENT); }
        asm volatile("s_waitcnt vmcnt(0)" ::: "memory");
        if (lane_ == 0) (void)__hip_atomic_fetch_add((unsigned*)(F.ctl + CW_SCRDY), 1u, __ATOMIC_RELAXED, __HIP_MEMORY_SCOPE_AGENT);
    }
    convert_range(a, F.lds + RING_OFF + F.wave * 16384, 0, I_END0, gw, NGW);
}

DI void row_load(const float* xrow, int lane, f32x4 (&v)[16]) {
    const GAS f32x4* xr = (const GAS f32x4*)xrow + lane;
#pragma unroll
    for (int j = 0; j < 16; ++j) v[j] = xr[64 * j];
}
DI void row_load_bf16(const bf16* xrow, int lane, f32x4 (&v)[16]) {
    const GAS unsigned long long* xr = (const GAS unsigned long long*)xrow + lane;
#pragma unroll
    for (int j = 0; j < 16; ++j) { const unsigned long long w = xr[64 * j]; v[j] = (f32x4){bf_lo((unsigned)w), bf_hi((unsigned)w), bf_lo((unsigned)(w >> 32)), bf_hi((unsigned)(w >> 32))}; }
}
DI float row_rstd(const f32x4 (&v)[16]) {
    float s = 0.f;
#pragma unroll
    for (int j = 0; j < 16; ++j) s += (v[j].x * v[j].x + v[j].y * v[j].y) + (v[j].z * v[j].z + v[j].w * v[j].w);
    return 1.0f / sqrtf(wave_sum(s) * (1.0f / DM) + RMS_EPS);
}
DI void row_store_mod_bf16(f32x4 (&v)[16], float rstd, const float* g, const float* shift, const float* scale, bf16* orow, int lane, unsigned char* orow8 = nullptr, float* hs = nullptr, bf16* orowx = nullptr  ) {
    GAS unsigned long long* o8 = (GAS unsigned long long*)orow + lane; GAS unsigned* o4 = (GAS unsigned*)orow8 + lane;
    const bool i8 = orow8 != nullptr; float mx = 0.f;
#pragma unroll
    for (int j0 = 0; j0 < 16; j0 += 4) {
        f32x4 gg[4], sc[4], sh[4];
#pragma unroll
        for (int j = 0; j < 4; ++j) { gg[j] = ((const GAS f32x4*)g)[lane + 64 * (j0 + j)]; sc[j] = ((const GAS f32x4*)scale)[lane + 64 * (j0 + j)]; sh[j] = ((const GAS f32x4*)shift)[lane + 64 * (j0 + j)]; }
        __builtin_amdgcn_sched_barrier(0);
#pragma unroll
        for (int j = 0; j < 4; ++j) { const f32x4 o = (v[j0 + j] * rstd) * gg[j] * (sc[j] + 1.0f) + sh[j]; v[j0 + j] = o;
            mx = fmaxf(fmaxf(mx, fmaxf(fabsf(o.x), fabsf(o.y))), fmaxf(fabsf(o.z), fabsf(o.w))); }
        __builtin_amdgcn_sched_barrier(0);
    }
    if (i8) {
#pragma unroll
        for (int d = 32; d >= 1; d >>= 1) mx = fmaxf(mx, __shfl_xor(mx, d));
        const float inv = mx > 0.f ? 127.0f / mx : 0.f;
        if (lane == 0) *hs = mx * (1.0f / 127.0f);
#pragma unroll
        for (int j = 0; j < 16; ++j) o4[64 * j] = pack_i8x4(v[j].x * inv, v[j].y * inv, v[j].z * inv, v[j].w * inv);
        if (orowx) { GAS unsigned long long* ox = (GAS unsigned long long*)orowx + lane;
#pragma unroll
            for (int j = 0; j < 16; ++j) ox[64 * j] = (unsigned long long)cvtpk(v[j].x, v[j].y) | ((unsigned long long)cvtpk(v[j].z, v[j].w) << 32); }
    } else {
#pragma unroll
        for (int j = 0; j < 16; ++j) o8[64 * j] = (unsigned long long)cvtpk(v[j].x, v[j].y) | ((unsigned long long)cvtpk(v[j].z, v[j].w) << 32);
    }
}
DI int cond_of_row(int row) { return row < NTOKP ? (row >> 12) : 2 + ((row - NTOKP) >> 3); }
template <int SRC, int SLOT> DI void norm_mod_phase(const Args& a, const bf16* X1, const float* MOD, const float* g, bf16* H, int gw, int NGW, int lane, unsigned char* H8 = nullptr  , float* HS = nullptr  , bf16* HST = nullptr) {
    auto ldrow = [&](int m, f32x4 (&v)[16]) { if (SRC == 1) row_load_bf16(X1 + (size_t)m * DM, lane, v); else row_load(m < NTOKP ? a.in[0] + (size_t)m * DM : a.in[1] + (size_t)(m - NTOKP) * DM, lane, v); };
    f32x4 cur[16], nxt[16];
    int m = gw; if (m >= MTOT) return;
    ldrow(m, cur);
    for (;;) {
        const int mn = m + NGW; const bool more = mn < MTOT;
        ldrow(more ? mn : m, nxt);
        const float rstd = row_rstd(cur);
        const float* mod = MOD + (size_t)cond_of_row(m) * NMOD;
        { const int pm_ = m >> 8; const bool q8_ = H8 && (SRC == 1 ? (pm_ != 15 && pm_ != 31) : i8_panel(pm_));
          bf16* ox_ = (SRC == 1 && HST && m >= NTOKP && ((m & 7) >= 6)) ? HST + (size_t)(2 * ((m - NTOKP) >> 3) + ((m & 7) - 6)) * PK : nullptr;
          row_store_mod_bf16(cur, rstd, g, mod + SLOT * DM, mod + (SLOT + 1) * DM, H + (size_t)m * PK, lane, q8_ ? H8 + (size_t)m * PKB : nullptr, HS ? HS + m : nullptr, ox_); }
        if (!more) break;
#pragma unroll
        for (int j = 0; j < 16; ++j) cur[j] = nxt[j];
        m = mn;
    }
}
DI void final_norm_phase(const bf16* X2, float* Y, const float* g, int gw, int NGW, int lane) {
    f32x4 cur[16], nxt[16];
    int m = gw; if (m >= MTOT) return;
    row_load_bf16(X2 + (size_t)m * DM, lane, cur);
    for (;;) {
        const int mn = m + NGW; const bool more = mn < MTOT;
        row_load_bf16(X2 + (size_t)(more ? mn : m) * DM, lane, nxt);
        const float rstd = row_rstd(cur);
        GAS f32x4* xr = (GAS f32x4*)(Y + (size_t)m * DM) + lane;
#pragma unroll
        for (int j0 = 0; j0 < 16; j0 += 8) {
            f32x4 gg[8];
#pragma unroll
            for (int j = 0; j < 8; ++j) gg[j] = ((const GAS f32x4*)g)[lane + 64 * (j0 + j)];
            __builtin_amdgcn_sched_barrier(0);
#pragma unroll
            for (int j = 0; j < 8; ++j) xr[64 * (j0 + j)] = (cur[j0 + j] * rstd) * gg[j];
            __builtin_amdgcn_sched_barrier(0);
        }
        if (!more) break;
#pragma unroll
        for (int j = 0; j < 16; ++j) cur[j] = nxt[j];
        m = mn;
    }
}

namespace att {
constexpr int KROW = 72, VROW = 260;
constexpr int VT_OFF = 256 * KROW * 2;
constexpr float C2 = 0.125f * LOG2E;
DI int crow(int i, int h) { return (i & 3) + 8 * (i >> 2) + 4 * h; }
#define ATT_MFMA(a, b, c) __builtin_amdgcn_mfma_f32_32x32x16_bf16((a), (b), (c), 0, 0, 0)
template <bool GENERIC> DI float softmax5(f32x16 (&sc)[5], int kb0, int jmin, int jmax, float sink2, int h, bf16x8 (&pf)[5][2]) {
    float mx = -INFINITY;
#pragma unroll
    for (int b = 0; b < 5; ++b)
#pragma unroll
        for (int i = 0; i < 16; ++i) { const int j = 32 * (kb0 + b) + crow(i, h);
            if (GENERIC) { if (!(j >= jmin && j <= jmax)) sc[b][i] = -INFINITY; }
            else { if (b == 0) { if (j < jmin) sc[b][i] = -INFINITY; } if (b == 4) { if (j > jmax) sc[b][i] = -INFINITY; } }
            mx = fmaxf(mx, sc[b][i]); }
    mx = fmaxf(mx, __shfl_xor(mx, 32));
    const float m2 = fmaxf(mx * C2, sink2);
    float sum = 0.f;
#pragma unroll
    for (int b = 0; b < 5; ++b)
#pragma unroll
        for (int i = 0; i < 16; ++i) { const float p = __builtin_amdgcn_exp2f(__builtin_fmaf(sc[b][i], C2, -m2)); sc[b][i] = p; sum += p; }
    sum += __shfl_xor(sum, 32); sum += __builtin_amdgcn_exp2f(sink2 - m2);
#pragma unroll
    for (int b = 0; b < 5; ++b)
#pragma unroll
        for (int s = 0; s < 2; ++s) { v4u w; w.x = cvtpk(sc[b][8 * s], sc[b][8 * s + 1]); w.y = cvtpk(sc[b][8 * s + 2], sc[b][8 * s + 3]);
            w.z = cvtpk(sc[b][8 * s + 4], sc[b][8 * s + 5]); w.w = cvtpk(sc[b][8 * s + 6], sc[b][8 * s + 7]); pf[b][s] = __builtin_bit_cast(bf16x8, w); }
    return 1.0f / sum;
}
DI void store_o(const f32x16& o, unsigned char* orow, int dblk, int h) {
    constexpr float S_ = pg8::ATT_PRESCALE;
#pragma unroll
    for (int g = 0; g < 4; ++g) *(GAS unsigned*)(orow + 32 * dblk + 8 * g + 4 * h) = pack_fp8x4(o[4 * g] * S_, o[4 * g + 1] * S_, o[4 * g + 2] * S_, o[4 * g + 3] * S_);
}
DI void q_load(const bf16* qp, int h, bf16x8 (&qf)[4]) {
#pragma unroll
    for (int d0 = 0; d0 < 4; ++d0) qf[d0] = *(const GAS bf16x8*)(qp + 16 * d0 + 8 * h);
}
template <int VR, bool GENERIC> DI void lds_chunk(const LAS bf16* Kl, const LAS bf16* Vt, int kb0, int jmin, int jmax, float sink2, const bf16x8 (&qf)[4], unsigned char* op, int r, int h) {
    const f32x16 zero = {};
    f32x16 sc[5];
#pragma unroll
    for (int b = 0; b < 5; ++b) {
        const LAS bf16* kp = Kl + ((kb0 + b) * 32 + r) * KROW + 8 * h;
#pragma unroll
        for (int d0 = 0; d0 < 4; ++d0) { const bf16x8 a = *(const LAS bf16x8*)(kp + 16 * d0); sc[b] = ATT_MFMA(a, qf[d0], d0 == 0 ? zero : sc[b]); }
    }
    bf16x8 pf[5][2];
    const float inv = softmax5<GENERIC>(sc, kb0, jmin, jmax, sink2, h, pf);
#pragma unroll
    for (int dblk = 0; dblk < 2; ++dblk) {
        f32x16 o = zero;
#pragma unroll
        for (int b = 0; b < 5; ++b)
#pragma unroll
            for (int s = 0; s < 2; ++s) {
                const LAS bf16* vp = Vt + (dblk * 32 + r) * VR + (kb0 + b) * 32 + 16 * s + 4 * h;
                const s16x4 lo = *(const LAS s16x4*)vp, hi = *(const LAS s16x4*)(vp + 8);
                const bf16x8 a = __builtin_shufflevector(lo, hi, 0, 1, 2, 3, 4, 5, 6, 7);
                o = ATT_MFMA(a, pf[b][s], o);
            }
        o = o * inv;
        store_o(o, op, dblk, h);
    }
}
DI void vt_scatter(LAS bf16* vd, int VR, const v4u vvv) {
    vd[0 * VR] = (bf16)(vvv.x & 0xffffu); vd[1 * VR] = (bf16)(vvv.x >> 16); vd[2 * VR] = (bf16)(vvv.y & 0xffffu); vd[3 * VR] = (bf16)(vvv.y >> 16);
    vd[4 * VR] = (bf16)(vvv.z & 0xffffu); vd[5 * VR] = (bf16)(vvv.z >> 16); vd[6 * VR] = (bf16)(vvv.w & 0xffffu); vd[7 * VR] = (bf16)(vvv.w >> 16);
}
DI void prompt_unit(LAS unsigned char* lds, const bf16* PROJ, unsigned char* MIX, const float* sinks, int n, int blk, int kv, int tid) {
    const int lane = tid & 63, w = __builtin_amdgcn_readfirstlane(tid >> 6), r = lane & 31, h = lane >> 5;
    LAS bf16* Kl = (LAS bf16*)lds; LAS bf16* Vt = (LAS bf16*)(lds + VT_OFF);
    v4u kst[4], vst[4];
#pragma unroll
    for (int i = 0; i < 4; ++i) {
        const int c = tid + 512 * i, key = c >> 3, ch = c & 7, kpos = blk * 128 - 128 + key;
        const bf16* src = PROJ + (size_t)(n * SEQ + (kpos < 0 ? 0 : kpos)) * NPR + kv * 64 + ch * 8; kst[i] = *(const GAS v4u*)(src + COL_K); vst[i] = *(const GAS v4u*)(src + COL_V);
    }
    __builtin_amdgcn_sched_barrier(0);
#pragma unroll
    for (int i = 0; i < 4; ++i) {
        const int c = tid + 512 * i, key = c >> 3, ch = c & 7, kpos = blk * 128 - 128 + key;
        const v4u z = (v4u){0u, 0u, 0u, 0u};
        *(LAS v4u*)(Kl + key * KROW + ch * 8) = kpos < 0 ? z : kst[i];
        vt_scatter(Vt + (ch * 8) * VROW + key, VROW, kpos < 0 ? z : vst[i]);
    }
    const int hq = kv * 8 + w; const float sink2 = sinks[hq] * LOG2E;
    const bf16* qbase = PROJ + (size_t)(n * SEQ + blk * 128 + r) * NPR + hq * 64;
    unsigned char* obase = MIX + (size_t)(n * SEQ + blk * 128 + r) * (2 * PK) + hq * 64;
    bf16x8 qc[4], qn[4];
    q_load(qbase, h, qn);
    __syncthreads();
#pragma unroll 1
    for (int c = 0; c < 4; ++c) {
#pragma unroll
        for (int d0 = 0; d0 < 4; ++d0) qc[d0] = qn[d0];
        q_load(qbase + (size_t)(32 * ((c + 1) & 3)) * NPR, h, qn);
        const int qi = 32 * c + r;
        if (blk == 0) lds_chunk<VROW, true>(Kl, Vt, c, 128, qi + 128, sink2, qc, obase + (size_t)(32 * c) * (2 * PK), r, h);
        else lds_chunk<VROW, false>(Kl, Vt, c, qi, qi + 128, sink2, qc, obase + (size_t)(32 * c) * (2 * PK), r, h);
    }
    __syncthreads();
}
constexpr int KS_BYTES = 160 * KROW * 2, VROW_S = 172, VS_OFF = 2 * KS_BYTES, VS_BYTES = 64 * VROW_S * 2;
DI void sample_unit(LAS unsigned char* lds, const bf16* PROJ, const float* ck, const float* cv, unsigned char* MIX, const float* sinks, int s, int kp, int tid) {
    const int lane = tid & 63, w = __builtin_amdgcn_readfirstlane(tid >> 6), r = lane & 31, h = lane >> 5;
    f32x4 kf[5][2], vf[5][2]; v4u kb_[5], vb_[5];
#pragma unroll
    for (int i = 0; i < 5; ++i) {
        const int c = tid + 512 * i, kvl = c / 1280, rem = c - kvl * 1280, key = rem >> 3, ch = rem & 7, kv = kp * 2 + kvl;
        const size_t o = ((size_t)(s * 128 + (key < 128 ? key : 127)) * 4 + kv) * 64 + ch * 8;
        kf[i][0] = *(const GAS f32x4*)(ck + o); kf[i][1] = *(const GAS f32x4*)(ck + o + 4); vf[i][0] = *(const GAS f32x4*)(cv + o); vf[i][1] = *(const GAS f32x4*)(cv + o + 4);
        if (i == 2 || i == 4) { const int nk = (key >= 128 && key < 136) ? key - 128 : 0;     const bf16* src = PROJ + (size_t)(NTOKP + s * 8 + nk) * NPR + kv * 64 + ch * 8; kb_[i] = *(const GAS v4u*)(src + COL_K); vb_[i] = *(const GAS v4u*)(src + COL_V); }
    }
    __builtin_amdgcn_sched_barrier(0);
#pragma unroll
    for (int i = 0; i < 5; ++i) {
        const int c = tid + 512 * i, kvl = c / 1280, rem = c - kvl * 1280, key = rem >> 3, ch = rem & 7;
        v4u kvv = (v4u){cvtpk(kf[i][0].x, kf[i][0].y), cvtpk(kf[i][0].z, kf[i][0].w), cvtpk(kf[i][1].x, kf[i][1].y), cvtpk(kf[i][1].z, kf[i][1].w)};
        v4u vvv = (v4u){cvtpk(vf[i][0].x, vf[i][0].y), cvtpk(vf[i][0].z, vf[i][0].w), cvtpk(vf[i][1].x, vf[i][1].y), cvtpk(vf[i][1].z, vf[i][1].w)};
        if (i == 2 || i == 4) { const v4u z = (v4u){0u, 0u, 0u, 0u}; kvv = key < 128 ? kvv : (key < 136 ? kb_[i] : z); vvv = key < 128 ? vvv : (key < 136 ? vb_[i] : z); }
        *(LAS v4u*)((LAS bf16*)(lds + kvl * KS_BYTES) + key * KROW + ch * 8) = kvv;
        vt_scatter((LAS bf16*)(lds + VS_OFF + kvl * VS_BYTES) + (ch * 8) * VROW_S + key, VROW_S, vvv);
    }
    const int kvl_ = (w >> 1) & 1, c_ = w & 1, kv_ = kp * 2 + kvl_, rho_ = 32 * c_ + r, g_ = rho_ >> 3, t_ = rho_ & 7, hq_ = kv_ * 8 + g_;
    const size_t qrow_ = (size_t)(NTOKP + s * 8 + t_);
    bf16x8 qf[4]; q_load(PROJ + qrow_ * NPR + hq_ * 64, h, qf);
    const float sink2_ = sinks[hq_] * LOG2E;
    __syncthreads();
    if (w < 4) lds_chunk<VROW_S, false>((const LAS bf16*)(lds + kvl_ * KS_BYTES), (const LAS bf16*)(lds + VS_OFF + kvl_ * VS_BYTES), 0, t_, 128 + t_, sink2_, qf, MIX + qrow_ * (2 * PK) + hq_ * 64, r, h);
    __syncthreads();
}
}

DI void convfix_item(const Args& a, const float* SB2, bf16* MIX, int ti, int cg, int lane) {
    const int pm = 1 + ti + (ti >= 15 ? 1 : 0), ch = cg * 512 + lane * 8;
    const float* cw = a.in[13];
    const float* cur = SB2 + (size_t)pm * 6 * DCONV + ch; const float* prv = SB2 + (size_t)(pm - 1) * 6 * DCONV + ch;
    float o0[8], o1[8];
#pragma unroll
    for (int e = 0; e < 8; ++e) {
        const float w0 = cw[ch + e], w1 = cw[DCONV + ch + e], w2 = cw[2 * DCONV + ch + e];
        const float um2 = prv[4 * DCONV + e], um1 = prv[5 * DCONV + e], u0 = cur[e], u1 = cur[DCONV + e], b0 = cur[2 * DCONV + e], b1 = cur[3 * DCONV + e];
        o0[e] = b0 * (w0 * um2 + w1 * um1 + w2 * u0); o1[e] = b1 * (w0 * um1 + w1 * u0 + w2 * u1);
    }
    *(GAS v4u*)(MIX + (size_t)(pm * 256) * PK + DCONV + ch) = pack8(o0);
    *(GAS v4u*)(MIX + (size_t)(pm * 256 + 1) * PK + DCONV + ch) = pack8(o1);
}
DI void kvcopy_queue(const Args& a, unsigned* head) {
    const int lane = opaque_tid() & 63;
    for (;;) {
        const int base = __builtin_amdgcn_readfirstlane((int)cq_claim_n(head, lane, 32u));
        if (base >= 30720) break;
#pragma unroll 1
        for (int q0 = 0; q0 < 32; q0 += 8) {
            f32x4 v[8]; float* dst[8];
#pragma unroll
            for (int q = 0; q < 8; ++q) { const int r = base + q0 + q, tsr = r / 15360, rr = r - tsr * 15360, s_ = rr / 120, i = rr - s_ * 120;
                v[q] = ((const GAS f32x4*)((tsr ? a.in[3] : a.in[2]) + (size_t)(s_ * 128 + i + 8) * 256))[lane];
                dst[q] = a.out + (tsr ? O_VS : O_KS) + (size_t)(s_ * 128 + i) * 256; }
            __builtin_amdgcn_sched_barrier(0);
#pragma unroll
            for (int q = 0; q < 8; ++q) ((GAS f32x4*)dst[q])[lane] = v[q];
        }
    }
}
DI void kvstate_item4(const Args& a, const bf16* PROJ, int it, int lane) {
    unsigned long long vb_[4]; float* dst[4];
#pragma unroll
    for (int q = 0; q < 4; ++q) {
        const bf16* sb_;
        if (it < 128) { const int tsr = it >> 6, n = (it >> 5) & 1, i = 4 * (it & 31) + q;
            sb_ = PROJ + (size_t)(n * SEQ + SEQ - 128 + i) * NPR + (tsr ? COL_V : COL_K); dst[q] = a.out + (tsr ? O_VP : O_KP) + (size_t)(n * 128 + i) * 256; }
        else { const int j = it - 128, tsr = j >> 8, s_ = (j >> 1) & 127, i = 4 * (j & 1) + q;
            sb_ = PROJ + (size_t)(NTOKP + s_ * 8 + i) * NPR + (tsr ? COL_V : COL_K); dst[q] = a.out + (tsr ? O_VS : O_KS) + (size_t)(s_ * 128 + 120 + i) * 256; }
        vb_[q] = ((const GAS unsigned long long*)sb_)[lane];
    }
    __builtin_amdgcn_sched_barrier(0);
#pragma unroll
    for (int q = 0; q < 4; ++q) { const unsigned long long w = vb_[q];
        ((GAS f32x4*)dst[q])[lane] = (f32x4){bf_lo((unsigned)w), bf_hi((unsigned)w), bf_lo((unsigned)(w >> 32)), bf_hi((unsigned)(w >> 32))}; }
}
DI void fixup_item(const Args& a, const float* SB, unsigned char* ACT, int ti, int cg, int lane) {
    const int pm = 1 + ti + (ti >= 15 ? 1 : 0), ch = cg * 512 + lane * 8;
    if (ch >= DFF) return;
    const float* cw = a.in[17];
    const float* cur = SB + (size_t)pm * 6 * DFF + ch; const float* prv = SB + (size_t)(pm - 1) * 6 * DFF + ch;
    float o0[8], o1[8];
#pragma unroll
    for (int e = 0; e < 8; ++e) {
        const float w0 = cw[ch + e], w1 = cw[DFF + ch + e], w2 = cw[2 * DFF + ch + e];
        const float gm2 = prv[4 * DFF + e], gm1 = prv[5 * DFF + e], g0 = cur[e], g1 = cur[DFF + e], u0 = cur[2 * DFF + e], u1 = cur[3 * DFF + e];
        o0[e] = silu_f(w0 * gm2 + w1 * gm1 + w2 * g0) * u0; o1[e] = silu_f(w0 * gm1 + w1 * g0 + w2 * g1) * u1;
    }
    constexpr float S_ = pg8::ACT_PRESCALE; typedef unsigned u32x2_ __attribute__((ext_vector_type(2)));
    *(GAS u32x2_*)(ACT + (size_t)(pm * 256) * PFB + ch) = (u32x2_){pack_fp8x4(o0[0] * S_, o0[1] * S_, o0[2] * S_, o0[3] * S_), pack_fp8x4(o0[4] * S_, o0[5] * S_, o0[6] * S_, o0[7] * S_)};
    *(GAS u32x2_*)(ACT + (size_t)(pm * 256 + 1) * PFB + ch) = (u32x2_){pack_fp8x4(o1[0] * S_, o1[1] * S_, o1[2] * S_, o1[3] * S_), pack_fp8x4(o1[4] * S_, o1[5] * S_, o1[6] * S_, o1[7] * S_)};
}
typedef float f32x2v __attribute__((ext_vector_type(2)));
constexpr int MODA_ROW = 144  , MODA_SLOT = 144 * MODA_ROW;
template <bool ACTIVE> DI void mod_phase_wave(const Args& a, const bf16* SC, float* MOD, LAS unsigned char* lds, int nb, int tid, unsigned* rdy  ) {
    const int lane = tid & 63, c = lane & 15, kq = lane >> 4;
    constexpr int NAP = ACTIVE ? 1 : 4;
    unsigned asrc[NAP], adst[NAP];
#pragma unroll
    for (int i = 0; i < NAP; ++i) { int p_ = (tid - 192) + 320 * i; p_ = p_ < 0 ? 0 : (p_ > 1151 ? 1151 : p_); asrc[i] = (unsigned)((p_ >> 3) * PK + (p_ & 7) * 8) * 2u; adst[i] = (unsigned)((p_ >> 3) * MODA_ROW + (p_ & 7) * 16); }
    const GAS char* scb = (const GAS char*)SC;
    const int n0 = nb * 32;
    const GAS char* wb = (const GAS char*)(a.in[8] + n0);
    const unsigned woff = (unsigned)((8 * kq) * NMOD + 2 * c) * 4u;
    const unsigned aoff = (unsigned)(c * MODA_ROW + 16 * kq);
    f32x4 acc[9][2];
#pragma unroll
    for (int mb = 0; mb < 9; ++mb) { acc[mb][0] = (f32x4){0.f, 0.f, 0.f, 0.f}; acc[mb][1] = (f32x4){0.f, 0.f, 0.f, 0.f}; }
    v4u ap[3][NAP]; f32x2v br[3][2][8];
#define MOD_ISSUE(slot, q) do { if (!ACTIVE) { _Pragma("unroll") for (int i = 0; i < NAP; ++i) ap[slot][i] = *(const GAS v4u*)(scb + (size_t)(q) * 128 + asrc[i]); } \
        if (ACTIVE) { _Pragma("unroll") for (int ks = 0; ks < 2; ++ks) { const GAS char* p_ = wb + (size_t)((q) * 2 + ks) * 32 * NMOD * 4; \
            _Pragma("unroll") for (int j = 0; j < 8; ++j) br[slot][ks][j] = __builtin_nontemporal_load((const GAS f32x2v*)(p_ + (size_t)j * NMOD * 4 + woff)); } } \
        __builtin_amdgcn_sched_barrier(0); } while (0)
#define MOD_CHUNK(u, q) do { \
        LAS unsigned char* slot = lds + ((q) & 3) * MODA_SLOT; \
        if (!ACTIVE) { _Pragma("unroll") for (int i = 0; i < NAP; ++i) *(LAS v4u*)(slot + adst[i]) = ap[u][i]; } \
        asm volatile("s_waitcnt lgkmcnt(0)" ::: "memory"); __builtin_amdgcn_s_barrier(); asm volatile("" ::: "memory"); \
        if (ACTIVE) { _Pragma("unroll") for (int ks = 0; ks < 2; ++ks) { \
            v4u w0, w1; \
            w0.x = cvtpk(br[u][ks][0].x, br[u][ks][1].x); w0.y = cvtpk(br[u][ks][2].x, br[u][ks][3].x); w0.z = cvtpk(br[u][ks][4].x, br[u][ks][5].x); w0.w = cvtpk(br[u][ks][6].x, br[u][ks][7].x); \
            w1.x = cvtpk(br[u][ks][0].y, br[u][ks][1].y); w1.y = cvtpk(br[u][ks][2].y, br[u][ks][3].y); w1.z = cvtpk(br[u][ks][4].y, br[u][ks][5].y); w1.w = cvtpk(br[u][ks][6].y, br[u][ks][7].y); \
            const bf16x8 b0 = __builtin_bit_cast(bf16x8, w0), b1 = __builtin_bit_cast(bf16x8, w1); \
            _Pragma("unroll") for (int mb = 0; mb < 9; ++mb) { const bf16x8 af = *(const LAS bf16x8*)(slot + mb * 16 * MODA_ROW + ks * 64 + aoff); \
                acc[mb][0] = __builtin_amdgcn_mfma_f32_16x16x32_bf16(af, b0, acc[mb][0], 0, 0, 0); acc[mb][1] = __builtin_amdgcn_mfma_f32_16x16x32_bf16(af, b1, acc[mb][1], 0, 0, 0); } } } \
        __builtin_amdgcn_sched_barrier(0); \
        { const int qn_ = ((q) + 3 < 64) ? (q) + 3 : 63; MOD_ISSUE(u, qn_); } } while (0)
    MOD_ISSUE(0, 0); MOD_ISSUE(1, 1); MOD_ISSUE(2, 2);
    for (int q0 = 0; q0 < 63; q0 += 3) { MOD_CHUNK(0, q0); MOD_CHUNK(1, q0 + 1); MOD_CHUNK(2, q0 + 2); }
    MOD_CHUNK(0, 63);
#undef MOD_CHUNK
#undef MOD_ISSUE
    if (ACTIVE) {
        const f32x2v bias = *(const GAS f32x2v*)(a.in[9] + n0 + 2 * c);
#pragma unroll
        for (int mb = 0; mb < 9; ++mb)
#pragma unroll
            for (int i = 0; i < 4; ++i) { const int row = mb * 16 + 4 * kq + i;
                if (row < NCOND) { const f32x2v o_ = (f32x2v){acc[mb][0][i] + bias.x, acc[mb][1][i] + bias.y};
                    __hip_atomic_store((unsigned long long*)(MOD + (size_t)row * NMOD + n0 + 2 * c), __builtin_bit_cast(unsigned long long, o_), __ATOMIC_RELAXED, __HIP_MEMORY_SCOPE_AGENT); } }
        asm volatile("s_waitcnt vmcnt(0)" ::: "memory");
        if (rdy && lane == 0) (void)__hip_atomic_fetch_add(rdy, 1u, __ATOMIC_RELAXED, __HIP_MEMORY_SCOPE_AGENT);
    }
}

#ifndef MK_PER_PHASE
#define MK_PER_PHASE 0
#endif
constexpr int NPHASE = 11;
__global__ void __launch_bounds__(NWAVES * 64, 2) mega_fwd(Args args) {
    extern __shared__ __attribute__((aligned(16))) unsigned char lds[];
    Frame F;
    F.lds = (LAS unsigned char*)lds;
    F.MISC = (volatile LAS unsigned*)(F.lds + MISC_OFF);
    F.wave = __builtin_amdgcn_readfirstlane((int)threadIdx.x >> 6);
    F.G = gridDim.x; { const int bx = blockIdx.x; F.vcu = (F.G % 8 == 0) ? (bx % 8) * (F.G / 8) + bx / 8 : bx; }
    unsigned char* ws = args.ws;
    F.ctl = (gu32*)(ws + WS_CTL);
    for (int u = (int)threadIdx.x; u < (LDS_BYTES - LDSCTL_OFF) / 4; u += NWAVES * 64) ((LAS unsigned*)(F.lds + LDSCTL_OFF))[u] = 0u;
    __syncthreads();
    if (threadIdx.x == 0) { const unsigned x_ = xb_xcc_id(); F.MISC[16] = x_; F.MISC[17] = xb_add((unsigned*)(F.ctl + CW_XRANK) + 64 * x_, 1u); }
    XcdBarrier bar; bar.bar = (unsigned*)(F.ctl + CW_BAR); bar.x = 0; bar.st = nullptr;
    if (!MK_PER_PHASE) bar = xcd_barrier_post((unsigned*)(F.ctl + CW_BAR), F.MISC + 8);
#define GRID_BAR() do { if (!MK_PER_PHASE) xcd_barrier(bar); } while (0)
    const int lo = args.ph_lo, hi = args.ph_hi;
#ifndef PHASE_MASK
#define PHASE_MASK 0x7ff
#endif
#define IN(k) (((PHASE_MASK >> (k)) & 1) && lo <= (k) && (k) < hi)
#define BOTH(k) (IN(k) && IN((k) + 1))
    const int gw = F.vcu * NWAVES + F.wave, NGW = F.G * NWAVES;
    bf16* const SC = (bf16*)(ws + WS_SC); float* const MOD = (float*)(ws + WS_MOD);
    bf16* const H = (bf16*)(ws + WS_H); bf16* const PROJ = (bf16*)(ws + WS_PROJ); bf16* const MIX = (bf16*)(ws + WS_MIX);
    bf16* const X2 = (bf16*)(ws + WS_H);        bf16* const X1 = (bf16*)(ws + WS_X1);       unsigned char* const ACT = ws + WS_ACT;

    if (IN(0)) { p0_prologue(F, args); }
    if (IN(1)) {
        if (F.wave == 0) {
            unsigned sp_ = 0u; unsigned* tmo_ = (unsigned*)(F.ctl + CW_BAR) + XB_TMO;
            while (xb_ld((unsigned*)(F.ctl + CW_SCRDY)) < 256u) { __builtin_amdgcn_s_sleep(4); if ((++sp_ & 255u) == 0u) { if (xb_ld(tmo_)) break; if (sp_ > XB_SPIN_CAP) { atomicAdd(tmo_, 1u); break; } } }
            __builtin_amdgcn_fence(__ATOMIC_ACQUIRE, "agent"); asm volatile("s_waitcnt vmcnt(0)" ::: "memory");
        }
        __syncthreads();
        for (int nb0 = 3 * F.vcu; nb0 < NMOD / 32; nb0 += 3 * F.G) {
            const int t_ = opaque_tid();
            if (F.wave < 3) mod_phase_wave<true>(args, SC, MOD, F.lds + RING_OFF, (nb0 + F.wave < NMOD / 32) ? nb0 + F.wave : nb0, t_, (nb0 + F.wave < 2 * DM / 32) ? (unsigned*)(F.ctl + CW_MODRDY) : nullptr);
            else mod_phase_wave<false>(args, SC, MOD, F.lds + RING_OFF, 0, t_, nullptr);
            __syncthreads();
        }
    }
    if (IN(2)) {
        if (F.wave == 0) {
            unsigned sp_ = 0u; unsigned* tmo_ = (unsigned*)(F.ctl + CW_BAR) + XB_TMO;
            while (xb_ld((unsigned*)(F.ctl + CW_MODRDY)) < 256u) { __builtin_amdgcn_s_sleep(4); if ((++sp_ & 255u) == 0u) { if (xb_ld(tmo_)) break; if (sp_ > XB_SPIN_CAP) { atomicAdd(tmo_, 1u); break; } } }
            __builtin_amdgcn_fence(__ATOMIC_ACQUIRE, "agent"); asm volatile("s_waitcnt vmcnt(0)" ::: "memory");
        }
        __syncthreads();
        const int l_ = opaque_tid() & 63;
        norm_mod_phase<0, 0>(args, X1, MOD, args.in[10], H, gw, NGW, l_, ws + WS_H8, (float*)(ws + WS_HS));
        if (BOTH(2)) GRID_BAR();
    }
    int cid = (int)blockIdx.x;
    if (!MK_PER_PHASE && lo == 0 && (F.G & 7) == 0) {
        bool even = true;
        for (int j = 0; j < 8; ++j) even = even && (xb_ld((unsigned*)(F.ctl + CW_XRANK) + 64 * j) == (unsigned)(F.G >> 3));
        const int x_ = __builtin_amdgcn_readfirstlane((int)F.MISC[16]), r_ = __builtin_amdgcn_readfirstlane((int)F.MISC[17]);
        if (even && x_ < 8 && r_ < (F.G >> 3)) cid = r_ * 8 + x_;
    }
    float* const SB2 = (float*)(ws + WS_GU + 16 * MiB);
    if (IN(3)) {
        { pg8::Gemm g{(const bf16*)(ws + WS_H8), (const bf16*)(ws + WS_WIN8), 30 * 256, NIN, DM / 2, PKB / 2}; pg8::StaticOrder S; S.init(30 * 256, NIN, DM / 2, F.G, cid); S.pmode = 2;
          pg8::EpiInProjT<true> E{PROJ, NPR, MIX, PK, args.in[13], args.in[4], SB2, args.out + O_CP, args.out + O_CS, (LAS float*)(F.lds + HALO_OFF), 1.0f / pg8::WGU_I8SCALE, (const float*)(ws + WS_HS)};
          pg8::gemm_phase<pg8::EpiInProjT<true>, pg8::StaticOrder, true, true, 2>(F.lds + RING_OFF, g, S, E); }
        __syncthreads();
        { pg8::Gemm g{H, (const bf16*)(ws + WS_WIN), 6 * 256, NIN, DM, PK}; pg8::StaticOrder S; S.init(6 * 256, NIN, DM, F.G, cid); S.pmode = 1;
          pg8::EpiInProj E{PROJ, NPR, MIX, PK, args.in[13], args.in[4], SB2, args.out + O_CP, args.out + O_CS, (LAS float*)(F.lds + HALO_OFF)};
          pg8::gemm_phase<pg8::EpiInProj, pg8::StaticOrder, true, true, 0>(F.lds + RING_OFF, g, S, E); }
        convert_queue(args, F.lds + RING_OFF + F.wave * 16384, I_END0, I_END1, (unsigned*)(F.ctl + CW_CONVQ + 128));
        kvcopy_queue(args, (unsigned*)(F.ctl + CW_CONVQ + 256));
        if (BOTH(3)) GRID_BAR();
    }
    if (IN(4)) {
        const int first_ = ((int)blockIdx.x >> 3) & 1;
#pragma unroll 1
        for (int pass = 0; pass < 2; ++pass) {
            if ((pass ^ first_) == 0) {
                for (int u = (int)blockIdx.x; u < 256; u += F.G) { const int t_ = opaque_tid(); att::prompt_unit(F.lds + RING_OFF, PROJ, ws + WS_MIX8A, args.in[14], u >> 7, (u >> 2) & 31, u & 3, t_); }
                for (int u = (int)blockIdx.x; u < 256; u += F.G) { const int t_ = opaque_tid(); att::sample_unit(F.lds + RING_OFF, PROJ, args.in[2], args.in[3], ws + WS_MIX8A, args.in[14], u >> 1, u & 1, t_); }
            } else {
                for (int it = gw; it < 30 * 4; it += NGW) { const int l_ = opaque_tid() & 63; convfix_item(args, SB2, MIX, it >> 2, it & 3, l_); }
                for (int it = gw; it < 640; it += NGW) { const int l_ = opaque_tid() & 63; kvstate_item4(args, PROJ, it, l_); }
            }
        }
        if (BOTH(4)) GRID_BAR();
    }
    if (IN(5)) {
        const int Gg = (F.G & 31) ? F.G : F.G - (F.G >> 2);
        if (cid < Gg) {
            pg8::Gemm g{MIX, (const bf16*)(ws + WS_WOUT), MTOT, DM, DM, PK, 0, 0, (const bf16*)(ws + WS_MIX8A), (const bf16*)(ws + WS_WOUT8A), 1.0f / (pg8::ATT_PRESCALE * pg8::WOUT_PRESCALE)}; pg8::PairOrder S; S.init(MTOT, DM, DM, Gg, cid);
            pg8::EpiResGate<false, true> E{args.in[0], args.in[1], X1, MOD + 2 * DM};
            pg8::gemm_phase<pg8::EpiResGate<false, true>, pg8::PairOrder, true, true, 3>(F.lds + RING_OFF, g, S, E);
        }
        convert_queue(args, F.lds + RING_OFF + F.wave * 16384, I_END1, I_END2 + I_DN_P5, (unsigned*)(F.ctl + CW_CONVQ));
        if (BOTH(5)) GRID_BAR();
    }
    if (IN(6)) {
        const int l_ = opaque_tid() & 63;
        norm_mod_phase<1, 3>(args, X1, MOD, args.in[11], H, gw, NGW, l_, ws + WS_H8, (float*)(ws + WS_HS), (bf16*)(ws + WS_HST));
        if (BOTH(6)) GRID_BAR();
    }
    float* const SB = (float*)(ws + WS_GU);
    if (IN(7)) {
        { pg8::Gemm g{(const bf16*)(ws + WS_H8), (const bf16*)(ws + WS_WGU8), 34 * 256, NGU, DM / 2, PKB / 2}; pg8::SplitOrder S; S.init2(34 * 256, NGU, DM / 2, F.G, cid, 8, (float*)(ws + WS_SLAB), (unsigned*)(F.ctl + CW_TICK + 3 * TICK_WORDS)); S.pmode = 3; S.ints = true; S.wgflag = (LAS unsigned*)(F.lds + MISC_OFF + 80);
          pg8::EpiGateUpT<true> E{ACT, PFB, args.in[17], args.in[5], SB, args.out + O_FP, args.out + O_FS, (LAS float*)(F.lds + HALO_OFF), 1.0f / pg8::WGU_I8SCALE, (const float*)(ws + WS_HS)};
          pg8::gemm_phase<pg8::EpiGateUpT<true>, pg8::SplitOrder, true, true, 2>(F.lds + RING_OFF, g, S, E); }
        __syncthreads();
        { pg8::Gemm g{H, (const bf16*)(ws + WS_WGU), 2 * 256, NGU, DM, PK}; pg8::StaticOrder S; S.init(2 * 256, NGU, DM, F.G, cid); S.pmode = 4;
          pg8::EpiGateUp E{ACT, PFB, args.in[17], args.in[5], SB, args.out + O_FP, args.out + O_FS, (LAS float*)(F.lds + HALO_OFF), 1.0f};
          pg8::gemm_phase<pg8::EpiGateUp, pg8::StaticOrder, true, true, 0>(F.lds + RING_OFF, g, S, E); }
        __syncthreads();
        { pg8::Gemm g{(const bf16*)(ws + WS_HST), (const bf16*)(ws + WS_WGU), 256, 43 * 256, DM, PK, (size_t)512 * PK, (size_t)1024 * PK}; pg8::StaticOrder S; S.init(256, 43 * 256, DM, F.G, (cid + F.G - 172) % F.G);
          pg8::EpiGateState E{args.out + O_FS};
          pg8::gemm_phase<pg8::EpiGateState, pg8::StaticOrder, true, true, 0>(F.lds + RING_OFF, g, S, E); }
        convert_queue(args, F.lds + RING_OFF + F.wave * 16384, I_END2 + I_DN_P5, I_END3, (unsigned*)(F.ctl + CW_CONVQ + 192));
        if (BOTH(7)) GRID_BAR();
    }
    if (IN(8)) {
        for (int it = gw; it < 30 * 22; it += NGW) { const int l_ = opaque_tid() & 63; fixup_item(args, SB, ACT, it / 22, it % 22, l_); }
        if (BOTH(8)) GRID_BAR();
    }
    if (IN(9)) {
        pg8::Gemm g{(const bf16*)ACT, (const bf16*)(ws + WS_WDN), MTOT, DM, DFF / 2, PFB / 2}; pg8::SplitOrder S; S.init2(MTOT, DM, DFF / 2, F.G, cid, 4, (float*)(ws + WS_SLAB), (unsigned*)(F.ctl + CW_TICK + 2 * TICK_WORDS));
        pg8::EpiResGate<true, true> E{X1, X1 + (size_t)NTOKP * DM, X2, MOD + 5 * DM, 1.0f / (pg8::ACT_PRESCALE * pg8::WDN_PRESCALE)};
        pg8::gemm_phase<pg8::EpiResGate<true, true>, pg8::SplitOrder, true, true, true>(F.lds + RING_OFF, g, S, E);
        if (BOTH(9)) GRID_BAR();
    }
    if (IN(10)) {
        const int l_ = opaque_tid() & 63;
        final_norm_phase(X2, args.out + O_Y, args.in[19], gw, NGW, l_);
    }
#undef IN
#undef BOTH
#undef GRID_BAR
}

extern "C" void kernel_launch(void* const* d_in, const int* in_sizes, int n_in, void* d_out, int out_size, void* d_ws, size_t ws_size, hipStream_t stream) {
    static int grid = 0;
    if (grid == 0) {
        if (n_in != 20 || in_sizes[0] != NTOKP * DM || (size_t)out_size != O_END || ws_size < WS_END) {
            fprintf(stderr, "kernel_launch: unexpected shapes: n_in %d in0 %d out %d ws %zu (need %zu); nothing launched\n", n_in, n_in > 0 ? in_sizes[0] : -1, out_size, ws_size, (size_t)WS_END); grid = -1; return; }
        int dev = 0, cus = 0, per_cu = 0;
        if (hipGetDevice(&dev) != hipSuccess || hipDeviceGetAttribute(&cus, hipDeviceAttributeMultiprocessorCount, dev) != hipSuccess) { fprintf(stderr, "kernel_launch: device query failed\n"); grid = -1; return; }
        if (hipFuncSetAttribute((const void*)mega_fwd, hipFuncAttributeMaxDynamicSharedMemorySize, LDS_BYTES) != hipSuccess) { fprintf(stderr, "kernel_launch: hipFuncSetAttribute failed\n"); grid = -1; return; }
        if (hipOccupancyMaxActiveBlocksPerMultiprocessor(&per_cu, (const void*)mega_fwd, NWAVES * 64, LDS_BYTES) != hipSuccess || per_cu < 1)
            fprintf(stderr, "kernel_launch: note: occupancy query reports %d workgroups per CU\n", per_cu);
        (void)hipGetLastError();
        grid = cus;
    }
    if (grid < 0) return;
    if (hipMemsetAsync((char*)d_ws + WS_CTL, 0, CTL_ZERO_BYTES, stream) != hipSuccess) { fprintf(stderr, "kernel_launch: memset failed\n"); return; }
    Args a{};
    for (int i = 0; i < 20; ++i) a.in[i] = (const float*)d_in[i];
    a.out = (float*)d_out; a.ws = (unsigned char*)d_ws; a.li = 0; a.pad = 0;
#if MK_PER_PHASE
    for (int p = 0; p < NPHASE; ++p) { a.ph_lo = p; a.ph_hi = p + 1; hipLaunchKernelGGL(mega_fwd, dim3(grid), dim3(NWAVES * 64), LDS_BYTES, stream, a); }
#else
    a.ph_lo = 0; a.ph_hi = NPHASE;
    hipLaunchKernelGGL(mega_fwd, dim3(grid), dim3(NWAVES * 64), LDS_BYTES, stream, a);
#endif
    const hipError_t le = hipPeekAtLastError();
    if (le != hipSuccess) fprintf(stderr, "kernel_launch: launch failed: %s\n", hipGetErrorName(le));
}
```

```cpp
#include <hip/hip_runtime.h>
#include <hip/hip_bf16.h>
#include <cstdio>
#include <cstdint>
#include <cmath>
#define MK_PER_PHASE 0
namespace pg8 {
#define PG8_LAS __attribute__((address_space(3)))
typedef unsigned short bf16_t;
typedef short bf16x8 __attribute__((ext_vector_type(8)));
typedef float f32x4 __attribute__((ext_vector_type(4)));
typedef unsigned u32x4 __attribute__((ext_vector_type(4)));
constexpr int BM = 256, BK = 64, HALF = 128, HTB = HALF * BK * 2  , STAGE_BYTES = 8 * HTB, NXCD = 8, WGM = 8;

__host__ __device__ __forceinline__ int lds_byte(int r, int c) { const int st = (r >> 4) * 2 + (c >> 5), rr = r & 15, cc = c & 31, ob = rr * 64 + cc * 2; return st * 1024 + (ob ^ (((ob >> 9) & 1) << 5)); }
__host__ __device__ __forceinline__ void stage_rc(int b, int& R, int& C) { const int st = b / 1024, sb = b % 1024, swz = sb ^ (((sb >> 9) & 1) << 5); R = (st >> 1) * 16 + swz / 64; C = (st & 1) * 32 + (swz % 64) / 2; }
__host__ __device__ __forceinline__ int perm32(int rho) { const int n = rho >> 4, i = rho & 15; return 8 * (i >> 2) + 4 * n + (i & 3); }

struct Unit { unsigned w0, w1;
    __host__ __device__ __forceinline__ int pm() const { return (int)(w0 & 255u); } __host__ __device__ __forceinline__ int pn() const { return (int)((w0 >> 8) & 255u); }
    __host__ __device__ __forceinline__ int k0() const { return (int)((w0 >> 16) & 255u) * 128; } __host__ __device__ __forceinline__ int nt() const { return (int)(w0 >> 24) * 2; }
    __host__ __device__ __forceinline__ int ns() const { return (int)(w1 & 255u); } __host__ __device__ __forceinline__ int sp() const { return (int)((w1 >> 8) & 255u); } __host__ __device__ __forceinline__ int sid() const { return (int)((w1 >> 16) & 0x7fffu); } __host__ __device__ __forceinline__ bool f8() const { return (w1 >> 31) != 0u; }
    __host__ __device__ __forceinline__ void set(int pm_, int pn_, int k0_, int nt_, int ns_, int sp_, int sid_) { w0 = (unsigned)pm_ | ((unsigned)pn_ << 8) | ((unsigned)(k0_ >> 7) << 16) | ((unsigned)(nt_ >> 1) << 24); w1 = (unsigned)ns_ | ((unsigned)sp_ << 8) | ((unsigned)sid_ << 16); }
};
struct Gemm { const bf16_t* A; const bf16_t* Bt; int M, N, K, ld; size_t bh = 0, bt = 0; const bf16_t* A8 = nullptr; const bf16_t* B8 = nullptr; float seam = 1.0f; };

struct StaticOrder {
    int nM, nN, nwg, G, c, ntK; int pm0 = 0; int pmode = 0;
    __host__ __device__ void init(int M, int N, int K, int G_, int c_) { nM = M / BM; nN = N / BM; nwg = nM * nN; G = G_; c = c_; ntK = K / BK; }
    __host__ __device__ bool next(int i, Unit& u) const { return at((long)i * G + c, u); }
    __host__ __device__ bool at(const long L, Unit& u) const {
        if (L >= nwg) return false;
        int wgid = (int)L; { const int q = nwg / NXCD, r = nwg % NXCD, xcd = wgid % NXCD, off = wgid / NXCD; wgid = (xcd < r ? xcd * (q + 1) : r * (q + 1) + (xcd - r) * q) + off; }
        const int nig = WGM * nN, gid = wgid / nig, fm = gid * WGM, gsz = (nM - fm) < WGM ? (nM - fm) : WGM;
        int pm_ = pm0 + fm + ((wgid % nig) % gsz); if (pmode == 1) pm_ = (pm_ == 0) ? 15 : 30 + pm_; else if (pmode == 2) pm_ = (pm_ < 15) ? pm_ : pm_ + 1;
        else if (pmode == 3) pm_ = (pm_ < 15) ? pm_ : (pm_ < 30 ? pm_ + 1 : pm_ + 2); else if (pmode == 4) pm_ = 15 + 16 * pm_;
        u.set(pm_, (wgid % nig) / gsz, 0, ntK, 1, 0, 0); return true;
    }
    __device__ __forceinline__ void a_ready(const Unit&) const {}
    __device__ __forceinline__ void done(const Unit&) const {}
    __device__ __forceinline__ bool combine(f32x4 (&)[2][2][4][2], const Unit&, int, int) const { return true; }
};
struct PairOrder : StaticOrder {
    int nt8 = 16, k1 = 2048, nt16 = 32;
    __device__ __forceinline__ bool next(int i, Unit& u) const {
        if (!at((long)(i >> 1) * G + c, u)) return false;
        if ((i & 1) == 0) { u.set(u.pm(), u.pn(), 0, nt8, 1, 0, 0); u.w1 |= 0x80000000u; } else u.set(u.pm(), u.pn(), k1, nt16, 1, 0, 0);
        return true;
    }
};
struct SplitOrder : StaticOrder {
    bool ints = false;
    int S, full, rem; float* slab; unsigned* tick; PG8_LAS unsigned* wgflag = nullptr;
    __device__ __forceinline__ void init2(int M, int N, int K, int G_, int c_, int S_, float* slab_, unsigned* tick_) {
        init(M, N, K, G_, c_); full = nwg / G; rem = nwg - full * G; slab = slab_; tick = tick_;
        const int grp = (rem + 7) >> 3; S = S_; if (grp > 0 && grp * S * 8 > G) S = (G >> 3) / grp; if (S < 1 || (G & 7)) S = 1; if (S > (ntK >> 1)) S = ntK >> 1;
    }
    __device__ __forceinline__ bool next(int i, Unit& u) const {
        if (i < full) return at((long)i * G + c, u);
        if (i > full || rem == 0) return false;
        if (S == 1) return at((long)i * G + c, u);
        const int x = c & 7, y = c >> 3, jhi = y / S, s = y - jhi * S, j = jhi * 8 + x;
        if (j >= rem) return false;
        at((long)full * G + j, u);
        const int pairs = ntK >> 1, p = pairs / S, r = pairs - p * S, np = p + (s < r ? 1 : 0), p0 = s * p + (s < r ? s : r);
        u.set(u.pm(), u.pn(), p0 * 2 * BK, np * 2, S, s, j); return true;
    }
    __device__ __forceinline__ bool combine(f32x4 (&acc)[2][2][4][2], const Unit& u, int wid, int lane) const {
        float* mine = slab + ((size_t)(u.sid() * S + u.sp()) * 8 + wid) * 8192;
        const __amdgpu_buffer_rsrc_t rs = __builtin_amdgcn_make_buffer_rsrc(mine, 0, 32768, 0x00020000);
        const unsigned voff = (unsigned)lane * 16u;
#pragma unroll
        for (int ai = 0; ai < 2; ++ai)
#pragma unroll
            for (int bj = 0; bj < 2; ++bj)
#pragma unroll
                for (int m = 0; m < 4; ++m)
#pragma unroll
                    for (int n = 0; n < 2; ++n) __builtin_amdgcn_raw_buffer_store_b128(__builtin_bit_cast(u32x4, acc[ai][bj][m][n]), rs, voff, ((((ai * 2 + bj) * 4 + m) * 2 + n) * 1024),   16);
        asm volatile("s_waitcnt vmcnt(0)" ::: "memory");
        unsigned old = 0u;
        if (wgflag) {
            asm volatile("" ::: "memory"); __builtin_amdgcn_s_barrier(); asm volatile("" ::: "memory");
            if (wid == 0) { if (lane == 0) old = __hip_atomic_fetch_add(tick + (size_t)(u.sid() * 8) * 16, 1u, __ATOMIC_RELAXED, __HIP_MEMORY_SCOPE_AGENT);
                old = (unsigned)__builtin_amdgcn_readfirstlane((int)old); if (lane == 0) *wgflag = old; }
            asm volatile("s_waitcnt vmcnt(0) lgkmcnt(0)" ::: "memory"); __builtin_amdgcn_s_barrier(); asm volatile("" ::: "memory");
            old = (unsigned)__builtin_amdgcn_readfirstlane((int)*wgflag);
        } else {
            if (lane == 0) old = __hip_atomic_fetch_add(tick + (size_t)(u.sid() * 8 + wid) * 16, 1u, __ATOMIC_RELAXED, __HIP_MEMORY_SCOPE_AGENT);
            old = (unsigned)__builtin_amdgcn_readfirstlane((int)old);
        }
        if (old + 1u != (unsigned)S) { __builtin_amdgcn_s_waitcnt(0); return false; }
        __builtin_amdgcn_fence(__ATOMIC_ACQUIRE, "agent"); asm volatile("s_waitcnt vmcnt(0)" ::: "memory");
        for (int s = 0; s < S; ++s) {
            const __amdgpu_buffer_rsrc_t rr = __builtin_amdgcn_make_buffer_rsrc(slab + ((size_t)(u.sid() * S + s) * 8 + wid) * 8192, 0, 32768, 0x00020000);
#pragma unroll
            for (int ai = 0; ai < 2; ++ai) {
                f32x4 t[2][4][2];
#pragma unroll
                for (int bj = 0; bj < 2; ++bj)
#pragma unroll
                    for (int m = 0; m < 4; ++m)
#pragma unroll
                        for (int n = 0; n < 2; ++n) t[bj][m][n] = __builtin_bit_cast(f32x4, __builtin_amdgcn_raw_buffer_load_b128(rr, voff, ((((ai * 2 + bj) * 4 + m) * 2 + n) * 1024), 0));
                __builtin_amdgcn_sched_barrier(0);
#pragma unroll
                for (int bj = 0; bj < 2; ++bj)
#pragma unroll
                    for (int m = 0; m < 4; ++m)
#pragma unroll
                        for (int n = 0; n < 2; ++n) { typedef int i32x4_ __attribute__((ext_vector_type(4)));
                            acc[ai][bj][m][n] = (s == 0) ? t[bj][m][n] : (ints ? __builtin_bit_cast(f32x4, __builtin_bit_cast(i32x4_, acc[ai][bj][m][n]) + __builtin_bit_cast(i32x4_, t[bj][m][n])) : acc[ai][bj][m][n] + t[bj][m][n]); }
                __builtin_amdgcn_sched_barrier(0);
            }
        }
        __builtin_amdgcn_s_waitcnt(0);
        return true;
    }
};

__device__ __forceinline__ unsigned cvt_pk_bf16(float lo, float hi) { unsigned r; asm volatile("v_cvt_pk_bf16_f32 %0, %1, %2" : "=v"(r) : "v"(lo), "v"(hi)); return r; }
typedef float f32x2 __attribute__((ext_vector_type(2)));
__device__ __forceinline__ f32x2 gelu_pk(f32x2 v) {
    const f32x2 av = __builtin_elementwise_abs(v), d = av * 0.2316418882f + 1.0f;
    f32x2 t; t.x = __builtin_amdgcn_rcpf(d.x); t.y = __builtin_amdgcn_rcpf(d.y);
    f32x2 q = t * 0.5307027145f + (-0.7265760135f); q = q * t + 0.7107068705f; q = q * t + (-0.142248368f); q = q * t + 0.127414796f; q = q * t;
    const f32x2 s = (v * v) * (-0.72134752044f);
    f32x2 e; e.x = __builtin_amdgcn_exp2f(s.x); e.y = __builtin_amdgcn_exp2f(s.y);
    const f32x2 m = v * (q * e), r = v - m;
    f32x2 o; o.x = v.x < 0.f ? m.x : r.x; o.y = v.y < 0.f ? m.y : r.y; return o;
}

template <int ACT  > struct EpiBf16 {
    static constexpr bool PERM = true, AFTER_DRAIN = false; static_assert(ACT == 0 || ACT == 1, "EpiBf16: ACT is 0 (none) or 1 (gelu_pk)");
    bf16_t* O; int ldc; const float* bias; int split_cols; size_t split_stride; float scale0;
    __device__ __forceinline__ void operator()(const f32x4 (&acc)[2][2][4][2], const Unit& u, int wr, int wc, int fr, int fq) const {
        const int row0 = u.pm() * BM + wr * 64 + fr; int colt = u.pn() * BM; bf16_t* base = O;
        float sc = 1.f; if (split_cols) { const int t = colt / split_cols; base += (size_t)t * split_stride; colt -= t * split_cols; if (t == 0) sc = scale0; }
        const int col0 = colt + wc * 32 + 8 * fq, bcol0 = u.pn() * BM + wc * 32 + 8 * fq;
        f32x4 bv[2][2];
#pragma unroll
        for (int bj = 0; bj < 2; ++bj)
#pragma unroll
            for (int n = 0; n < 2; ++n) bv[bj][n] = bias ? *(const f32x4*)(bias + bcol0 + bj * HALF + 4 * n) : (f32x4){0.f, 0.f, 0.f, 0.f};
#pragma unroll
        for (int ai = 0; ai < 2; ++ai)
#pragma unroll
            for (int m = 0; m < 4; ++m) { bf16_t* rowp = base + (size_t)(row0 + ai * HALF + m * 16) * ldc + col0;
#pragma unroll
                for (int bj = 0; bj < 2; ++bj) { f32x4 v0 = acc[ai][bj][m][0] + bv[bj][0], v1 = acc[ai][bj][m][1] + bv[bj][1];
                    if (ACT == 1) { f32x2 a = gelu_pk((f32x2){v0[0], v0[1]}), b = gelu_pk((f32x2){v0[2], v0[3]}), c = gelu_pk((f32x2){v1[0], v1[1]}), d = gelu_pk((f32x2){v1[2], v1[3]});
                        v0 = (f32x4){a.x, a.y, b.x, b.y}; v1 = (f32x4){c.x, c.y, d.x, d.y}; }
                    v0 = v0 * sc; v1 = v1 * sc; u32x4 w; w.x = cvt_pk_bf16(v0[0], v0[1]); w.y = cvt_pk_bf16(v0[2], v0[3]); w.z = cvt_pk_bf16(v1[0], v1[1]); w.w = cvt_pk_bf16(v1[2], v1[3]);
                    *(u32x4*)(rowp + bj * HALF) = w; } }
    }
};
struct EpiF32 {
    static constexpr bool PERM = false, AFTER_DRAIN = false;
    float* C; int ldc; const float* bias;
    __device__ __forceinline__ void operator()(const f32x4 (&acc)[2][2][4][2], const Unit& u, int wr, int wc, int fr, int fq) const {
        const int row0 = u.pm() * BM + wr * 64 + fr, col0 = u.pn() * BM + wc * 32 + 4 * fq;
        f32x4 bv[2][2];
#pragma unroll
        for (int bj = 0; bj < 2; ++bj)
#pragma unroll
            for (int n = 0; n < 2; ++n) bv[bj][n] = bias ? *(const f32x4*)(bias + col0 + bj * HALF + n * 16) : (f32x4){0.f, 0.f, 0.f, 0.f};
#pragma unroll
        for (int ai = 0; ai < 2; ++ai)
#pragma unroll
            for (int m = 0; m < 4; ++m) { float* rowp = C + (size_t)(row0 + ai * HALF + m * 16) * ldc + col0;
#pragma unroll
                for (int bj = 0; bj < 2; ++bj)
#pragma unroll
                    for (int n = 0; n < 2; ++n) *(f32x4*)(rowp + bj * HALF + n * 16) = acc[ai][bj][m][n] + bv[bj][n]; }
    }
};
template <bool BASE_BF16, bool OUT_BF16> struct EpiResGate {
    static constexpr bool PERM = false, AFTER_DRAIN = false;
    const void* base_p; const void* base_s; void* out; const float* gate; float accs = 1.0f;
    __device__ __forceinline__ void ldgrp(int gi, const Unit& u, int wr, int fr, int col0, f32x4 (&b)[4], f32x4 (&g)[4]) const {
        const int ai = gi >> 2, m = gi & 3, r = u.pm() * BM + ai * HALF + wr * 64 + m * 16 + fr;
        const int cond = r < 8192 ? (r >> 12) : 2 + ((r - 8192) >> 3);
        const float* gp = gate + (size_t)cond * 24576 + col0;
        if (BASE_BF16) {
            typedef unsigned u32x2 __attribute__((ext_vector_type(2)));
            const bf16_t* bp = (r < 8192 ? (const bf16_t*)base_p + (size_t)r * 4096 : (const bf16_t*)base_s + (size_t)(r - 8192) * 4096) + col0;
#pragma unroll
            for (int q = 0; q < 4; ++q) { const u32x2 w = *(const u32x2*)(bp + (q >> 1) * HALF + (q & 1) * 16);
                b[q] = (f32x4){__uint_as_float(w.x << 16), __uint_as_float(w.x & 0xffff0000u), __uint_as_float(w.y << 16), __uint_as_float(w.y & 0xffff0000u)}; g[q] = *(const f32x4*)(gp + (q >> 1) * HALF + (q & 1) * 16); }
        } else {
            const float* bp = (r < 8192 ? (const float*)base_p + (size_t)r * 4096 : (const float*)base_s + (size_t)(r - 8192) * 4096) + col0;
#pragma unroll
            for (int q = 0; q < 4; ++q) { b[q] = *(const f32x4*)(bp + (q >> 1) * HALF + (q & 1) * 16); g[q] = *(const f32x4*)(gp + (q >> 1) * HALF + (q & 1) * 16); }
        }
        __builtin_amdgcn_sched_barrier(0);
    }
    __device__ __forceinline__ void operator()(const f32x4 (&acc)[2][2][4][2], const Unit& u, int wr, int wc, int fr, int fq) const {
        const int col0 = u.pn() * BM + wc * 32 + 4 * fq;
        f32x4 b[2][4], g[2][4];
        ldgrp(0, u, wr, fr, col0, b[0], g[0]);
#pragma unroll
        for (int gi = 0; gi < 8; ++gi) {
            if (gi + 1 < 8) ldgrp(gi + 1, u, wr, fr, col0, b[(gi + 1) & 1], g[(gi + 1) & 1]);
            const int ai = gi >> 2, m = gi & 3, r = u.pm() * BM + ai * HALF + wr * 64 + m * 16 + fr;
#pragma unroll
            for (int q = 0; q < 4; ++q) { const f32x4 o = b[gi & 1][q] + (g[gi & 1][q] * accs) * acc[ai][q >> 1][m][q & 1];
                if (OUT_BF16) { typedef unsigned u32x2 __attribute__((ext_vector_type(2))); u32x2 w; w.x = cvt_pk_bf16(o[0], o[1]); w.y = cvt_pk_bf16(o[2], o[3]);
                    *(u32x2*)((bf16_t*)out + (size_t)r * 4096 + col0 + (q >> 1) * HALF + (q & 1) * 16) = w; }
                else *(f32x4*)((float*)out + (size_t)r * 4096 + col0 + (q >> 1) * HALF + (q & 1) * 16) = o; }
            __builtin_amdgcn_sched_barrier(0);
        }
    }
};
__device__ __forceinline__ float dpp_ror1(float x) { return __builtin_bit_cast(float, __builtin_amdgcn_mov_dpp(__builtin_bit_cast(int, x), 0x121, 0xf, 0xf, true)); }
__device__ __forceinline__ float dpp_ror2(float x) { return __builtin_bit_cast(float, __builtin_amdgcn_mov_dpp(__builtin_bit_cast(int, x), 0x122, 0xf, 0xf, true)); }
__device__ __forceinline__ float dpp_shr1(float old, float x) { return __builtin_bit_cast(float, __builtin_amdgcn_update_dpp(__builtin_bit_cast(int, old), __builtin_bit_cast(int, x), 0x111, 0xf, 0xf, false)); }
__device__ __forceinline__ float dpp_shr2(float old, float x) { return __builtin_bit_cast(float, __builtin_amdgcn_update_dpp(__builtin_bit_cast(int, old), __builtin_bit_cast(int, x), 0x112, 0xf, 0xf, false)); }
constexpr float WGU_I8SCALE = 2048.0f;
constexpr float ATT_PRESCALE = 16.0f, WOUT_PRESCALE = 2048.0f;
constexpr float ACT_PRESCALE = 8.0f, WDN_PRESCALE = 4096.0f;
template <bool I8> struct EpiGateUpT {
    static constexpr bool PERM = true, AFTER_DRAIN = false;
    unsigned char* ACT; int ldact  ; const float* cw; const float* st; float* sb; float* out_fp; float* out_fs; PG8_LAS float* halo; float accs = 1.0f; const float* rowscale = nullptr;
    template <bool SAMP> __device__ __forceinline__ void body(const f32x4 (&acc)[2][2][4][2], const Unit& u, int wr, int wc, int fr, int fq) const {
        constexpr int DFF_ = 11008;
        const int pm = u.pm(), ch0 = 128 * u.pn() + 32 * wc + 8 * fq;
        PG8_LAS float* RS = halo + 1024;
        if (I8) { const int t_ = (wr * 4 + wc) * 64 + fq * 16 + fr; if (t_ < 256) RS[t_] = rowscale[pm * BM + t_] * accs; }
        auto cv = [](const f32x4& a_, float f_) -> f32x4 { if (I8) { typedef int i32x4_ __attribute__((ext_vector_type(4))); const i32x4_ i_ = __builtin_bit_cast(i32x4_, a_);
            return (f32x4){(float)i_[0] * f_, (float)i_[1] * f_, (float)i_[2] * f_, (float)i_[3] * f_}; } else return a_ * f_; };
        if (fr >= 14) {
#pragma unroll
            for (int ai = 0; ai < 2; ++ai) { PG8_LAS f32x4* hp = (PG8_LAS f32x4*)(halo + ((((ai * 2 + wr) * 4 + wc) * 2 + (fr - 14)) * 4 + fq) * 8); const float f_ = I8 ? rowscale[pm * BM + ai * HALF + wr * 64 + 48 + fr] * accs : accs; f32x4 t0_ = acc[ai][0][3][0], t1_ = acc[ai][0][3][1]; if (I8) asm volatile("" : "+v"(t0_), "+v"(t1_));
                hp[0] = cv(t0_, f_); hp[1] = cv(t1_, f_); }
        }
        f32x2 w0[4], w1[4], w2[4];
        { const f32x4 a0 = *(const f32x4*)(cw + ch0), a1 = *(const f32x4*)(cw + ch0 + 4), b0 = *(const f32x4*)(cw + DFF_ + ch0), b1 = *(const f32x4*)(cw + DFF_ + ch0 + 4), c0 = *(const f32x4*)(cw + 2 * DFF_ + ch0), c1 = *(const f32x4*)(cw + 2 * DFF_ + ch0 + 4);
          w0[0] = (f32x2){a0[0], a0[1]}; w0[1] = (f32x2){a0[2], a0[3]}; w0[2] = (f32x2){a1[0], a1[1]}; w0[3] = (f32x2){a1[2], a1[3]};
          w1[0] = (f32x2){b0[0], b0[1]}; w1[1] = (f32x2){b0[2], b0[3]}; w1[2] = (f32x2){b1[0], b1[1]}; w1[3] = (f32x2){b1[2], b1[3]};
          w2[0] = (f32x2){c0[0], c0[1]}; w2[1] = (f32x2){c0[2], c0[3]}; w2[2] = (f32x2){c1[0], c1[1]}; w2[3] = (f32x2){c1[2], c1[3]}; }
        asm volatile("s_waitcnt lgkmcnt(0)" ::: "memory"); __builtin_amdgcn_s_barrier(); asm volatile("" ::: "memory");
#pragma unroll
        for (int ai = 0; ai < 2; ++ai) {
            float o1[8], o2[8];
            if (wr == 1 || ai == 1) {
                const int sa = (wr == 1) ? ai : 0, sw = (wr == 1) ? 0 : 1;
                const PG8_LAS f32x4* h1 = (const PG8_LAS f32x4*)(halo + ((((sa * 2 + sw) * 4 + wc) * 2 + 1) * 4 + fq) * 8);
                const PG8_LAS f32x4* h0 = (const PG8_LAS f32x4*)(halo + ((((sa * 2 + sw) * 4 + wc) * 2 + 0) * 4 + fq) * 8);
                const f32x4 x0 = h1[0], x1 = h1[1], y0 = h0[0], y1 = h0[1];
#pragma unroll
                for (int j = 0; j < 4; ++j) { o1[j] = x0[j]; o1[4 + j] = x1[j]; o2[j] = (fr == 0) ? y0[j] : x0[j]; o2[4 + j] = (fr == 0) ? y1[j] : x1[j]; }
            } else {
#pragma unroll
                for (int j = 0; j < 8; ++j) { o1[j] = 0.f; o2[j] = 0.f; }
            }
#pragma unroll
            for (int m = 0; m < 4; ++m) {
                const int r = pm * BM + ai * HALF + wr * 64 + m * 16 + fr;
                float g[8], p1[8], p2[8];
                const float rs_c = I8 ? RS[ai * HALF + wr * 64 + m * 16 + fr] : accs;
                const f32x4 ga_ = cv(acc[ai][0][m][0], rs_c), gb_ = cv(acc[ai][0][m][1], rs_c);
#pragma unroll
                for (int j = 0; j < 4; ++j) { g[j] = ga_[j]; g[4 + j] = gb_[j]; }
#pragma unroll
                for (int j = 0; j < 8; ++j) { p1[j] = dpp_shr1(o1[j], g[j]); p2[j] = dpp_shr2(o2[j], g[j]); }
                if (m < 3) {
#pragma unroll
                    for (int j = 0; j < 8; ++j) { o1[j] = dpp_ror1(g[j]); o2[j] = dpp_ror2(g[j]); }
                }
                if (SAMP) {
                    const int t = fr & 7, seq = (r - 8192) >> 3;
                    const float* sp = st + (size_t)seq * 2 * DFF_ + ch0;
                    f32x4 s00 = {0.f, 0.f, 0.f, 0.f}, s01 = s00, s10 = s00, s11 = s00;
                    if (t < 2) { s10 = *(const f32x4*)(sp + DFF_); s11 = *(const f32x4*)(sp + DFF_ + 4); if (t == 0) { s00 = *(const f32x4*)(sp); s01 = *(const f32x4*)(sp + 4); } }
#pragma unroll
                    for (int j = 0; j < 4; ++j) { p1[j] = (t == 0) ? s10[j] : p1[j]; p1[4 + j] = (t == 0) ? s11[j] : p1[4 + j];
                        p2[j] = (t == 0) ? s00[j] : ((t == 1) ? s10[j] : p2[j]); p2[4 + j] = (t == 0) ? s01[j] : ((t == 1) ? s11[j] : p2[4 + j]); }
                    if (!I8 && t >= 6) { float* so = out_fs + ((size_t)seq * 2 + (t - 6)) * DFF_ + ch0; *(f32x4*)(so) = ga_; *(f32x4*)(so + 4) = gb_; }
                } else {
                    if (ai == 0 && m == 0) { if (wr == 0 && fr < 2) { float* q = sb + ((size_t)pm * 6 + fr) * DFF_ + ch0; *(f32x4*)(q) = ga_; *(f32x4*)(q + 4) = gb_;
                        q += 2 * DFF_; *(f32x4*)(q) = cv(acc[0][1][0][0], rs_c); *(f32x4*)(q + 4) = cv(acc[0][1][0][1], rs_c); } }
                    if (ai == 1 && m == 3) { if (wr == 1 && fr >= 14) { float* q = sb + ((size_t)pm * 6 + 4 + (fr - 14)) * DFF_ + ch0; *(f32x4*)(q) = ga_; *(f32x4*)(q + 4) = gb_;
                        if ((pm & 15) == 15) { float* so = out_fp + ((size_t)(pm >> 4) * 2 + (fr - 14)) * DFF_ + ch0; *(f32x4*)(so) = ga_; *(f32x4*)(so + 4) = gb_; } } }
                }
                int q0 = 0, q1 = 0;
#pragma unroll
                for (int jp = 0; jp < 4; ++jp) {
                    const f32x2 gv = (f32x2){g[2 * jp], g[2 * jp + 1]}, p1v = (f32x2){p1[2 * jp], p1[2 * jp + 1]}, p2v = (f32x2){p2[2 * jp], p2[2 * jp + 1]};
                    const f32x2 ur_ = (jp < 2) ? (f32x2){acc[ai][1][m][0][2 * jp], acc[ai][1][m][0][2 * jp + 1]} : (f32x2){acc[ai][1][m][1][2 * jp - 4], acc[ai][1][m][1][2 * jp - 3]};
                    const float ux_ = ur_.x, uy_ = ur_.y;
                    const f32x2 uv = I8 ? (f32x2){(float)__float_as_int(ux_), (float)__float_as_int(uy_)} * rs_c : ur_ * rs_c;
                    const f32x2 gc = w0[jp] * p2v + w1[jp] * p1v + w2[jp] * gv, ea = gc * (-1.4426950408889634f);
                    f32x2 e; e.x = __builtin_amdgcn_exp2f(ea.x); e.y = __builtin_amdgcn_exp2f(ea.y);
                    const f32x2 d = e + 1.0f; f32x2 rc; rc.x = __builtin_amdgcn_rcpf(d.x); rc.y = __builtin_amdgcn_rcpf(d.y);
                    const f32x2 o = ((gc * rc) * uv) * ACT_PRESCALE;
                    const float ox = __builtin_amdgcn_fmed3f(o.x, -448.0f, 448.0f), oy = __builtin_amdgcn_fmed3f(o.y, -448.0f, 448.0f);
                    if (jp == 0) q0 = __builtin_amdgcn_cvt_pk_fp8_f32(ox, oy, q0, false); else if (jp == 1) q0 = __builtin_amdgcn_cvt_pk_fp8_f32(ox, oy, q0, true);
                    else if (jp == 2) q1 = __builtin_amdgcn_cvt_pk_fp8_f32(ox, oy, q1, false); else q1 = __builtin_amdgcn_cvt_pk_fp8_f32(ox, oy, q1, true);
                }
                { typedef unsigned u32x2 __attribute__((ext_vector_type(2))); *(u32x2*)(ACT + (size_t)r * ldact + ch0) = (u32x2){(unsigned)q0, (unsigned)q1}; }
            }
        }
    }
    __device__ __forceinline__ void operator()(const f32x4 (&acc)[2][2][4][2], const Unit& u, int wr, int wc, int fr, int fq) const {
        if (u.pm() >= 32) body<true>(acc, u, wr, wc, fr, fq); else body<false>(acc, u, wr, wc, fr, fq);
    }
};
typedef EpiGateUpT<false> EpiGateUp;
struct EpiGateState {
    static constexpr bool PERM = true, AFTER_DRAIN = false;
    float* out_fs;
    __device__ __forceinline__ void operator()(const f32x4 (&acc)[2][2][4][2], const Unit& u, int wr, int wc, int fr, int fq) const {
        constexpr int DFF_ = 11008;
#pragma unroll
        for (int ai = 0; ai < 2; ++ai)
#pragma unroll
            for (int m = 0; m < 4; ++m) { float* rowp = out_fs + (size_t)(ai * HALF + wr * 64 + m * 16 + fr) * DFF_;
#pragma unroll
                for (int bj = 0; bj < 2; ++bj) { const int tile = 2 * u.pn() + bj;
                    float* q = rowp + 128 * tile + 32 * wc + 8 * fq; *(f32x4*)(q) = acc[ai][bj][m][0]; *(f32x4*)(q + 4) = acc[ai][bj][m][1]; } }
    }
};
template <bool I8> struct EpiInProjT {
    static constexpr bool PERM = true, AFTER_DRAIN = false;
    bf16_t* PROJ; int ldp; bf16_t* MIX; int ldm; const float* cw; const float* st; float* sb; float* out_cp; float* out_cs; PG8_LAS float* halo; float accs = 1.0f; const float* rowscale = nullptr;
    static __device__ __forceinline__ f32x4 cv(const f32x4& a_, float f_) { if (I8) { typedef int i32x4_ __attribute__((ext_vector_type(4))); const i32x4_ i_ = __builtin_bit_cast(i32x4_, a_);
        return (f32x4){(float)i_[0] * f_, (float)i_[1] * f_, (float)i_[2] * f_, (float)i_[3] * f_}; } else return a_; }
    __device__ __forceinline__ void plain(const f32x4 (&acc)[2][2][4][2], const Unit& u, int wr, int wc, int fr, int fq) const {
        const int row0 = u.pm() * BM + wr * 64 + fr, col0 = 2048 + (u.pn() - 32) * BM + wc * 32 + 8 * fq;
#pragma unroll
        for (int ai = 0; ai < 2; ++ai)
#pragma unroll
            for (int m = 0; m < 4; ++m) { bf16_t* rowp = PROJ + (size_t)(row0 + ai * HALF + m * 16) * ldp + col0; const float rs_c = I8 ? rowscale[row0 + ai * HALF + m * 16] * accs : 1.0f;
#pragma unroll
                for (int bj = 0; bj < 2; ++bj) { const f32x4 v0 = cv(acc[ai][bj][m][0], rs_c), v1 = cv(acc[ai][bj][m][1], rs_c);
                    u32x4 w; w.x = cvt_pk_bf16(v0[0], v0[1]); w.y = cvt_pk_bf16(v0[2], v0[3]); w.z = cvt_pk_bf16(v1[0], v1[1]); w.w = cvt_pk_bf16(v1[2], v1[3]);
                    *(u32x4*)(rowp + bj * HALF) = w; } }
    }
    template <bool SAMP> __device__ __forceinline__ void body(const f32x4 (&acc)[2][2][4][2], const Unit& u, int wr, int wc, int fr, int fq) const {
        constexpr int DC = 2048;
        typedef unsigned u32x2 __attribute__((ext_vector_type(2)));
        const int pm = u.pm(), ch0 = 64 * u.pn() + 16 * wc + 4 * fq;
        PG8_LAS float* RS = halo + 1024;
        if (I8) { const int t_ = (wr * 4 + wc) * 64 + fq * 16 + fr; if (t_ < 256) RS[t_] = rowscale[pm * BM + t_] * accs; }
        if (fr >= 14) {
#pragma unroll
            for (int ai = 0; ai < 2; ++ai) { const float f_ = I8 ? rowscale[pm * BM + ai * HALF + wr * 64 + 48 + fr] * accs : 1.0f; f32x4 t0_ = acc[ai][0][3][1], t1_ = acc[ai][1][3][0]; if (I8) asm volatile("" : "+v"(t0_), "+v"(t1_));
                *(PG8_LAS f32x4*)(halo + ((((ai * 2 + wr) * 4 + wc) * 2 + (fr - 14)) * 4 + fq) * 4) = cv(t0_, f_) * cv(t1_, f_); }
        }
        const f32x4 w0 = *(const f32x4*)(cw + ch0), w1 = *(const f32x4*)(cw + DC + ch0), w2 = *(const f32x4*)(cw + 2 * DC + ch0);
        asm volatile("s_waitcnt lgkmcnt(0)" ::: "memory"); __builtin_amdgcn_s_barrier(); asm volatile("" ::: "memory");
#pragma unroll
        for (int ai = 0; ai < 2; ++ai) {
            float o1[4], o2[4];
            if (wr == 1 || ai == 1) {
                const int sa = (wr == 1) ? ai : 0, sw = (wr == 1) ? 0 : 1;
                const f32x4 x = *(const PG8_LAS f32x4*)(halo + ((((sa * 2 + sw) * 4 + wc) * 2 + 1) * 4 + fq) * 4);
                const f32x4 y = *(const PG8_LAS f32x4*)(halo + ((((sa * 2 + sw) * 4 + wc) * 2 + 0) * 4 + fq) * 4);
#pragma unroll
                for (int j = 0; j < 4; ++j) { o1[j] = x[j]; o2[j] = (fr == 0) ? y[j] : x[j]; }
            } else {
#pragma unroll
                for (int j = 0; j < 4; ++j) { o1[j] = 0.f; o2[j] = 0.f; }
            }
#pragma unroll
            for (int m = 0; m < 4; ++m) {
                const int r = pm * BM + ai * HALF + wr * 64 + m * 16 + fr;
                const float rs_c = I8 ? RS[ai * HALF + wr * 64 + m * 16 + fr] : 1.0f;
                const f32x4 Bv = cv(acc[ai][0][m][0], rs_c), uu = cv(acc[ai][0][m][1], rs_c) * cv(acc[ai][1][m][0], rs_c), Qv = cv(acc[ai][1][m][1], rs_c);
                { u32x2 wq; wq.x = cvt_pk_bf16(Qv[0], Qv[1]); wq.y = cvt_pk_bf16(Qv[2], Qv[3]); *(u32x2*)(PROJ + (size_t)r * ldp + ch0) = wq; }
                f32x4 p1, p2;
#pragma unroll
                for (int j = 0; j < 4; ++j) { p1[j] = dpp_shr1(o1[j], uu[j]); p2[j] = dpp_shr2(o2[j], uu[j]); }
                if (m < 3) {
#pragma unroll
                    for (int j = 0; j < 4; ++j) { o1[j] = dpp_ror1(uu[j]); o2[j] = dpp_ror2(uu[j]); }
                }
                if (SAMP) {
                    const int t = fr & 7, seq = (r - 8192) >> 3;
                    const float* sp = st + (size_t)seq * 2 * DC + ch0;
                    f32x4 s0 = {0.f, 0.f, 0.f, 0.f}, s1 = s0;
                    if (t < 2) { s1 = *(const f32x4*)(sp + DC); if (t == 0) s0 = *(const f32x4*)(sp); }
#pragma unroll
                    for (int j = 0; j < 4; ++j) { p1[j] = (t == 0) ? s1[j] : p1[j]; p2[j] = (t == 0) ? s0[j] : ((t == 1) ? s1[j] : p2[j]); }
                    if (t >= 6) *(f32x4*)(out_cs + ((size_t)seq * 2 + (t - 6)) * DC + ch0) = uu;
                } else {
                    if (ai == 0 && m == 0) { if (wr == 0 && fr < 2) { float* q = sb + ((size_t)pm * 6 + fr) * DC + ch0; *(f32x4*)(q) = uu; *(f32x4*)(q + 2 * DC) = Bv; } }
                    if (ai == 1 && m == 3) { if (wr == 1 && fr >= 14) { *(f32x4*)(sb + ((size_t)pm * 6 + 4 + (fr - 14)) * DC + ch0) = uu;
                        if ((pm & 15) == 15) *(f32x4*)(out_cp + ((size_t)(pm >> 4) * 2 + (fr - 14)) * DC + ch0) = uu; } }
                }
                const f32x4 o = Bv * (w0 * p2 + w1 * p1 + w2 * uu);
                u32x2 wo; wo.x = cvt_pk_bf16(o[0], o[1]); wo.y = cvt_pk_bf16(o[2], o[3]);
                *(u32x2*)(MIX + (size_t)r * ldm + DC + ch0) = wo;
            }
        }
    }
    __device__ __forceinline__ void operator()(const f32x4 (&acc)[2][2][4][2], const Unit& u, int wr, int wc, int fr, int fq) const {
        if (u.pn() >= 32) plain(acc, u, wr, wc, fr, fq); else if (!I8 && u.pm() >= 32) body<true>(acc, u, wr, wc, fr, fq); else body<false>(acc, u, wr, wc, fr, fq);
    }
};
typedef EpiInProjT<false> EpiInProj;
template <bool B_> struct BoolTag { static constexpr bool value = B_; };
template <class Epi, class Sched, bool ALIGN_EPI = false, bool SP2 = false, int PREC = 0>
__device__ __forceinline__ void gemm_phase(PG8_LAS unsigned char* lds, const Gemm g, const Sched& S, const Epi& E) {
    constexpr bool FP8 = (PREC == 1), I8 = (PREC == 2), MIXED = (PREC == 3);
    constexpr bool T8 = FP8 || MIXED;
    int tid_ = threadIdx.x; asm volatile("" : "+v"(tid_));
    const int tid = tid_, wid = __builtin_amdgcn_readfirstlane(tid >> 6), lane = tid & 63, wr = wid >> 2, wc = wid & 3, fr = lane & 15, fq = lane >> 4;
    const int K = g.ld;
    unsigned voffA[2], voffB[2];
#pragma unroll
    for (int i = 0; i < 2; ++i) { int R, C; stage_rc(tid * 16 + i * 8192, R, C); const int Rb = Epi::PERM ? ((R & ~31) + perm32(R & 31)) : R;
        voffA[i] = (unsigned)(R * K + C) * 2u; voffB[i] = (unsigned)(Rb * K + C) * 2u; }
    const size_t kstep = (size_t)(BK * 2);
    const size_t hstep = (size_t)HALF * K * 2;
    const size_t tstep = 2 * hstep;
    const size_t hstepB = g.bh ? g.bh : hstep, tstepB = g.bt ? g.bt : tstep;
    const unsigned ldsw = (unsigned)wid * 1024u;
    const int aoff = lds_byte(wr * 64 + fr, fq * 8), boff = lds_byte(wc * 32 + fr, fq * 8);
#define PG8_SA(b, h) (((b) * 2 + (h)) * HTB)
#define PG8_SB(b, h) ((4 + (b) * 2 + (h)) * HTB)
#define PG8_STAGE(bufoff, gbase, voff) do { _Pragma("unroll") for (int _i = 0; _i < 2; ++_i) \
        __builtin_amdgcn_global_load_lds((const unsigned*)((const char*)(gbase) + (voff)[_i]), (PG8_LAS unsigned*)(lds + (bufoff) + ldsw + _i * 8192), 16, 0, 0); } while (0)
#define PG8_LDA(dst, b, h) do { if constexpr (T8) { _Pragma("unroll") for (int m = 0; m < 4; ++m) { \
            const v4i_ lo_ = *(const PG8_LAS v4i_*)(lds + PG8_SA(b, h) + aoff + m * 2048), hi_ = *(const PG8_LAS v4i_*)(lds + PG8_SA(b, h) + aoff + m * 2048 + 1024); \
            dst##8[m] = __builtin_shufflevector(lo_, hi_, 0, 1, 2, 3, 4, 5, 6, 7); } } \
        else { _Pragma("unroll") for (int m = 0; m < 4; ++m) _Pragma("unroll") for (int k = 0; k < 2; ++k) dst[m][k] = *(const PG8_LAS bf16x8*)(lds + PG8_SA(b, h) + aoff + m * 2048 + k * 1024); } } while (0)
#define PG8_LDB(dst, b, h) do { if constexpr (T8) { _Pragma("unroll") for (int n = 0; n < 2; ++n) { \
            const v4i_ lo_ = *(const PG8_LAS v4i_*)(lds + PG8_SB(b, h) + boff + n * 2048), hi_ = *(const PG8_LAS v4i_*)(lds + PG8_SB(b, h) + boff + n * 2048 + 1024); \
            dst##8[n] = __builtin_shufflevector(lo_, hi_, 0, 1, 2, 3, 4, 5, 6, 7); } } \
        else { _Pragma("unroll") for (int n = 0; n < 2; ++n) _Pragma("unroll") for (int k = 0; k < 2; ++k) dst[n][k] = *(const PG8_LAS bf16x8*)(lds + PG8_SB(b, h) + boff + n * 2048 + k * 1024); } } while (0)
#define PG8_MMA(ai, bj, At, Bt) do { __builtin_amdgcn_s_setprio(1); \
        if constexpr (FP8) { \
            _Pragma("unroll") for (int m = 0; m < 4; ++m) _Pragma("unroll") for (int n = 0; n < 2; ++n) \
                asm volatile("v_mfma_f32_16x16x128_f8f6f4 %0, %1, %2, %0" : "+v"(acc[ai][bj][m][n]) : "v"(Bt##8[n]), "v"(At##8[m]));     \
        } else if constexpr (MIXED) { if constexpr (F8SEG) { \
            _Pragma("unroll") for (int m = 0; m < 4; ++m) _Pragma("unroll") for (int n = 0; n < 2; ++n) \
                asm volatile("v_mfma_f32_16x16x128_f8f6f4 %0, %1, %2, %0" : "+v"(acc[ai][bj][m][n]) : "v"(Bt##8[n]), "v"(At##8[m]));     \
          } else { _Pragma("unroll") for (int m = 0; m < 4; ++m) _Pragma("unroll") for (int n = 0; n < 2; ++n) { \
                asm volatile("v_mfma_f32_16x16x32_bf16 %0, %1, %2, %0" : "+v"(acc[ai][bj][m][n]) : "v"(Bt##8[n].lo), "v"(At##8[m].lo)); } \
            _Pragma("unroll") for (int m = 0; m < 4; ++m) _Pragma("unroll") for (int n = 0; n < 2; ++n) { \
                asm volatile("v_mfma_f32_16x16x32_bf16 %0, %1, %2, %0" : "+v"(acc[ai][bj][m][n]) : "v"(Bt##8[n].hi), "v"(At##8[m].hi)); } } \
        } else if constexpr (I8) { _Pragma("unroll") for (int k = 0; k < 2; ++k) _Pragma("unroll") for (int m = 0; m < 4; ++m) _Pragma("unroll") for (int n = 0; n < 2; ++n) \
            acc[ai][bj][m][n] = __builtin_bit_cast(f32x4, __builtin_amdgcn_mfma_i32_16x16x64_i8(__builtin_bit_cast(v4i_, Bt[n][k]), __builtin_bit_cast(v4i_, At[m][k]), __builtin_bit_cast(v4i_, acc[ai][bj][m][n]), 0, 0, 0)); \
        } else { _Pragma("unroll") for (int m = 0; m < 4; ++m) _Pragma("unroll") for (int n = 0; n < 2; ++n) _Pragma("unroll") for (int k = 0; k < 2; ++k) \
            acc[ai][bj][m][n] = __builtin_amdgcn_mfma_f32_16x16x32_bf16(Bt[n][k], At[m][k], acc[ai][bj][m][n], 0, 0, 0); } \
        __builtin_amdgcn_s_setprio(0); } while (0)
#define PG8_WAIT_V(n) asm volatile("s_waitcnt vmcnt(" #n ")" ::: "memory")
#define PG8_WAIT_L(n) asm volatile("s_waitcnt lgkmcnt(" #n ")" ::: "memory")
#define PG8_BAR __builtin_amdgcn_s_barrier()
#define PG8_SCHED __builtin_amdgcn_sched_barrier(0)
    Unit cur, nxt; int ui = 0;
    if (!S.next(0, cur)) return;
    f32x4 acc[2][2][4][2];
#pragma unroll
    for (int a = 0; a < 2; ++a)
#pragma unroll
        for (int b = 0; b < 2; ++b)
#pragma unroll
            for (int m = 0; m < 4; ++m)
#pragma unroll
                for (int n = 0; n < 2; ++n) acc[a][b][m][n] = (f32x4){0.f, 0.f, 0.f, 0.f};
    typedef int v8i_ __attribute__((ext_vector_type(8))); typedef int v4i_ __attribute__((ext_vector_type(4)));
    int fp8_unit_scale = 0x7f7f7f7f; asm volatile("" : "+v"(fp8_unit_scale));
    bf16x8 At[4][2], B0[2][2], B1[2][2]; v8i_ At8[4], B08[2], B18[2];
    bool seg8 = MIXED && cur.f8();
    const char* cA = (const char*)((MIXED && cur.f8()) ? g.A8 : g.A) + (size_t)cur.pm() * tstep + (size_t)cur.k0() * 2; const char* cB = (const char*)((MIXED && cur.f8()) ? g.B8 : g.Bt) + (size_t)cur.pn() * tstepB + (size_t)cur.k0() * 2;
    S.a_ready(cur);
    if constexpr (SP2) {
        PG8_STAGE(PG8_SB(0, 0), cB, voffB); PG8_STAGE(PG8_SB(0, 1), cB + hstepB, voffB); PG8_STAGE(PG8_SA(0, 0), cA, voffA); PG8_STAGE(PG8_SA(0, 1), cA + hstep, voffA);
        if (wr == 1) PG8_BAR;
        PG8_WAIT_V(2); PG8_BAR;
        PG8_STAGE(PG8_SB(1, 0), cB + kstep, voffB); PG8_STAGE(PG8_SA(1, 0), cA + kstep, voffA); PG8_STAGE(PG8_SB(1, 1), cB + hstepB + kstep, voffB);
        PG8_WAIT_V(6); PG8_BAR;
    } else {
        PG8_STAGE(PG8_SB(0, 0), cB, voffB); PG8_STAGE(PG8_SA(0, 0), cA, voffA); PG8_STAGE(PG8_SB(0, 1), cB + hstepB, voffB); PG8_STAGE(PG8_SA(0, 1), cA + hstep, voffA);
        if (wr == 1) PG8_BAR;
        PG8_WAIT_V(4); PG8_BAR;
        PG8_STAGE(PG8_SB(1, 0), cB + kstep, voffB); PG8_STAGE(PG8_SA(1, 0), cA + kstep, voffA); PG8_STAGE(PG8_SB(1, 1), cB + hstepB + kstep, voffB);
        PG8_WAIT_V(6); PG8_BAR;
    }
    if constexpr (MIXED) {
    auto seg_ = [&](auto tag_) __attribute__((always_inline)) -> bool { constexpr bool F8SEG = decltype(tag_)::value; (void)F8SEG;
        const bool has_next = S.next(ui + 1, nxt);
        const char* nA = has_next ? (const char*)((MIXED && nxt.f8()) ? g.A8 : g.A) + (size_t)nxt.pm() * tstep + (size_t)nxt.k0() * 2 : cA; const char* nB = has_next ? (const char*)((MIXED && nxt.f8()) ? g.B8 : g.Bt) + (size_t)nxt.pn() * tstepB + (size_t)nxt.k0() * 2 : cB;
        const int nt = cur.nt();
        for (int t = 0; t < nt; t += 2) {
            const bool last = (t == nt - 2);
            const char* a1 = cA + (size_t)(t + 1) * kstep;
            const char* a2 = last ? nA : cA + (size_t)(t + 2) * kstep; const char* b2 = last ? nB : cB + (size_t)(t + 2) * kstep;
            const char* a3 = a2 + kstep; const char* b3 = b2 + kstep;
            if (last && has_next) S.a_ready(nxt);
            if constexpr (SP2) {
            PG8_LDB(B0, 0, 0); PG8_LDB(B1, 0, 1); PG8_SCHED; PG8_LDA(At, 0, 0); PG8_STAGE(PG8_SA(1, 1), a1 + hstep, voffA);
            PG8_WAIT_V(8); PG8_WAIT_L(0); PG8_BAR; PG8_MMA(0, 0, At, B0); PG8_MMA(0, 1, At, B1); PG8_BAR; PG8_SCHED;
            PG8_LDA(At, 0, 1); PG8_STAGE(PG8_SB(0, 0), b2, voffB); PG8_STAGE(PG8_SB(0, 1), b2 + hstepB, voffB); PG8_STAGE(PG8_SA(0, 0), a2, voffA);
            PG8_WAIT_V(8); PG8_WAIT_L(0); PG8_BAR; PG8_MMA(1, 0, At, B0); PG8_MMA(1, 1, At, B1); PG8_BAR; PG8_SCHED;
            PG8_LDB(B0, 1, 0); PG8_LDB(B1, 1, 1); PG8_SCHED; PG8_LDA(At, 1, 0); PG8_STAGE(PG8_SA(0, 1), a2 + hstep, voffA);
            PG8_WAIT_V(8); PG8_WAIT_L(0); PG8_BAR; PG8_MMA(0, 0, At, B0); PG8_MMA(0, 1, At, B1); PG8_BAR; PG8_SCHED;
            PG8_LDA(At, 1, 1); PG8_STAGE(PG8_SB(1, 0), b3, voffB); PG8_STAGE(PG8_SB(1, 1), b3 + hstepB, voffB); PG8_STAGE(PG8_SA(1, 0), a3, voffA);
            PG8_WAIT_V(8); PG8_WAIT_L(0); PG8_BAR; PG8_MMA(1, 0, At, B0); PG8_MMA(1, 1, At, B1); PG8_BAR; PG8_SCHED;
            } else {
            PG8_LDB(B0, 0, 0); PG8_SCHED; PG8_LDA(At, 0, 0); PG8_STAGE(PG8_SA(1, 1), a1 + hstep, voffA);
            PG8_WAIT_L(8); PG8_BAR; PG8_WAIT_L(0); PG8_MMA(0, 0, At, B0); PG8_BAR; PG8_SCHED;
            PG8_LDB(B1, 0, 1); PG8_STAGE(PG8_SB(0, 0), b2, voffB);
            PG8_BAR; PG8_WAIT_L(0); PG8_MMA(0, 1, At, B1); PG8_BAR;
            PG8_LDA(At, 0, 1); PG8_STAGE(PG8_SA(0, 0), a2, voffA);
            PG8_BAR; PG8_WAIT_L(0); PG8_MMA(1, 0, At, B0); PG8_BAR; PG8_SCHED;
            PG8_STAGE(PG8_SB(0, 1), b2 + hstepB, voffB);
            PG8_WAIT_V(6); PG8_BAR; PG8_MMA(1, 1, At, B1); PG8_BAR;
            PG8_LDB(B0, 1, 0); PG8_SCHED; PG8_LDA(At, 1, 0); PG8_STAGE(PG8_SA(0, 1), a2 + hstep, voffA);
            PG8_WAIT_L(8); PG8_BAR; PG8_WAIT_L(0); PG8_MMA(0, 0, At, B0); PG8_BAR; PG8_SCHED;
            PG8_LDB(B1, 1, 1); PG8_STAGE(PG8_SB(1, 0), b3, voffB);
            PG8_BAR; PG8_WAIT_L(0); PG8_MMA(0, 1, At, B1); PG8_BAR;
            PG8_LDA(At, 1, 1); PG8_STAGE(PG8_SA(1, 0), a3, voffA);
            PG8_BAR; PG8_WAIT_L(0); PG8_MMA(1, 0, At, B0); PG8_BAR; PG8_SCHED;
            PG8_STAGE(PG8_SB(1, 1), b3 + hstepB, voffB);
            PG8_WAIT_V(6); PG8_BAR; PG8_MMA(1, 1, At, B1); PG8_BAR;
            }
        }
        if constexpr (FP8 || MIXED) asm volatile("s_nop 15\n\ts_nop 15" ::: "memory");
        if constexpr (ALIGN_EPI) { if (wr == 0) PG8_BAR; }
        if constexpr (MIXED && F8SEG) {
            _Pragma("unroll") for (int a = 0; a < 2; ++a) _Pragma("unroll") for (int b = 0; b < 2; ++b) _Pragma("unroll") for (int m = 0; m < 4; ++m) _Pragma("unroll") for (int n = 0; n < 2; ++n) acc[a][b][m][n] = acc[a][b][m][n] * g.seam;
        } else
        if constexpr (!Epi::AFTER_DRAIN) { bool fin = true; if (cur.ns() > 1) fin = S.combine(acc, cur, wid, lane); if (fin) E(acc, cur, wr, wc, fr, fq); S.done(cur); }
        if (!has_next) return true;
        if constexpr (!(MIXED && F8SEG)) {
#pragma unroll
        for (int a = 0; a < 2; ++a)
#pragma unroll
            for (int b = 0; b < 2; ++b)
#pragma unroll
                for (int m = 0; m < 4; ++m)
#pragma unroll
                    for (int n = 0; n < 2; ++n) acc[a][b][m][n] = (f32x4){0.f, 0.f, 0.f, 0.f};
        }
        cur = nxt; cA = nA; cB = nB; ++ui; seg8 = MIXED && cur.f8();
        if constexpr (ALIGN_EPI) { if (wr == 1) PG8_BAR; }
            return false;
    };
    for (;;) {
        if constexpr (MIXED) { if (seg_(BoolTag<true>{})) break; }
        if (seg_(BoolTag<false>{})) break;
    }
    } else {
    constexpr bool F8SEG = false; (void)F8SEG;
    for (;;) {
        const bool has_next = S.next(ui + 1, nxt);
        const char* nA = has_next ? (const char*)g.A + (size_t)nxt.pm() * tstep + (size_t)nxt.k0() * 2 : cA; const char* nB = has_next ? (const char*)g.Bt + (size_t)nxt.pn() * tstepB + (size_t)nxt.k0() * 2 : cB;
        const int nt = cur.nt();
        for (int t = 0; t < nt; t += 2) {
            const bool last = (t == nt - 2);
            const char* a1 = cA + (size_t)(t + 1) * kstep;
            const char* a2 = last ? nA : cA + (size_t)(t + 2) * kstep; const char* b2 = last ? nB : cB + (size_t)(t + 2) * kstep;
            const char* a3 = a2 + kstep; const char* b3 = b2 + kstep;
            if (last && has_next) S.a_ready(nxt);
            if constexpr (SP2) {
            PG8_LDB(B0, 0, 0); PG8_LDB(B1, 0, 1); PG8_SCHED; PG8_LDA(At, 0, 0); PG8_STAGE(PG8_SA(1, 1), a1 + hstep, voffA);
            PG8_WAIT_V(8); PG8_WAIT_L(0); PG8_BAR; PG8_MMA(0, 0, At, B0); PG8_MMA(0, 1, At, B1); PG8_BAR; PG8_SCHED;
            PG8_LDA(At, 0, 1); PG8_STAGE(PG8_SB(0, 0), b2, voffB); PG8_STAGE(PG8_SB(0, 1), b2 + hstepB, voffB); PG8_STAGE(PG8_SA(0, 0), a2, voffA);
            PG8_WAIT_V(8); PG8_WAIT_L(0); PG8_BAR; PG8_MMA(1, 0, At, B0); PG8_MMA(1, 1, At, B1); PG8_BAR; PG8_SCHED;
            PG8_LDB(B0, 1, 0); PG8_LDB(B1, 1, 1); PG8_SCHED; PG8_LDA(At, 1, 0); PG8_STAGE(PG8_SA(0, 1), a2 + hstep, voffA);
            PG8_WAIT_V(8); PG8_WAIT_L(0); PG8_BAR; PG8_MMA(0, 0, At, B0); PG8_MMA(0, 1, At, B1); PG8_BAR; PG8_SCHED;
            PG8_LDA(At, 1, 1); PG8_STAGE(PG8_SB(1, 0), b3, voffB); PG8_STAGE(PG8_SB(1, 1), b3 + hstepB, voffB); PG8_STAGE(PG8_SA(1, 0), a3, voffA);
            PG8_WAIT_V(8); PG8_WAIT_L(0); PG8_BAR; PG8_MMA(1, 0, At, B0); PG8_MMA(1, 1, At, B1); PG8_BAR; PG8_SCHED;
            } else {
            PG8_LDB(B0, 0, 0); PG8_SCHED; PG8_LDA(At, 0, 0); PG8_STAGE(PG8_SA(1, 1), a1 + hstep, voffA);
            PG8_WAIT_L(8); PG8_BAR; PG8_WAIT_L(0); PG8_MMA(0, 0, At, B0); PG8_BAR; PG8_SCHED;
            PG8_LDB(B1, 0, 1); PG8_STAGE(PG8_SB(0, 0), b2, voffB);
            PG8_BAR; PG8_WAIT_L(0); PG8_MMA(0, 1, At, B1); PG8_BAR;
            PG8_LDA(At, 0, 1); PG8_STAGE(PG8_SA(0, 0), a2, voffA);
            PG8_BAR; PG8_WAIT_L(0); PG8_MMA(1, 0, At, B0); PG8_BAR; PG8_SCHED;
            PG8_STAGE(PG8_SB(0, 1), b2 + hstepB, voffB);
            PG8_WAIT_V(6); PG8_BAR; PG8_MMA(1, 1, At, B1); PG8_BAR;
            PG8_LDB(B0, 1, 0); PG8_SCHED; PG8_LDA(At, 1, 0); PG8_STAGE(PG8_SA(0, 1), a2 + hstep, voffA);
            PG8_WAIT_L(8); PG8_BAR; PG8_WAIT_L(0); PG8_MMA(0, 0, At, B0); PG8_BAR; PG8_SCHED;
            PG8_LDB(B1, 1, 1); PG8_STAGE(PG8_SB(1, 0), b3, voffB);
            PG8_BAR; PG8_WAIT_L(0); PG8_MMA(0, 1, At, B1); PG8_BAR;
            PG8_LDA(At, 1, 1); PG8_STAGE(PG8_SA(1, 0), a3, voffA);
            PG8_BAR; PG8_WAIT_L(0); PG8_MMA(1, 0, At, B0); PG8_BAR; PG8_SCHED;
            PG8_STAGE(PG8_SB(1, 1), b3 + hstepB, voffB);
            PG8_WAIT_V(6); PG8_BAR; PG8_MMA(1, 1, At, B1); PG8_BAR;
            }
        }
        if constexpr (FP8) asm volatile("s_nop 15\n\ts_nop 15" ::: "memory");
        if constexpr (ALIGN_EPI) { if (wr == 0) PG8_BAR; }
        if constexpr (!Epi::AFTER_DRAIN) { bool fin = true; if (cur.ns() > 1) fin = S.combine(acc, cur, wid, lane); if (fin) E(acc, cur, wr, wc, fr, fq); S.done(cur); }
        if (!has_next) break;
#pragma unroll
        for (int a = 0; a < 2; ++a)
#pragma unroll
            for (int b = 0; b < 2; ++b)
#pragma unroll
                for (int m = 0; m < 4; ++m)
#pragma unroll
                    for (int n = 0; n < 2; ++n) acc[a][b][m][n] = (f32x4){0.f, 0.f, 0.f, 0.f};
        cur = nxt; cA = nA; cB = nB; ++ui;
        if constexpr (ALIGN_EPI) { if (wr == 1) PG8_BAR; }
    }
    }
    PG8_WAIT_V(0);
    if constexpr (!ALIGN_EPI) { if (wr == 0) PG8_BAR; }
    PG8_BAR;
    if constexpr (Epi::AFTER_DRAIN) { E.fused(acc, cur, wr, wc, fr, fq, lds, wid, lane); S.done(cur); }
#undef PG8_SA
#undef PG8_SB
#undef PG8_STAGE
#undef PG8_LDA
#undef PG8_LDB
#undef PG8_MMA
#undef PG8_WAIT_V
#undef PG8_WAIT_L
#undef PG8_BAR
#undef PG8_SCHED
}
}
#define GAS __attribute__((address_space(1)))
#define LAS __attribute__((address_space(3)))
typedef unsigned short bf16;
typedef unsigned v4u __attribute__((ext_vector_type(4)));
typedef float f32x4 __attribute__((ext_vector_type(4)));
typedef short bf16x8 __attribute__((ext_vector_type(8)));
typedef GAS unsigned gu32;
typedef GAS unsigned long long gu64;
#define RLX_AGENT __ATOMIC_RELAXED, __HIP_MEMORY_SCOPE_AGENT
#define LDS_WAIT() asm volatile("s_waitcnt lgkmcnt(0)" ::: "memory")
#define VM_WAIT() asm volatile("s_waitcnt vmcnt(0)" ::: "memory")
__device__ __forceinline__ unsigned long long rt() { return __builtin_amdgcn_s_memrealtime(); }
__device__ __forceinline__ unsigned f2bf(float f) { unsigned u = __builtin_bit_cast(unsigned, f); return (u + 0x7fffu + ((u >> 16) & 1u)) >> 16; }
__device__ __forceinline__ unsigned pk2(float lo, float hi) { return f2bf(lo) | (f2bf(hi) << 16); }
#define XB_TMO      128
#define XB_XCNT(j)  (256  + 64 * (j))
#define XB_XSUB(j)  (1280 + 64 * (j))
#define XB_XGEN(j)  (2304 + 64 * (j))
#define XB_TOP      3328
#define XB_TOPGEN   3392
#define XCD_BAR_WORDS 3456
#define XB_SPIN_CAP (1u << 18)

__device__ __forceinline__ unsigned xb_ld(unsigned* p)              { return __hip_atomic_load(p, __ATOMIC_RELAXED, __HIP_MEMORY_SCOPE_AGENT); }
__device__ __forceinline__ unsigned xb_add(unsigned* p, unsigned v) { return __hip_atomic_fetch_add(p, v, __ATOMIC_RELAXED, __HIP_MEMORY_SCOPE_AGENT); }
__device__ __forceinline__ unsigned xb_xcc_id() { return (unsigned)__builtin_amdgcn_s_getreg((3 << 11) | 20) & 0xFu; }
#define XB_SPIN(cond, bar) do { unsigned _sp = 0; while (cond) { __builtin_amdgcn_s_sleep(1); \
    if ((++_sp & 255u) == 0u) { if (xb_ld(&(bar)[XB_TMO])) break; if (_sp > XB_SPIN_CAP) { atomicAdd(&(bar)[XB_TMO], 1u); break; } } } } while (0)

struct XcdBarrier {
    unsigned* bar; unsigned x;
    volatile LAS unsigned* st;
};

__device__ __forceinline__ XcdBarrier xcd_barrier_post(unsigned* bar, volatile LAS unsigned* st) {
    XcdBarrier b; b.bar = bar; b.x = xb_xcc_id(); b.st = st;
    if (threadIdx.x == 0) (void)xb_add(&bar[XB_XCNT(b.x)], 1u);
    return b;
}
__device__ __forceinline__ void xcd_barrier_complete(unsigned* bar, unsigned x, unsigned& nloc, unsigned& nx) {
    const unsigned G = gridDim.x * gridDim.y * gridDim.z;
    unsigned sum, cnt, mine, sp = 0u;
    for (;;) {
        sum = 0u; cnt = 0u; mine = 0u;
#pragma unroll
        for (unsigned j = 0; j < 16; ++j) { const unsigned c = xb_ld(&bar[XB_XCNT(j)]); sum += c; cnt += (c > 0u) ? 1u : 0u; mine = (j == x) ? c : mine; }
        if (sum == G) break;
        __builtin_amdgcn_s_sleep(1);
        if ((++sp & 255u) == 0u) { if (xb_ld(&bar[XB_TMO])) break; if (sp > XB_SPIN_CAP) { atomicAdd(&bar[XB_TMO], 1u); break; } }
    }
    nloc = mine > 0u ? mine : 1u; nx = cnt > 0u ? cnt : 1u;
}

__device__ __forceinline__ void xcd_barrier(const XcdBarrier& b) {
    asm volatile("s_waitcnt vmcnt(0)" ::: "memory");
    __syncthreads();
    if (threadIdx.x == 0) {
        unsigned* bar = b.bar;
        __builtin_amdgcn_s_waitcnt(0);
        unsigned nloc = b.st[0], nx = b.st[1];
        if (nloc == 0u) { xcd_barrier_complete(bar, b.x, nloc, nx); b.st[0] = nloc; b.st[1] = nx; }
        const unsigned old = xb_add(&bar[XB_XSUB(b.x)], 1u);
        const unsigned gen = old / nloc;
        if (old + 1u == (gen + 1u) * nloc) {
            __builtin_amdgcn_fence(__ATOMIC_RELEASE, "agent");
            asm volatile("s_waitcnt vmcnt(0)" ::: "memory");
            (void)xb_add(&bar[XB_TOP], 1u);
        }
        XB_SPIN(xb_ld(&bar[XB_TOP]) < (gen + 1u) * nx, bar);
        __builtin_amdgcn_fence(__ATOMIC_ACQUIRE, "agent");
        asm volatile("s_waitcnt vmcnt(0)" ::: "memory");
    }
    __syncthreads();
}
__device__ __forceinline__ float wave_sum(float v) {
#pragma unroll
    for (int o = 1; o < 64; o <<= 1) v += __shfl_xor(v, o);
    return v;
}
__device__ __forceinline__ void p0_transpose_item(const float* W, int K, int N, bf16* WT, int ldt, LAS float* scr, int item, int lane, int gu_half = 0) {
    const int nblk = N / 32, kb = item / nblk, nb = item % nblk, k0 = 64 * kb, n0 = 32 * nb;
    const int d0 = gu_half ? ((n0 < gu_half) ? ((n0 >> 7) * 256 + (n0 & 127)) : (((n0 - gu_half) >> 7) * 256 + 128 + ((n0 - gu_half) & 127))) : n0;
#pragma unroll 8
    for (int i = 0; i < 32; ++i) { const int kk = 2 * i + (lane >> 5); scr[kk * 33 + (lane & 31)] = W[(size_t)(k0 + kk) * N + n0 + (lane & 31)]; }
    LDS_WAIT(); asm volatile("" ::: "memory");
    const int c = lane & 7;
#pragma unroll
    for (int j = 0; j < 4; ++j) { const int n = (lane >> 3) + 8 * j; const LAS float* s = scr + (8 * c) * 33 + n;
        v4u o; o.x = pk2(s[0 * 33], s[1 * 33]); o.y = pk2(s[2 * 33], s[3 * 33]); o.z = pk2(s[4 * 33], s[5 * 33]); o.w = pk2(s[6 * 33], s[7 * 33]);
        *(GAS v4u*)(WT + (size_t)(d0 + n) * ldt + k0 + 8 * c) = o; }
    LDS_WAIT(); asm volatile("" ::: "memory");
}

constexpr int NWAVES = 8;
constexpr int DM = 4096, SEQ = 4096, NTOKP = 8192, NTOKS = 1024, MTOT = 9216, NCOND = 130;
constexpr int NIN = 8704, NPR = 2560  , DFF = 11008, NGU = 22016, NMOD = 24576, DCONV = 2048;
constexpr int PKB = DM + 128;
__device__ __forceinline__ bool i8_panel(int pm) { return pm < 31 && pm != 15; }
constexpr size_t WS_WGU8 = (1037 + 32) * (size_t)(1u << 20), WS_H8 = (1037 + 160) * (size_t)(1u << 20), WS_HS = (1037 + 224) * (size_t)(1u << 20)  , WS_WIN8 = (1037 + 243) * (size_t)(1u << 20)  , WS_HST = (1037 + 285) * (size_t)(1u << 20)  ,
                 WS_WOUT8A = (1037 + 289) * (size_t)(1u << 20)  , WS_MIX8A = 716 * (size_t)(1u << 20)  ;
constexpr int PFB = DFF + 128;
constexpr int PK = DM + 64, PF = DFF + 64;
constexpr int COL_K = 2048, COL_V = 2304, COL_B = 2560, COL_C = 4608, COL_HC = 6656;
constexpr float RMS_EPS = 1e-5f;
constexpr float LOG2E = 1.4426950408889634f;
constexpr size_t O_Y = 0, O_KP = 37748736, O_VP = O_KP + 65536, O_CP = O_VP + 65536, O_FP = O_CP + 8192, O_KS = O_FP + 44032, O_VS = O_KS + 4194304,
                 O_CS = O_VS + 4194304, O_FS = O_CS + 524288, O_END = O_FS + 2818048;
static_assert(O_END == 49662976, "d_out map");
constexpr size_t MiB = 1u << 20;
constexpr size_t WS_CTL = 0, CTL_ZERO_BYTES = 256 * 1024;
constexpr size_t WS_SC = 2 * MiB, WS_MOD = 5 * MiB, WS_WIN = 32 * MiB, WS_WOUT = 102 * MiB, WS_WGU = 135 * MiB, WS_WDN = 310 * MiB, WS_WMOD = 397 * MiB,
                 WS_H = 592 * MiB, WS_PROJ = 666 * MiB, WS_MIX = 819 * MiB, WS_X1 = 893 * MiB, WS_GU = 1037 * MiB, WS_SLAB = 1424 * MiB, WS_END = 1488 * MiB, WS_ACT = 397 * MiB;
static_assert(WS_SC + (size_t)256 * PK * 2 <= WS_MOD && WS_WIN + (size_t)NIN * PK * 2 <= WS_WOUT && WS_WOUT + (size_t)DM * PK * 2 <= WS_WGU && WS_WGU + (size_t)NGU * PK * 2 <= WS_WDN && WS_WDN + (size_t)DM * PF * 2 <= WS_WMOD && WS_WMOD + (size_t)NMOD * PK * 2 <= WS_H &&
              WS_H + (size_t)MTOT * PK * 2 <= WS_PROJ && WS_PROJ + (size_t)MTOT * NIN * 2 <= WS_MIX && WS_MIX + (size_t)MTOT * PK * 2 <= WS_X1 && WS_X1 + (size_t)MTOT * DM * 4 <= WS_GU &&
              WS_GU + (size_t)MTOT * NGU * 2 <= WS_SLAB && WS_ACT + (size_t)MTOT * PF * 2 <= WS_H && WS_MOD + (size_t)256 * NMOD * 4 <= WS_WIN, "d_ws map");
constexpr int CW_CONVQ = 1024  , CW_SCRDY = 1408  , CW_MODRDY = 1472  , CW_XRANK = 2048  , CW_BAR = 4096, CW_TICK = 16384, TICK_WORDS = 8192;
constexpr int RING_OFF = 0, RING_BYTES = 131072;
constexpr int LDSCTL_OFF = RING_BYTES, MISC_OFF = LDSCTL_OFF + 320;
constexpr int HALO_OFF = LDSCTL_OFF + 1024;
constexpr int LDS_BYTES = 147456;

typedef float f32x16 __attribute__((ext_vector_type(16)));
typedef float f32x2_t __attribute__((ext_vector_type(2)));
typedef __bf16 bf16x2_t __attribute__((ext_vector_type(2)));
typedef short s16x4 __attribute__((ext_vector_type(4)));
#define DI __device__ __forceinline__
DI int opaque_tid() { int t_ = threadIdx.x; asm volatile("" : "+v"(t_)); return t_; }
DI unsigned cvtpk(float lo, float hi) { f32x2_t v = {lo, hi}; bf16x2_t b = __builtin_convertvector(v, bf16x2_t); return __builtin_bit_cast(unsigned, b); }
DI float bf_lo(unsigned w) { return __uint_as_float(w << 16); }
DI float bf_hi(unsigned w) { return __uint_as_float(w & 0xffff0000u); }
DI void unpack8(const v4u w, float (&f)[8]) { f[0] = bf_lo(w.x); f[1] = bf_hi(w.x); f[2] = bf_lo(w.y); f[3] = bf_hi(w.y); f[4] = bf_lo(w.z); f[5] = bf_hi(w.z); f[6] = bf_lo(w.w); f[7] = bf_hi(w.w); }
DI v4u pack8(const float (&f)[8]) { v4u w; w.x = cvtpk(f[0], f[1]); w.y = cvtpk(f[2], f[3]); w.z = cvtpk(f[4], f[5]); w.w = cvtpk(f[6], f[7]); return w; }
DI float silu_f(float x) { return x / (1.0f + __expf(-x)); }

struct Frame {
    LAS unsigned char* lds;
    volatile LAS unsigned* MISC;
    gu32* ctl;
    int wave, vcu, G;
};
struct Args { const float* in[20]; float* out; unsigned char* ws; int ph_lo, ph_hi, li, pad; };

struct ConvMat { const float* W; bf16* WT; int K, N, ldt, gu_half; int f8 = 0; unsigned char* WT8 = nullptr; int ldt8 = 0; int c8fp = 0; };
DI int inproj_row(int n) {
    if (n < 2048) return ((n >> 6) << 8) + 128 + ((n >> 4) & 3) * 32 + ((n >> 2) & 3) * 8 + 4 + (n & 3);
    if (n < 2560) return 8192 + (n - 2048);
    const int reg = (n - 2560) >> 11, ch = (n - 2560) & 2047;
    return ((ch >> 6) << 8) + (reg == 2 ? 128 : 0) + ((ch >> 4) & 3) * 32 + ((ch >> 2) & 3) * 8 + (reg == 1 ? 4 : 0) + (ch & 3);
}
DI void tr_load(const ConvMat& m, int item, int lane, float (&v)[32]) {
    const int nblk = m.N / 32, kb = item / nblk, nb = item - kb * nblk;
    const GAS float* p = (const GAS float*)m.W + (size_t)(64 * kb + 32 * (lane >> 5)) * m.N + 32 * nb + (lane & 31);
#pragma unroll
    for (int i = 0; i < 32; ++i) v[i] = __builtin_nontemporal_load(p + (size_t)i * m.N);
}
DI void tr_store(const ConvMat& m, int item, int lane, const float (&v)[32], LAS unsigned* scr) {
    const int nblk = m.N / 32, kb = item / nblk, nb = item - kb * nblk, k0 = 64 * kb, n0 = 32 * nb;
    const int d0 = m.gu_half > 0 ? ((n0 < m.gu_half) ? ((n0 >> 7) * 256 + (n0 & 127)) : (((n0 - m.gu_half) >> 7) * 256 + 128 + ((n0 - m.gu_half) & 127))) : n0;
    LAS unsigned* sw = scr + (lane & 31) * 34 + 16 * (lane >> 5);
#pragma unroll
    for (int ip = 0; ip < 16; ++ip) sw[ip] = cvtpk(v[2 * ip], v[2 * ip + 1]);
    LDS_WAIT(); asm volatile("" ::: "memory");
    const int c = lane & 7;
#pragma unroll
    for (int j = 0; j < 4; ++j) { const int nn = (lane >> 3) + 8 * j; typedef unsigned u32x2 __attribute__((ext_vector_type(2)));
        const LAS u32x2* sp = (const LAS u32x2*)(scr + nn * 34 + 4 * c); const u32x2 x = sp[0], y = sp[1];
        const int drow = m.gu_half < 0 ? inproj_row(n0 + nn) : d0 + nn;
        *(GAS v4u*)(m.WT + (size_t)drow * m.ldt + k0 + 8 * c) = (v4u){x.x, x.y, y.x, y.y}; }
    LDS_WAIT(); asm volatile("" ::: "memory");
}
DI unsigned pack_fp8x4(float a, float b, float c, float d) {
    int w = 0;
    w = __builtin_amdgcn_cvt_pk_fp8_f32(__builtin_amdgcn_fmed3f(a, -448.0f, 448.0f), __builtin_amdgcn_fmed3f(b, -448.0f, 448.0f), w, false);
    w = __builtin_amdgcn_cvt_pk_fp8_f32(__builtin_amdgcn_fmed3f(c, -448.0f, 448.0f), __builtin_amdgcn_fmed3f(d, -448.0f, 448.0f), w, true);
    return (unsigned)w;
}
DI unsigned pack_i8x4(float a, float b, float c, float d) {
    const int ia = (int)__builtin_rintf(__builtin_amdgcn_fmed3f(a, -127.0f, 127.0f)), ib = (int)__builtin_rintf(__builtin_amdgcn_fmed3f(b, -127.0f, 127.0f));
    const int ic = (int)__builtin_rintf(__builtin_amdgcn_fmed3f(c, -127.0f, 127.0f)), id = (int)__builtin_rintf(__builtin_amdgcn_fmed3f(d, -127.0f, 127.0f));
    return ((unsigned)ia & 255u) | (((unsigned)ib & 255u) << 8) | (((unsigned)ic & 255u) << 16) | ((unsigned)id << 24);
}
DI void tr_store_f8(const ConvMat& m, int item, int lane, const float (&v)[32], LAS unsigned* scr) {
    const int nblk = m.N / 32, kb = item / nblk, nb = item - kb * nblk, k0 = 64 * kb, n0 = 32 * nb;
    const int d0 = m.gu_half > 0 ? ((n0 < m.gu_half) ? ((n0 >> 7) * 256 + (n0 & 127)) : (((n0 - m.gu_half) >> 7) * 256 + 128 + ((n0 - m.gu_half) & 127))) : n0;
    GAS unsigned char* dst = m.WT8 ? (GAS unsigned char*)m.WT8 : (GAS unsigned char*)m.WT; const int ld_ = m.WT8 ? m.ldt8 : m.ldt;
    LAS unsigned* sw = scr + (lane & 31) * 20 + 8 * (lane >> 5);
    const float S_ = m.WT8 ? (m.c8fp ? pg8::WOUT_PRESCALE : pg8::WGU_I8SCALE) : pg8::WDN_PRESCALE; const bool i8c_ = m.WT8 && !m.c8fp;
#pragma unroll
    for (int q = 0; q < 8; ++q) sw[q] = i8c_ ? pack_i8x4(v[4 * q] * S_, v[4 * q + 1] * S_, v[4 * q + 2] * S_, v[4 * q + 3] * S_) : pack_fp8x4(v[4 * q] * S_, v[4 * q + 1] * S_, v[4 * q + 2] * S_, v[4 * q + 3] * S_);
    LDS_WAIT(); asm volatile("" ::: "memory");
#pragma unroll
    for (int j = 0; j < 2; ++j) { const int p_ = lane + 64 * j, nn = p_ >> 2, c = p_ & 3;
        const v4u x = *(const LAS v4u*)(scr + nn * 20 + 4 * c);
        const int drow = m.gu_half < 0 ? inproj_row(n0 + nn) : d0 + nn;
        *(GAS v4u*)(dst + (size_t)drow * ld_ + k0 + 16 * c) = x; }
    LDS_WAIT(); asm volatile("" ::: "memory");
}
constexpr int I_IN = (DM / 64) * (NIN / 32), I_OUT = (DM / 64) * (DM / 32), I_GU = (DM / 64) * (NGU / 32), I_DN = (DFF / 64) * (DM / 32);
constexpr int I_DN_P5 = 0;
constexpr int I_END0 = I_IN, I_END1 = I_IN + I_OUT, I_END2 = I_END1 + I_GU, I_END3 = I_END2 + I_DN;
DI ConvMat conv_mat(const Args& a, int& item) {
    unsigned char* ws = a.ws;
    const float* w0_ = a.in[12]; const float* w1_ = a.in[15]; const float* w2_ = a.in[16]; const float* w3_ = a.in[18];
    asm volatile("" : "+s"(w0_), "+s"(w1_), "+s"(w2_), "+s"(w3_));
    if (item < I_END0) return ConvMat{w0_, (bf16*)(ws + WS_WIN), DM, NIN, PK, -1, 0, ws + WS_WIN8, PKB};
    if (item < I_END1) { item -= I_END0; return ConvMat{w1_, (bf16*)(ws + WS_WOUT), DM, DM, PK, 0, 0, ws + WS_WOUT8A, 2 * PK, 1}; }
    if (item < I_END2) { item -= I_END1; return ConvMat{w2_, (bf16*)(ws + WS_WGU), DM, NGU, PK, DFF, 0, ws + WS_WGU8, PKB}; }
    item -= I_END2; return ConvMat{w3_, (bf16*)(ws + WS_WDN), DFF, DM, PFB, 0, 1};
}
struct PairRegs { float a[32], b[32]; };
DI void pair_load(const Args& a, int it, int hi, int lane, PairRegs& r) {
    int ia = it, ib = (it + 1 < hi) ? it + 1 : it;
    const ConvMat ma = conv_mat(a, ia), mb = conv_mat(a, ib);
    tr_load(ma, ia, lane, r.a); tr_load(mb, ib, lane, r.b);
}
DI void pair_store(const Args& a, int it, int hi, int lane, const PairRegs& r, LAS unsigned* scrA, LAS unsigned* scrB) {
    int ia = it, ib = it + 1; const bool hasb = ib < hi; if (!hasb) ib = it;
    const ConvMat ma = conv_mat(a, ia), mb = conv_mat(a, ib);
    if (ma.f8) tr_store_f8(ma, ia, lane, r.a, scrA); else { tr_store(ma, ia, lane, r.a, scrA); if (ma.WT8) tr_store_f8(ma, ia, lane, r.a, scrA); }
    if (hasb) { if (mb.f8) tr_store_f8(mb, ib, lane, r.b, scrB); else { tr_store(mb, ib, lane, r.b, scrB); if (mb.WT8) tr_store_f8(mb, ib, lane, r.b, scrB); } }
}
DI void convert_range(const Args& a, LAS unsigned char* lds_wave  , int lo, int hi, int w, int nw) {
    LAS unsigned* scrA = (LAS unsigned*)lds_wave; LAS unsigned* scrB = scrA + 32 * 34;
    int it = lo + 2 * w; if (it >= hi) return;
    const int lane = opaque_tid() & 63;
    PairRegs p0, p1;
    pair_load(a, it, hi, lane, p0);
    for (;;) {
        int nx = it + 2 * nw; bool more = nx < hi;
        pair_load(a, more ? nx : it, hi, lane, p1); __builtin_amdgcn_sched_barrier(0);
        pair_store(a, it, hi, lane, p0, scrA, scrB);
        if (!more) break;
        it = nx; nx = it + 2 * nw; more = nx < hi;
        pair_load(a, more ? nx : it, hi, lane, p0); __builtin_amdgcn_sched_barrier(0);
        pair_store(a, it, hi, lane, p1, scrA, scrB);
        if (!more) break;
        it = nx;
    }
}
DI unsigned cq_claim_n(unsigned* head, int lane, unsigned n) { unsigned t = 0u; if (lane == 0) t = __hip_atomic_fetch_add(head, n, __ATOMIC_RELAXED, __HIP_MEMORY_SCOPE_AGENT); return t; }
DI unsigned cq_claim(unsigned* head, int lane) { unsigned t = 0u; if (lane == 0) t = __hip_atomic_fetch_add(head, 8u, __ATOMIC_RELAXED, __HIP_MEMORY_SCOPE_AGENT); return t; }
DI void convert_queue(const Args& a, LAS unsigned char* lds_wave, int lo, int hi, unsigned* head) {
    LAS unsigned* scrA = (LAS unsigned*)lds_wave; LAS unsigned* scrB = scrA + 32 * 34;
    const int lane = opaque_tid() & 63;
    int base = lo + __builtin_amdgcn_readfirstlane((int)cq_claim(head, lane));
    if (base >= hi) return;
    unsigned pend = cq_claim(head, lane);
    int q = 0;
#define CQ_ADVANCE(vb, vq, ok) do { ok = true; if (vq < 3 && vb + 2 * (vq + 1) < hi) { vq = vq + 1; } else { vb = lo + __builtin_amdgcn_readfirstlane((int)pend); vq = 0; ok = vb < hi; if (ok) pend = cq_claim(head, lane); } } while (0)
    PairRegs p0, p1;
    pair_load(a, base, hi, lane, p0);
    for (;;) {
        int nb_ = base, nq_ = q; bool ok; CQ_ADVANCE(nb_, nq_, ok);
        pair_load(a, ok ? nb_ + 2 * nq_ : base + 2 * q, hi, lane, p1); __builtin_amdgcn_sched_barrier(0);
        pair_store(a, base + 2 * q, hi, lane, p0, scrA, scrB);
        if (!ok) break;
        base = nb_; q = nq_; CQ_ADVANCE(nb_, nq_, ok);
        pair_load(a, ok ? nb_ + 2 * nq_ : base + 2 * q, hi, lane, p0); __builtin_amdgcn_sched_barrier(0);
        pair_store(a, base + 2 * q, hi, lane, p1, scrA, scrB);
        if (!ok) break;
        base = nb_; q = nq_;
    }
#undef CQ_ADVANCE
}
DI void p0_prologue(Frame& F, const Args& a) {
    const int lane_ = opaque_tid() & 63;
    const int gw = F.vcu * NWAVES + F.wave, NGW = F.G * NWAVES;
    unsigned char* ws = a.ws;
    bf16* SC = (bf16*)(ws + WS_SC);
    for (int m = gw; m < 256; m += NGW) {
        const float* crow_ = m < 2 ? a.in[6] + (size_t)m * DM : a.in[7] + (size_t)(m - 2) * DM;
        unsigned long long* o8 = (unsigned long long*)(SC + (size_t)m * PK) + lane_;
        f32x4 cv_[16];
#pragma unroll
        for (int j = 0; j < 16; ++j) cv_[j] = (m < NCOND) ? ((const GAS f32x4*)crow_)[lane_ + 64 * j] : (f32x4){0.f, 0.f, 0.f, 0.f};
        __builtin_amdgcn_sched_barrier(0);
#pragma unroll
        for (int j = 0; j < 16; ++j) { const f32x4 v = cv_[j];
            __hip_atomic_store(o8 + 64 * j, (m < NCOND) ? ((unsigned long long)cvtpk(silu_f(v.x), silu_f(v.y)) | ((unsigned long long)cvtpk(silu_f(v.z), silu_f(v.w)) << 32)) : 0ull, __ATOMIC_RELAXED, __HIP_MEMORY_SCOPE_AGENT); }
        asm volatile("s_waitcnt vmcnt(0)" ::: "memory");
        if (lane_ == 0) (void)__hip_atomic_fetch_add((unsigned*)(F.ctl + CW_SCRDY), 1u, __ATOMIC_RELAXED, __HIP_MEMORY_SCOPE_AGENT);
    }
    convert_range(a, F.lds + RING_OFF + F.wave * 16384, 0, I_END0, gw, NGW);
}

DI void row_load(const float* xrow, int lane, f32x4 (&v)[16]) {
    const GAS f32x4* xr = (const GAS f32x4*)xrow + lane;
#pragma unroll
    for (int j = 0; j < 16; ++j) v[j] = xr[64 * j];
}
DI void row_load_bf16(const bf16* xrow, int lane, f32x4 (&v)[16]) {
    const GAS unsigned long long* xr = (const GAS unsigned long long*)xrow + lane;
#pragma unroll
    for (int j = 0; j < 16; ++j) { const unsigned long long w = xr[64 * j]; v[j] = (f32x4){bf_lo((unsigned)w), bf_hi((unsigned)w), bf_lo((unsigned)(w >> 32)), bf_hi((unsigned)(w >> 32))}; }
}
DI float row_rstd(const f32x4 (&v)[16]) {
    float s = 0.f;
#pragma unroll
    for (int j = 0; j < 16; ++j) s += (v[j].x * v[j].x + v[j].y * v[j].y) + (v[j].z * v[j].z + v[j].w * v[j].w);
    return 1.0f / sqrtf(wave_sum(s) * (1.0f / DM) + RMS_EPS);
}
DI void row_store_mod_bf16(f32x4 (&v)[16], float rstd, const float* g, const float* shift, const float* scale, bf16* orow, int lane, unsigned char* orow8 = nullptr, float* hs = nullptr, bf16* orowx = nullptr  ) {
    GAS unsigned long long* o8 = (GAS unsigned long long*)orow + lane; GAS unsigned* o4 = (GAS unsigned*)orow8 + lane;
    const bool i8 = orow8 != nullptr; float mx = 0.f;
#pragma unroll
    for (int j0 = 0; j0 < 16; j0 += 4) {
        f32x4 gg[4], sc[4], sh[4];
#pragma unroll
        for (int j = 0; j < 4; ++j) { gg[j] = ((const GAS f32x4*)g)[lane + 64 * (j0 + j)]; sc[j] = ((const GAS f32x4*)scale)[lane + 64 * (j0 + j)]; sh[j] = ((const GAS f32x4*)shift)[lane + 64 * (j0 + j)]; }
        __builtin_amdgcn_sched_barrier(0);
#pragma unroll
        for (int j = 0; j < 4; ++j) { const f32x4 o = (v[j0 + j] * rstd) * gg[j] * (sc[j] + 1.0f) + sh[j]; v[j0 + j] = o;
            mx = fmaxf(fmaxf(mx, fmaxf(fabsf(o.x), fabsf(o.y))), fmaxf(fabsf(o.z), fabsf(o.w))); }
        __builtin_amdgcn_sched_barrier(0);
    }
    if (i8) {
#pragma unroll
        for (int d = 32; d >= 1; d >>= 1) mx = fmaxf(mx, __shfl_xor(mx, d));
        const float inv = mx > 0.f ? 127.0f / mx : 0.f;
        if (lane == 0) *hs = mx * (1.0f / 127.0f);
#pragma unroll
        for (int j = 0; j < 16; ++j) o4[64 * j] = pack_i8x4(v[j].x * inv, v[j].y * inv, v[j].z * inv, v[j].w * inv);
        if (orowx) { GAS unsigned long long* ox = (GAS unsigned long long*)orowx + lane;
#pragma unroll
            for (int j = 0; j < 16; ++j) ox[64 * j] = (unsigned long long)cvtpk(v[j].x, v[j].y) | ((unsigned long long)cvtpk(v[j].z, v[j].w) << 32); }
    } else {
#pragma unroll
        for (int j = 0; j < 16; ++j) o8[64 * j] = (unsigned long long)cvtpk(v[j].x, v[j].y) | ((unsigned long long)cvtpk(v[j].z, v[j].w) << 32);
    }
}
DI int cond_of_row(int row) { return row < NTOKP ? (row >> 12) : 2 + ((row - NTOKP) >> 3); }
template <int SRC, int SLOT> DI void norm_mod_phase(const Args& a, const bf16* X1, const float* MOD, const float* g, bf16* H, int gw, int NGW, int lane, unsigned char* H8 = nullptr  , float* HS = nullptr  , bf16* HST = nullptr) {
    auto ldrow = [&](int m, f32x4 (&v)[16]) { if (SRC == 1) row_load_bf16(X1 + (size_t)m * DM, lane, v); else row_load(m < NTOKP ? a.in[0] + (size_t)m * DM : a.in[1] + (size_t)(m - NTOKP) * DM, lane, v); };
    f32x4 cur[16], nxt[16];
    int m = gw; if (m >= MTOT) return;
    ldrow(m, cur);
    for (;;) {
        const int mn = m + NGW; const bool more = mn < MTOT;
        ldrow(more ? mn : m, nxt);
        const float rstd = row_rstd(cur);
        const float* mod = MOD + (size_t)cond_of_row(m) * NMOD;
        { const int pm_ = m >> 8; const bool q8_ = H8 && (SRC == 1 ? (pm_ != 15 && pm_ != 31) : i8_panel(pm_));
          bf16* ox_ = (SRC == 1 && HST && m >= NTOKP && ((m & 7) >= 6)) ? HST + (size_t)(2 * ((m - NTOKP) >> 3) + ((m & 7) - 6)) * PK : nullptr;
          row_store_mod_bf16(cur, rstd, g, mod + SLOT * DM, mod + (SLOT + 1) * DM, H + (size_t)m * PK, lane, q8_ ? H8 + (size_t)m * PKB : nullptr, HS ? HS + m : nullptr, ox_); }
        if (!more) break;
#pragma unroll
        for (int j = 0; j < 16; ++j) cur[j] = nxt[j];
        m = mn;
    }
}
DI void final_norm_phase(const bf16* X2, float* Y, const float* g, int gw, int NGW, int lane) {
    f32x4 cur[16], nxt[16];
    int m = gw; if (m >= MTOT) return;
    row_load_bf16(X2 + (size_t)m * DM, lane, cur);
    for (;;) {
        const int mn = m + NGW; const bool more = mn < MTOT;
        row_load_bf16(X2 + (size_t)(more ? mn : m) * DM, lane, nxt);
        const float rstd = row_rstd(cur);
        GAS f32x4* xr = (GAS f32x4*)(Y + (size_t)m * DM) + lane;
#pragma unroll
        for (int j0 = 0; j0 < 16; j0 += 8) {
            f32x4 gg[8];
#pragma unroll
            for (int j = 0; j < 8; ++j) gg[j] = ((const GAS f32x4*)g)[lane + 64 * (j0 + j)];
            __builtin_amdgcn_sched_barrier(0);
#pragma unroll
            for (int j = 0; j < 8; ++j) xr[64 * (j0 + j)] = (cur[j0 + j] * rstd) * gg[j];
            __builtin_amdgcn_sched_barrier(0);
        }
        if (!more) break;
#pragma unroll
        for (int j = 0; j < 16; ++j) cur[j] = nxt[j];
        m = mn;
    }
}

namespace att {
constexpr int KROW = 72, VROW = 260;
constexpr int VT_OFF = 256 * KROW * 2;
constexpr float C2 = 0.125f * LOG2E;
DI int crow(int i, int h) { return (i & 3) + 8 * (i >> 2) + 4 * h; }
#define ATT_MFMA(a, b, c) __builtin_amdgcn_mfma_f32_32x32x16_bf16((a), (b), (c), 0, 0, 0)
template <bool GENERIC> DI float softmax5(f32x16 (&sc)[5], int kb0, int jmin, int jmax, float sink2, int h, bf16x8 (&pf)[5][2]) {
    float mx = -INFINITY;
#pragma unroll
    for (int b = 0; b < 5; ++b)
#pragma unroll
        for (int i = 0; i < 16; ++i) { const int j = 32 * (kb0 + b) + crow(i, h);
            if (GENERIC) { if (!(j >= jmin && j <= jmax)) sc[b][i] = -INFINITY; }
            else { if (b == 0) { if (j < jmin) sc[b][i] = -INFINITY; } if (b == 4) { if (j > jmax) sc[b][i] = -INFINITY; } }
            mx = fmaxf(mx, sc[b][i]); }
    mx = fmaxf(mx, __shfl_xor(mx, 32));
    const float m2 = fmaxf(mx * C2, sink2);
    float sum = 0.f;
#pragma unroll
    for (int b = 0; b < 5; ++b)
#pragma unroll
        for (int i = 0; i < 16; ++i) { const float p = __builtin_amdgcn_exp2f(__builtin_fmaf(sc[b][i], C2, -m2)); sc[b][i] = p; sum += p; }
    sum += __shfl_xor(sum, 32); sum += __builtin_amdgcn_exp2f(sink2 - m2);
#pragma unroll
    for (int b = 0; b < 5; ++b)
#pragma unroll
        for (int s = 0; s < 2; ++s) { v4u w; w.x = cvtpk(sc[b][8 * s], sc[b][8 * s + 1]); w.y = cvtpk(sc[b][8 * s + 2], sc[b][8 * s + 3]);
            w.z = cvtpk(sc[b][8 * s + 4], sc[b][8 * s + 5]); w.w = cvtpk(sc[b][8 * s + 6], sc[b][8 * s + 7]); pf[b][s] = __builtin_bit_cast(bf16x8, w); }
    return 1.0f / sum;
}
DI void store_o(const f32x16& o, unsigned char* orow, int dblk, int h) {
    constexpr float S_ = pg8::ATT_PRESCALE;
#pragma unroll
    for (int g = 0; g < 4; ++g) *(GAS unsigned*)(orow + 32 * dblk + 8 * g + 4 * h) = pack_fp8x4(o[4 * g] * S_, o[4 * g + 1] * S_, o[4 * g + 2] * S_, o[4 * g + 3] * S_);
}
DI void q_load(const bf16* qp, int h, bf16x8 (&qf)[4]) {
#pragma unroll
    for (int d0 = 0; d0 < 4; ++d0) qf[d0] = *(const GAS bf16x8*)(qp + 16 * d0 + 8 * h);
}
template <int VR, bool GENERIC> DI void lds_chunk(const LAS bf16* Kl, const LAS bf16* Vt, int kb0, int jmin, int jmax, float sink2, const bf16x8 (&qf)[4], unsigned char* op, int r, int h) {
    const f32x16 zero = {};
    f32x16 sc[5];
#pragma unroll
    for (int b = 0; b < 5; ++b) {
        const LAS bf16* kp = Kl + ((kb0 + b) * 32 + r) * KROW + 8 * h;
#pragma unroll
        for (int d0 = 0; d0 < 4; ++d0) { const bf16x8 a = *(const LAS bf16x8*)(kp + 16 * d0); sc[b] = ATT_MFMA(a, qf[d0], d0 == 0 ? zero : sc[b]); }
    }
    bf16x8 pf[5][2];
    const float inv = softmax5<GENERIC>(sc, kb0, jmin, jmax, sink2, h, pf);
#pragma unroll
    for (int dblk = 0; dblk < 2; ++dblk) {
        f32x16 o = zero;
#pragma unroll
        for (int b = 0; b < 5; ++b)
#pragma unroll
            for (int s = 0; s < 2; ++s) {
                const LAS bf16* vp = Vt + (dblk * 32 + r) * VR + (kb0 + b) * 32 + 16 * s + 4 * h;
                const s16x4 lo = *(const LAS s16x4*)vp, hi = *(const LAS s16x4*)(vp + 8);
                const bf16x8 a = __builtin_shufflevector(lo, hi, 0, 1, 2, 3, 4, 5, 6, 7);
                o = ATT_MFMA(a, pf[b][s], o);
            }
        o = o * inv;
        store_o(o, op, dblk, h);
    }
}
DI void vt_scatter(LAS bf16* vd, int VR, const v4u vvv) {
    vd[0 * VR] = (bf16)(vvv.x & 0xffffu); vd[1 * VR] = (bf16)(vvv.x >> 16); vd[2 * VR] = (bf16)(vvv.y & 0xffffu); vd[3 * VR] = (bf16)(vvv.y >> 16);
    vd[4 * VR] = (bf16)(vvv.z & 0xffffu); vd[5 * VR] = (bf16)(vvv.z >> 16); vd[6 * VR] = (bf16)(vvv.w & 0xffffu); vd[7 * VR] = (bf16)(vvv.w >> 16);
}
DI void prompt_unit(LAS unsigned char* lds, const bf16* PROJ, unsigned char* MIX, const float* sinks, int n, int blk, int kv, int tid) {
    const int lane = tid & 63, w = __builtin_amdgcn_readfirstlane(tid >> 6), r = lane & 31, h = lane >> 5;
    LAS bf16* Kl = (LAS bf16*)lds; LAS bf16* Vt = (LAS bf16*)(lds + VT_OFF);
    v4u kst[4], vst[4];
#pragma unroll
    for (int i = 0; i < 4; ++i) {
        const int c = tid + 512 * i, key = c >> 3, ch = c & 7, kpos = blk * 128 - 128 + key;
        const bf16* src = PROJ + (size_t)(n * SEQ + (kpos < 0 ? 0 : kpos)) * NPR + kv * 64 + ch * 8; kst[i] = *(const GAS v4u*)(src + COL_K); vst[i] = *(const GAS v4u*)(src + COL_V);
    }
    __builtin_amdgcn_sched_barrier(0);
#pragma unroll
    for (int i = 0; i < 4; ++i) {
        const int c = tid + 512 * i, key = c >> 3, ch = c & 7, kpos = blk * 128 - 128 + key;
        const v4u z = (v4u){0u, 0u, 0u, 0u};
        *(LAS v4u*)(Kl + key * KROW + ch * 8) = kpos < 0 ? z : kst[i];
        vt_scatter(Vt + (ch * 8) * VROW + key, VROW, kpos < 0 ? z : vst[i]);
    }
    const int hq = kv * 8 + w; const float sink2 = sinks[hq] * LOG2E;
    const bf16* qbase = PROJ + (size_t)(n * SEQ + blk * 128 + r) * NPR + hq * 64;
    unsigned char* obase = MIX + (size_t)(n * SEQ + blk * 128 + r) * (2 * PK) + hq * 64;
    bf16x8 qc[4], qn[4];
    q_load(qbase, h, qn);
    __syncthreads();
#pragma unroll 1
    for (int c = 0; c < 4; ++c) {
#pragma unroll
        for (int d0 = 0; d0 < 4; ++d0) qc[d0] = qn[d0];
        q_load(qbase + (size_t)(32 * ((c + 1) & 3)) * NPR, h, qn);
        const int qi = 32 * c + r;
        if (blk == 0) lds_chunk<VROW, true>(Kl, Vt, c, 128, qi + 128, sink2, qc, obase + (size_t)(32 * c) * (2 * PK), r, h);
        else lds_chunk<VROW, false>(Kl, Vt, c, qi, qi + 128, sink2, qc, obase + (size_t)(32 * c) * (2 * PK), r, h);
    }
    __syncthreads();
}
constexpr int KS_BYTES = 160 * KROW * 2, VROW_S = 172, VS_OFF = 2 * KS_BYTES, VS_BYTES = 64 * VROW_S * 2;
DI void sample_unit(LAS unsigned char* lds, const bf16* PROJ, const float* ck, const float* cv, unsigned char* MIX, const float* sinks, int s, int kp, int tid) {
    const int lane = tid & 63, w = __builtin_amdgcn_readfirstlane(tid >> 6), r = lane & 31, h = lane >> 5;
    f32x4 kf[5][2], vf[5][2]; v4u kb_[5], vb_[5];
#pragma unroll
    for (int i = 0; i < 5; ++i) {
        const int c = tid + 512 * i, kvl = c / 1280, rem = c - kvl * 1280, key = rem >> 3, ch = rem & 7, kv = kp * 2 + kvl;
        const size_t o = ((size_t)(s * 128 + (key < 128 ? key : 127)) * 4 + kv) * 64 + ch * 8;
        kf[i][0] = *(const GAS f32x4*)(ck + o); kf[i][1] = *(const GAS f32x4*)(ck + o + 4); vf[i][0] = *(const GAS f32x4*)(cv + o); vf[i][1] = *(const GAS f32x4*)(cv + o + 4);
        if (i == 2 || i == 4) { const int nk = (key >= 128 && key < 136) ? key - 128 : 0;     const bf16* src = PROJ + (size_t)(NTOKP + s * 8 + nk) * NPR + kv * 64 + ch * 8; kb_[i] = *(const GAS v4u*)(src + COL_K); vb_[i] = *(const GAS v4u*)(src + COL_V); }
    }
    __builtin_amdgcn_sched_barrier(0);
#pragma unroll
    for (int i = 0; i < 5; ++i) {
        const int c = tid + 512 * i, kvl = c / 1280, rem = c - kvl * 1280, key = rem >> 3, ch = rem & 7;
        v4u kvv = (v4u){cvtpk(kf[i][0].x, kf[i][0].y), cvtpk(kf[i][0].z, kf[i][0].w), cvtpk(kf[i][1].x, kf[i][1].y), cvtpk(kf[i][1].z, kf[i][1].w)};
        v4u vvv = (v4u){cvtpk(vf[i][0].x, vf[i][0].y), cvtpk(vf[i][0].z, vf[i][0].w), cvtpk(vf[i][1].x, vf[i][1].y), cvtpk(vf[i][1].z, vf[i][1].w)};
        if (i == 2 || i == 4) { const v4u z = (v4u){0u, 0u, 0u, 0u}; kvv = key < 128 ? kvv : (key < 136 ? kb_[i] : z); vvv = key < 128 ? vvv : (key < 136 ? vb_[i] : z); }
        *(LAS v4u*)((LAS bf16*)(lds + kvl * KS_BYTES) + key * KROW + ch * 8) = kvv;
        vt_scatter((LAS bf16*)(lds + VS_OFF + kvl * VS_BYTES) + (ch * 8) * VROW_S + key, VROW_S, vvv);
    }
    const int kvl_ = (w >> 1) & 1, c_ = w & 1, kv_ = kp * 2 + kvl_, rho_ = 32 * c_ + r, g_ = rho_ >> 3, t_ = rho_ & 7, hq_ = kv_ * 8 + g_;
    const size_t qrow_ = (size_t)(NTOKP + s * 8 + t_);
    bf16x8 qf[4]; q_load(PROJ + qrow_ * NPR + hq_ * 64, h, qf);
    const float sink2_ = sinks[hq_] * LOG2E;
    __syncthreads();
    if (w < 4) lds_chunk<VROW_S, false>((const LAS bf16*)(lds + kvl_ * KS_BYTES), (const LAS bf16*)(lds + VS_OFF + kvl_ * VS_BYTES), 0, t_, 128 + t_, sink2_, qf, MIX + qrow_ * (2 * PK) + hq_ * 64, r, h);
    __syncthreads();
}
}

DI void convfix_item(const Args& a, const float* SB2, bf16* MIX, int ti, int cg, int lane) {
    const int pm = 1 + ti + (ti >= 15 ? 1 : 0), ch = cg * 512 + lane * 8;
    const float* cw = a.in[13];
    const float* cur = SB2 + (size_t)pm * 6 * DCONV + ch; const float* prv = SB2 + (size_t)(pm - 1) * 6 * DCONV + ch;
    float o0[8], o1[8];
#pragma unroll
    for (int e = 0; e < 8; ++e) {
        const float w0 = cw[ch + e], w1 = cw[DCONV + ch + e], w2 = cw[2 * DCONV + ch + e];
        const float um2 = prv[4 * DCONV + e], um1 = prv[5 * DCONV + e], u0 = cur[e], u1 = cur[DCONV + e], b0 = cur[2 * DCONV + e], b1 = cur[3 * DCONV + e];
        o0[e] = b0 * (w0 * um2 + w1 * um1 + w2 * u0); o1[e] = b1 * (w0 * um1 + w1 * u0 + w2 * u1);
    }
    *(GAS v4u*)(MIX + (size_t)(pm * 256) * PK + DCONV + ch) = pack8(o0);
    *(GAS v4u*)(MIX + (size_t)(pm * 256 + 1) * PK + DCONV + ch) = pack8(o1);
}
DI void kvcopy_queue(const Args& a, unsigned* head) {
    const int lane = opaque_tid() & 63;
    for (;;) {
        const int base = __builtin_amdgcn_readfirstlane((int)cq_claim_n(head, lane, 32u));
        if (base >= 30720) break;
#pragma unroll 1
        for (int q0 = 0; q0 < 32; q0 += 8) {
            f32x4 v[8]; float* dst[8];
#pragma unroll
            for (int q = 0; q < 8; ++q) { const int r = base + q0 + q, tsr = r / 15360, rr = r - tsr * 15360, s_ = rr / 120, i = rr - s_ * 120;
                v[q] = ((const GAS f32x4*)((tsr ? a.in[3] : a.in[2]) + (size_t)(s_ * 128 + i + 8) * 256))[lane];
                dst[q] = a.out + (tsr ? O_VS : O_KS) + (size_t)(s_ * 128 + i) * 256; }
            __builtin_amdgcn_sched_barrier(0);
#pragma unroll
            for (int q = 0; q < 8; ++q) ((GAS f32x4*)dst[q])[lane] = v[q];
        }
    }
}
DI void kvstate_item4(const Args& a, const bf16* PROJ, int it, int lane) {
    unsigned long long vb_[4]; float* dst[4];
#pragma unroll
    for (int q = 0; q < 4; ++q) {
        const bf16* sb_;
        if (it < 128) { const int tsr = it >> 6, n = (it >> 5) & 1, i = 4 * (it & 31) + q;
            sb_ = PROJ + (size_t)(n * SEQ + SEQ - 128 + i) * NPR + (tsr ? COL_V : COL_K); dst[q] = a.out + (tsr ? O_VP : O_KP) + (size_t)(n * 128 + i) * 256; }
        else { const int j = it - 128, tsr = j >> 8, s_ = (j >> 1) & 127, i = 4 * (j & 1) + q;
            sb_ = PROJ + (size_t)(NTOKP + s_ * 8 + i) * NPR + (tsr ? COL_V : COL_K); dst[q] = a.out + (tsr ? O_VS : O_KS) + (size_t)(s_ * 128 + 120 + i) * 256; }
        vb_[q] = ((const GAS unsigned long long*)sb_)[lane];
    }
    __builtin_amdgcn_sched_barrier(0);
#pragma unroll
    for (int q = 0; q < 4; ++q) { const unsigned long long w = vb_[q];
        ((GAS f32x4*)dst[q])[lane] = (f32x4){bf_lo((unsigned)w), bf_hi((unsigned)w), bf_lo((unsigned)(w >> 32)), bf_hi((unsigned)(w >> 32))}; }
}
DI void fixup_item(const Args& a, const float* SB, unsigned char* ACT, int ti, int cg, int lane) {
    const int pm = 1 + ti + (ti >= 15 ? 1 : 0), ch = cg * 512 + lane * 8;
    if (ch >= DFF) return;
    const float* cw = a.in[17];
    const float* cur = SB + (size_t)pm * 6 * DFF + ch; const float* prv = SB + (size_t)(pm - 1) * 6 * DFF + ch;
    float o0[8], o1[8];
#pragma unroll
    for (int e = 0; e < 8; ++e) {
        const float w0 = cw[ch + e], w1 = cw[DFF + ch + e], w2 = cw[2 * DFF + ch + e];
        const float gm2 = prv[4 * DFF + e], gm1 = prv[5 * DFF + e], g0 = cur[e], g1 = cur[DFF + e], u0 = cur[2 * DFF + e], u1 = cur[3 * DFF + e];
        o0[e] = silu_f(w0 * gm2 + w1 * gm1 + w2 * g0) * u0; o1[e] = silu_f(w0 * gm1 + w1 * g0 + w2 * g1) * u1;
    }
    constexpr float S_ = pg8::ACT_PRESCALE; typedef unsigned u32x2_ __attribute__((ext_vector_type(2)));
    *(GAS u32x2_*)(ACT + (size_t)(pm * 256) * PFB + ch) = (u32x2_){pack_fp8x4(o0[0] * S_, o0[1] * S_, o0[2] * S_, o0[3] * S_), pack_fp8x4(o0[4] * S_, o0[5] * S_, o0[6] * S_, o0[7] * S_)};
    *(GAS u32x2_*)(ACT + (size_t)(pm * 256 + 1) * PFB + ch) = (u32x2_){pack_fp8x4(o1[0] * S_, o1[1] * S_, o1[2] * S_, o1[3] * S_), pack_fp8x4(o1[4] * S_, o1[5] * S_, o1[6] * S_, o1[7] * S_)};
}
typedef float f32x2v __attribute__((ext_vector_type(2)));
constexpr int MODA_ROW = 144  , MODA_SLOT = 144 * MODA_ROW;
template <bool ACTIVE> DI void mod_phase_wave(const Args& a, const bf16* SC, float* MOD, LAS unsigned char* lds, int nb, int tid, unsigned* rdy  ) {
    const int lane = tid & 63, c = lane & 15, kq = lane >> 4;
    constexpr int NAP = ACTIVE ? 1 : 4;
    unsigned asrc[NAP], adst[NAP];
#pragma unroll
    for (int i = 0; i < NAP; ++i) { int p_ = (tid - 192) + 320 * i; p_ = p_ < 0 ? 0 : (p_ > 1151 ? 1151 : p_); asrc[i] = (unsigned)((p_ >> 3) * PK + (p_ & 7) * 8) * 2u; adst[i] = (unsigned)((p_ >> 3) * MODA_ROW + (p_ & 7) * 16); }
    const GAS char* scb = (const GAS char*)SC;
    const int n0 = nb * 32;
    const GAS char* wb = (const GAS char*)(a.in[8] + n0);
    const unsigned woff = (unsigned)((8 * kq) * NMOD + 2 * c) * 4u;
    const unsigned aoff = (unsigned)(c * MODA_ROW + 16 * kq);
    f32x4 acc[9][2];
#pragma unroll
    for (int mb = 0; mb < 9; ++mb) { acc[mb][0] = (f32x4){0.f, 0.f, 0.f, 0.f}; acc[mb][1] = (f32x4){0.f, 0.f, 0.f, 0.f}; }
    v4u ap[3][NAP]; f32x2v br[3][2][8];
#define MOD_ISSUE(slot, q) do { if (!ACTIVE) { _Pragma("unroll") for (int i = 0; i < NAP; ++i) ap[slot][i] = *(const GAS v4u*)(scb + (size_t)(q) * 128 + asrc[i]); } \
        if (ACTIVE) { _Pragma("unroll") for (int ks = 0; ks < 2; ++ks) { const GAS char* p_ = wb + (size_t)((q) * 2 + ks) * 32 * NMOD * 4; \
            _Pragma("unroll") for (int j = 0; j < 8; ++j) br[slot][ks][j] = __builtin_nontemporal_load((const GAS f32x2v*)(p_ + (size_t)j * NMOD * 4 + woff)); } } \
        __builtin_amdgcn_sched_barrier(0); } while (0)
#define MOD_CHUNK(u, q) do { \
        LAS unsigned char* slot = lds + ((q) & 3) * MODA_SLOT; \
        if (!ACTIVE) { _Pragma("unroll") for (int i = 0; i < NAP; ++i) *(LAS v4u*)(slot + adst[i]) = ap[u][i]; } \
        asm volatile("s_waitcnt lgkmcnt(0)" ::: "memory"); __builtin_amdgcn_s_barrier(); asm volatile("" ::: "memory"); \
        if (ACTIVE) { _Pragma("unroll") for (int ks = 0; ks < 2; ++ks) { \
            v4u w0, w1; \
            w0.x = cvtpk(br[u][ks][0].x, br[u][ks][1].x); w0.y = cvtpk(br[u][ks][2].x, br[u][ks][3].x); w0.z = cvtpk(br[u][ks][4].x, br[u][ks][5].x); w0.w = cvtpk(br[u][ks][6].x, br[u][ks][7].x); \
            w1.x = cvtpk(br[u][ks][0].y, br[u][ks][1].y); w1.y = cvtpk(br[u][ks][2].y, br[u][ks][3].y); w1.z = cvtpk(br[u][ks][4].y, br[u][ks][5].y); w1.w = cvtpk(br[u][ks][6].y, br[u][ks][7].y); \
            const bf16x8 b0 = __builtin_bit_cast(bf16x8, w0), b1 = __builtin_bit_cast(bf16x8, w1); \
            _Pragma("unroll") for (int mb = 0; mb < 9; ++mb) { const bf16x8 af = *(const LAS bf16x8*)(slot + mb * 16 * MODA_ROW + ks * 64 + aoff); \
                acc[mb][0] = __builtin_amdgcn_mfma_f32_16x16x32_bf16(af, b0, acc[mb][0], 0, 0, 0); acc[mb][1] = __builtin_amdgcn_mfma_f32_16x16x32_bf16(af, b1, acc[mb][1], 0, 0, 0); } } } \
        __builtin_amdgcn_sched_barrier(0); \
        { const int qn_ = ((q) + 3 < 64) ? (q) + 3 : 63; MOD_ISSUE(u, qn_); } } while (0)
    MOD_ISSUE(0, 0); MOD_ISSUE(1, 1); MOD_ISSUE(2, 2);
    for (int q0 = 0; q0 < 63; q0 += 3) { MOD_CHUNK(0, q0); MOD_CHUNK(1, q0 + 1); MOD_CHUNK(2, q0 + 2); }
    MOD_CHUNK(0, 63);
#undef MOD_CHUNK
#undef MOD_ISSUE
    if (ACTIVE) {
        const f32x2v bias = *(const GAS f32x2v*)(a.in[9] + n0 + 2 * c);
#pragma unroll
        for (int mb = 0; mb < 9; ++mb)
#pragma unroll
            for (int i = 0; i < 4; ++i) { const int row = mb * 16 + 4 * kq + i;
                if (row < NCOND) { const f32x2v o_ = (f32x2v){acc[mb][0][i] + bias.x, acc[mb][1][i] + bias.y};
                    __hip_atomic_store((unsigned long long*)(MOD + (size_t)row * NMOD + n0 + 2 * c), __builtin_bit_cast(unsigned long long, o_), __ATOMIC_RELAXED, __HIP_MEMORY_SCOPE_AGENT); } }
        asm volatile("s_waitcnt vmcnt(0)" ::: "memory");
        if (rdy && lane == 0) (void)__hip_atomic_fetch_add(rdy, 1u, __ATOMIC_RELAXED, __HIP_MEMORY_SCOPE_AGENT);
    }
}

#ifndef MK_PER_PHASE
#define MK_PER_PHASE 0
#endif
constexpr int NPHASE = 11;
__global__ void __launch_bounds__(NWAVES * 64, 2) mega_fwd(Args args) {
    extern __shared__ __attribute__((aligned(16))) unsigned char lds[];
    Frame F;
    F.lds = (LAS unsigned char*)lds;
    F.MISC = (volatile LAS unsigned*)(F.lds + MISC_OFF);
    F.wave = __builtin_amdgcn_readfirstlane((int)threadIdx.x >> 6);
    F.G = gridDim.x; { const int bx = blockIdx.x; F.vcu = (F.G % 8 == 0) ? (bx % 8) * (F.G / 8) + bx / 8 : bx; }
    unsigned char* ws = args.ws;
    F.ctl = (gu32*)(ws + WS_CTL);
    for (int u = (int)threadIdx.x; u < (LDS_BYTES - LDSCTL_OFF) / 4; u += NWAVES * 64) ((LAS unsigned*)(F.lds + LDSCTL_OFF))[u] = 0u;
    __syncthreads();
    if (threadIdx.x == 0) { const unsigned x_ = xb_xcc_id(); F.MISC[16] = x_; F.MISC[17] = xb_add((unsigned*)(F.ctl + CW_XRANK) + 64 * x_, 1u); }
    XcdBarrier bar; bar.bar = (unsigned*)(F.ctl + CW_BAR); bar.x = 0; bar.st = nullptr;
    if (!MK_PER_PHASE) bar = xcd_barrier_post((unsigned*)(F.ctl + CW_BAR), F.MISC + 8);
#define GRID_BAR() do { if (!MK_PER_PHASE) xcd_barrier(bar); } while (0)
    const int lo = args.ph_lo, hi = args.ph_hi;
#ifndef PHASE_MASK
#define PHASE_MASK 0x7ff
#endif
#define IN(k) (((PHASE_MASK >> (k)) & 1) && lo <= (k) && (k) < hi)
#define BOTH(k) (IN(k) && IN((k) + 1))
    const int gw = F.vcu * NWAVES + F.wave, NGW = F.G * NWAVES;
    bf16* const SC = (bf16*)(ws + WS_SC); float* const MOD = (float*)(ws + WS_MOD);
    bf16* const H = (bf16*)(ws + WS_H); bf16* const PROJ = (bf16*)(ws + WS_PROJ); bf16* const MIX = (bf16*)(ws + WS_MIX);
    bf16* const X2 = (bf16*)(ws + WS_H);        bf16* const X1 = (bf16*)(ws + WS_X1);       unsigned char* const ACT = ws + WS_ACT;

    if (IN(0)) { p0_prologue(F, args); }
    if (IN(1)) {
        if (F.wave == 0) {
            unsigned sp_ = 0u; unsigned* tmo_ = (unsigned*)(F.ctl + CW_BAR) + XB_TMO;
            while (xb_ld((unsigned*)(F.ctl + CW_SCRDY)) < 256u) { __builtin_amdgcn_s_sleep(4); if ((++sp_ & 255u) == 0u) { if (xb_ld(tmo_)) break; if (sp_ > XB_SPIN_CAP) { atomicAdd(tmo_, 1u); break; } } }
            __builtin_amdgcn_fence(__ATOMIC_ACQUIRE, "agent"); asm volatile("s_waitcnt vmcnt(0)" ::: "memory");
        }
        __syncthreads();
        for (int nb0 = 3 * F.vcu; nb0 < NMOD / 32; nb0 += 3 * F.G) {
            const int t_ = opaque_tid();
            if (F.wave < 3) mod_phase_wave<true>(args, SC, MOD, F.lds + RING_OFF, (nb0 + F.wave < NMOD / 32) ? nb0 + F.wave : nb0, t_, (nb0 + F.wave < 2 * DM / 32) ? (unsigned*)(F.ctl + CW_MODRDY) : nullptr);
            else mod_phase_wave<false>(args, SC, MOD, F.lds + RING_OFF, 0, t_, nullptr);
            __syncthreads();
        }
    }
    if (IN(2)) {
        if (F.wave == 0) {
            unsigned sp_ = 0u; unsigned* tmo_ = (unsigned*)(F.ctl + CW_BAR) + XB_TMO;
            while (xb_ld((unsigned*)(F.ctl + CW_MODRDY)) < 256u) { __builtin_amdgcn_s_sleep(4); if ((++sp_ & 255u) == 0u) { if (xb_ld(tmo_)) break; if (sp_ > XB_SPIN_CAP) { atomicAdd(tmo_, 1u); break; } } }
            __builtin_amdgcn_fence(__ATOMIC_ACQUIRE, "agent"); asm volatile("s_waitcnt vmcnt(0)" ::: "memory");
        }
        __syncthreads();
        const int l_ = opaque_tid() & 63;
        norm_mod_phase<0, 0>(args, X1, MOD, args.in[10], H, gw, NGW, l_, ws + WS_H8, (float*)(ws + WS_HS));
        if (BOTH(2)) GRID_BAR();
    }
    int cid = (int)blockIdx.x;
    if (!MK_PER_PHASE && lo == 0 && (F.G & 7) == 0) {
        bool even = true;
        for (int j = 0; j < 8; ++j) even = even && (xb_ld((unsigned*)(F.ctl + CW_XRANK) + 64 * j) == (unsigned)(F.G >> 3));
        const int x_ = __builtin_amdgcn_readfirstlane((int)F.MISC[16]), r_ = __builtin_amdgcn_readfirstlane((int)F.MISC[17]);
        if (even && x_ < 8 && r_ < (F.G >> 3)) cid = r_ * 8 + x_;
    }
    float* const SB2 = (float*)(ws + WS_GU + 16 * MiB);
    if (IN(3)) {
        { pg8::Gemm g{(const bf16*)(ws + WS_H8), (const bf16*)(ws + WS_WIN8), 30 * 256, NIN, DM / 2, PKB / 2}; pg8::StaticOrder S; S.init(30 * 256, NIN, DM / 2, F.G, cid); S.pmode = 2;
          pg8::EpiInProjT<true> E{PROJ, NPR, MIX, PK, args.in[13], args.in[4], SB2, args.out + O_CP, args.out + O_CS, (LAS float*)(F.lds + HALO_OFF), 1.0f / pg8::WGU_I8SCALE, (const float*)(ws + WS_HS)};
          pg8::gemm_phase<pg8::EpiInProjT<true>, pg8::StaticOrder, true, true, 2>(F.lds + RING_OFF, g, S, E); }
        __syncthreads();
        { pg8::Gemm g{H, (const bf16*)(ws + WS_WIN), 6 * 256, NIN, DM, PK}; pg8::StaticOrder S; S.init(6 * 256, NIN, DM, F.G, cid); S.pmode = 1;
          pg8::EpiInProj E{PROJ, NPR, MIX, PK, args.in[13], args.in[4], SB2, args.out + O_CP, args.out + O_CS, (LAS float*)(F.lds + HALO_OFF)};
          pg8::gemm_phase<pg8::EpiInProj, pg8::StaticOrder, true, true, 0>(F.lds + RING_OFF, g, S, E); }
        convert_queue(args, F.lds + RING_OFF + F.wave * 16384, I_END0, I_END1, (unsigned*)(F.ctl + CW_CONVQ + 128));
        kvcopy_queue(args, (unsigned*)(F.ctl + CW_CONVQ + 256));
        if (BOTH(3)) GRID_BAR();
    }
    if (IN(4)) {
        const int first_ = ((int)blockIdx.x >> 3) & 1;
#pragma unroll 1
        for (int pass = 0; pass < 2; ++pass) {
            if ((pass ^ first_) == 0) {
                for (int u = (int)blockIdx.x; u < 256; u += F.G) { const int t_ = opaque_tid(); att::prompt_unit(F.lds + RING_OFF, PROJ, ws + WS_MIX8A, args.in[14], u >> 7, (u >> 2) & 31, u & 3, t_); }
                for (int u = (int)blockIdx.x; u < 256; u += F.G) { const int t_ = opaque_tid(); att::sample_unit(F.lds + RING_OFF, PROJ, args.in[2], args.in[3], ws + WS_MIX8A, args.in[14], u >> 1, u & 1, t_); }
            } else {
                for (int it = gw; it < 30 * 4; it += NGW) { const int l_ = opaque_tid() & 63; convfix_item(args, SB2, MIX, it >> 2, it & 3, l_); }
                for (int it = gw; it < 640; it += NGW) { const int l_ = opaque_tid() & 63; kvstate_item4(args, PROJ, it, l_); }
            }
        }
        if (BOTH(4)) GRID_BAR();
    }
    if (IN(5)) {
        const int Gg = (F.G & 31) ? F.G : F.G - (F.G >> 2);
        if (cid < Gg) {
            pg8::Gemm g{MIX, (const bf16*)(ws + WS_WOUT), MTOT, DM, DM, PK, 0, 0, (const bf16*)(ws + WS_MIX8A), (const bf16*)(ws + WS_WOUT8A), 1.0f / (pg8::ATT_PRESCALE * pg8::WOUT_PRESCALE)}; pg8::PairOrder S; S.init(MTOT, DM, DM, Gg, cid);
            pg8::EpiResGate<false, true> E{args.in[0], args.in[1], X1, MOD + 2 * DM};
            pg8::gemm_phase<pg8::EpiResGate<false, true>, pg8::PairOrder, true, true, 3>(F.lds + RING_OFF, g, S, E);
        }
        convert_queue(args, F.lds + RING_OFF + F.wave * 16384, I_END1, I_END2 + I_DN_P5, (unsigned*)(F.ctl + CW_CONVQ));
        if (BOTH(5)) GRID_BAR();
    }
    if (IN(6)) {
        const int l_ = opaque_tid() & 63;
        norm_mod_phase<1, 3>(args, X1, MOD, args.in[11], H, gw, NGW, l_, ws + WS_H8, (float*)(ws + WS_HS), (bf16*)(ws + WS_HST));
        if (BOTH(6)) GRID_BAR();
    }
    float* const SB = (float*)(ws + WS_GU);
    if (IN(7)) {
        { pg8::Gemm g{(const bf16*)(ws + WS_H8), (const bf16*)(ws + WS_WGU8), 34 * 256, NGU, DM / 2, PKB / 2}; pg8::SplitOrder S; S.init2(34 * 256, NGU, DM / 2, F.G, cid, 8, (float*)(ws + WS_SLAB), (unsigned*)(F.ctl + CW_TICK + 3 * TICK_WORDS)); S.pmode = 3; S.ints = true; S.wgflag = (LAS unsigned*)(F.lds + MISC_OFF + 80);
          pg8::EpiGateUpT<true> E{ACT, PFB, args.in[17], args.in[5], SB, args.out + O_FP, args.out + O_FS, (LAS float*)(F.lds + HALO_OFF), 1.0f / pg8::WGU_I8SCALE, (const float*)(ws + WS_HS)};
          pg8::gemm_phase<pg8::EpiGateUpT<true>, pg8::SplitOrder, true, true, 2>(F.lds + RING_OFF, g, S, E); }
        __syncthreads();
        { pg8::Gemm g{H, (const bf16*)(ws + WS_WGU), 2 * 256, NGU, DM, PK}; pg8::StaticOrder S; S.init(2 * 256, NGU, DM, F.G, cid); S.pmode = 4;
          pg8::EpiGateUp E{ACT, PFB, args.in[17], args.in[5], SB, args.out + O_FP, args.out + O_FS, (LAS float*)(F.lds + HALO_OFF), 1.0f};
          pg8::gemm_phase<pg8::EpiGateUp, pg8::StaticOrder, true, true, 0>(F.lds + RING_OFF, g, S, E); }
        __syncthreads();
        { pg8::Gemm g{(const bf16*)(ws + WS_HST), (const bf16*)(ws + WS_WGU), 256, 43 * 256, DM, PK, (size_t)512 * PK, (size_t)1024 * PK}; pg8::StaticOrder S; S.init(256, 43 * 256, DM, F.G, (cid + F.G - 172) % F.G);
          pg8::EpiGateState E{args.out + O_FS};
          pg8::gemm_phase<pg8::EpiGateState, pg8::StaticOrder, true, true, 0>(F.lds + RING_OFF, g, S, E); }
        convert_queue(args, F.lds + RING_OFF + F.wave * 16384, I_END2 + I_DN_P5, I_END3, (unsigned*)(F.ctl + CW_CONVQ + 192));
        if (BOTH(7)) GRID_BAR();
    }
    if (IN(8)) {
        for (int it = gw; it < 30 * 22; it += NGW) { const int l_ = opaque_tid() & 63; fixup_item(args, SB, ACT, it / 22, it % 22, l_); }
        if (BOTH(8)) GRID_BAR();
    }
    if (IN(9)) {
        pg8::Gemm g{(const bf16*)ACT, (const bf16*)(ws + WS_WDN), MTOT, DM, DFF / 2, PFB / 2}; pg8::SplitOrder S; S.init2(MTOT, DM, DFF / 2, F.G, cid, 4, (float*)(ws + WS_SLAB), (unsigned*)(F.ctl + CW_TICK + 2 * TICK_WORDS));
        pg8::EpiResGate<true, true> E{X1, X1 + (size_t)NTOKP * DM, X2, MOD + 5 * DM, 1.0f / (pg8::ACT_PRESCALE * pg8::WDN_PRESCALE)};
        pg8::gemm_phase<pg8::EpiResGate<true, true>, pg8::SplitOrder, true, true, true>(F.lds + RING_OFF, g, S, E);
        if (BOTH(9)) GRID_BAR();
    }
    if (IN(10)) {
        const int l_ = opaque_tid() & 63;
        final_norm_phase(X2, args.out + O_Y, args.in[19], gw, NGW, l_);
    }
#undef IN
#undef BOTH
#undef GRID_BAR
}

extern "C" void kernel_launch(void* const* d_in, const int* in_sizes, int n_in, void* d_out, int out_size, void* d_ws, size_t ws_size, hipStream_t stream) {
    static int grid = 0;
    if (grid == 0) {
        if (n_in != 20 || in_sizes[0] != NTOKP * DM || (size_t)out_size != O_END || ws_size < WS_END) {
            fprintf(stderr, "kernel_launch: unexpected shapes: n_in %d in0 %d out %d ws %zu (need %zu); nothing launched\n", n_in, n_in > 0 ? in_sizes[0] : -1, out_size, ws_size, (size_t)WS_END); grid = -1; return; }
        int dev = 0, cus = 0, per_cu = 0;
        if (hipGetDevice(&dev) != hipSuccess || hipDeviceGetAttribute(&cus, hipDeviceAttributeMultiprocessorCount, dev) != hipSuccess) { fprintf(stderr, "kernel_launch: device query failed\n"); grid = -1; return; }
        if (hipFuncSetAttribute((const void*)mega_fwd, hipFuncAttributeMaxDynamicSharedMemorySize, LDS_BYTES) != hipSuccess) { fprintf(stderr, "kernel_launch: hipFuncSetAttribute failed\n"); grid = -1; return; }
        if (hipOccupancyMaxActiveBlocksPerMultiprocessor(&per_cu, (const void*)mega_fwd, NWAVES * 64, LDS_BYTES) != hipSuccess || per_cu < 1)
            fprintf(stderr, "kernel_launch: note: occupancy query reports %d workgroups per CU\n", per_cu);
        (void)hipGetLastError();
        grid = cus;
    }
    if (grid < 0) return;
    if (hipMemsetAsync((char*)d_ws + WS_CTL, 0, CTL_ZERO_BYTES, stream) != hipSuccess) { fprintf(stderr, "kernel_launch: memset failed\n"); return; }
    Args a{};
    for (int i = 0; i < 20; ++i) a.in[i] = (const float*)d_in[i];
    a.out = (float*)d_out; a.ws = (unsigned char*)d_ws; a.li = 0; a.pad = 0;
#if MK_PER_PHASE
    for (int p = 0; p < NPHASE; ++p) { a.ph_lo = p; a.ph_hi = p + 1; hipLaunchKernelGGL(mega_fwd, dim3(grid), dim3(NWAVES * 64), LDS_BYTES, stream, a); }
#else
    a.ph_lo = 0; a.ph_hi = NPHASE;
    hipLaunchKernelGGL(mega_fwd, dim3(grid), dim3(NWAVES * 64), LDS_BYTES, stream, a);
#endif
    const hipError_t le = hipPeekAtLastError();
    if (le != hipSuccess) fprintf(stderr, "kernel_launch: launch failed: %s\n", hipGetErrorName(le));
}
```
